# Optimizing an MI355X kernel written in HIP

```python
import math
import jax, jax.numpy as jnp
from jax import lax
import numpy as np

D_MODEL = 1024
BATCH = 1
SEQ = 16384
DEPTH = 1

MIX_WIDTH = D_MODEL
ATTN_WIDTH = MIX_WIDTH // 2
CONV_WIDTH = MIX_WIDTH - ATTN_WIDTH
DIFF_HEAD_DIM = 64
V_HEAD_DIM = 2 * DIFF_HEAD_DIM
N_ATTN_HEADS = ATTN_WIDTH // V_HEAD_DIM
CONV_KERNEL = 31
FFN_HIDDEN = ((-(-8 * D_MODEL // 3) + 255) // 256) * 256
PLE_DIM = 256
Q_BLOCK = 128
IN_COLS = 3 * ATTN_WIDTH + 2 * CONV_WIDTH
EPS = 1e-6

kernel_name = "hybrid_diffattn_conformer_conv_block"


def alibi_slopes(n_heads):
    return np.array([2.0 ** (-8.0 * (h + 1) / n_heads) for h in range(n_heads)], dtype=np.float32)


def rmsnorm(x, gain):
    x32 = x.astype(jnp.float32)
    y = x32 * lax.rsqrt(jnp.mean(x32 * x32, axis=-1, keepdims=True) + EPS)
    return (y * gain.astype(jnp.float32)).astype(x.dtype)


def layernorm(x, gain, bias):
    x32 = x.astype(jnp.float32)
    mu = jnp.mean(x32, axis=-1, keepdims=True)
    xc = x32 - mu
    y = xc * lax.rsqrt(jnp.mean(xc * xc, axis=-1, keepdims=True) + EPS)
    return (y * gain.astype(jnp.float32) + bias.astype(jnp.float32)).astype(x.dtype)


def diff_attention(q, k, v, lam):
    B, S = q.shape[0], q.shape[1]
    nblk = S // Q_BLOCK
    scale = DIFF_HEAD_DIM ** -0.5
    slopes = jnp.asarray(alibi_slopes(N_ATTN_HEADS))
    key_pos = jnp.arange(S, dtype=jnp.int32)
    q_blocks = jnp.moveaxis(q.reshape(B, nblk, Q_BLOCK, N_ATTN_HEADS, 2, DIFF_HEAD_DIM), 1, 0)
    starts = jnp.arange(nblk, dtype=jnp.int32) * Q_BLOCK

    def block(args):
        q_blk, start = args
        s = jnp.einsum('bqhmd,bkhmd->bhmqk', q_blk, k).astype(jnp.float32) * scale
        q_pos = start + jnp.arange(Q_BLOCK, dtype=jnp.int32)
        dist = jnp.abs(q_pos[:, None] - key_pos[None, :]).astype(jnp.float32)
        s = s - slopes[:, None, None, None] * dist
        a = jax.nn.softmax(s, axis=-1)
        w = a[:, :, 0] - lam * a[:, :, 1]
        return jnp.einsum('bhqk,bkhe->bqhe', w.astype(v.dtype), v)

    o = lax.map(block, (q_blocks, starts))
    return jnp.moveaxis(o, 0, 1).reshape(B, S, N_ATTN_HEADS, V_HEAD_DIM)


def conformer_conv(a, g, conv_w, conv_b, ln_g, ln_b):
    u = a * jax.nn.sigmoid(g)
    rhs = conv_w[:, None, :].astype(u.dtype)
    y = lax.conv_general_dilated(
        u, rhs, window_strides=(1,),
        padding=[(CONV_KERNEL // 2, CONV_KERNEL // 2)],
        dimension_numbers=('NWC', 'WIO', 'NWC'),
        feature_group_count=CONV_WIDTH) + conv_b.astype(u.dtype)
    y = layernorm(y, ln_g, ln_b)
    return jax.nn.silu(y)


def setup_inputs(seed: int = 0) -> dict:
    key = jax.random.key(seed)
    ks = jax.random.split(key, 24)
    f32 = jnp.float32

    def nrm(k, shape, scale):
        return jax.random.normal(k, shape, f32) * scale

    def gain(k, shape):
        return 1.0 + 0.05 * jax.random.normal(k, shape, f32)

    L = DEPTH
    return {
        "x": nrm(ks[0], (BATCH, SEQ, D_MODEL), 1.0),
        "p": nrm(ks[1], (DEPTH, BATCH, SEQ, PLE_DIM), 1.0),
        "attn_norm": gain(ks[2], (L, D_MODEL)),
        "w_in": nrm(ks[3], (L, D_MODEL, IN_COLS), D_MODEL ** -0.5),
        "q_norm": gain(ks[4], (L, DIFF_HEAD_DIM)),
        "k_norm": gain(ks[5], (L, DIFF_HEAD_DIM)),
        "lambda_q1": nrm(ks[6], (L, DIFF_HEAD_DIM), 0.1),
        "lambda_k1": nrm(ks[7], (L, DIFF_HEAD_DIM), 0.1),
        "lambda_q2": nrm(ks[8], (L, DIFF_HEAD_DIM), 0.1),
        "lambda_k2": nrm(ks[9], (L, DIFF_HEAD_DIM), 0.1),
        "head_norm": gain(ks[10], (L, V_HEAD_DIM)),
        "conv_w": nrm(ks[11], (L, CONV_KERNEL, CONV_WIDTH), CONV_KERNEL ** -0.5),
        "conv_b": nrm(ks[12], (L, CONV_WIDTH), 0.02),
        "conv_ln_g": gain(ks[13], (L, CONV_WIDTH)),
        "conv_ln_b": nrm(ks[14], (L, CONV_WIDTH), 0.02),
        "w_out": nrm(ks[15], (L, MIX_WIDTH, D_MODEL), MIX_WIDTH ** -0.5),
        "ffn_norm": gain(ks[16], (L, D_MODEL)),
        "w_gate": nrm(ks[17], (L, D_MODEL, FFN_HIDDEN), D_MODEL ** -0.5),
        "w_up": nrm(ks[18], (L, D_MODEL, FFN_HIDDEN), D_MODEL ** -0.5),
        "w_down": nrm(ks[19], (L, FFN_HIDDEN, D_MODEL), FFN_HIDDEN ** -0.5),
        "ple_norm": gain(ks[20], (L, D_MODEL)),
        "w_ple_gate": nrm(ks[21], (L, D_MODEL, D_MODEL), D_MODEL ** -0.5),
        "w_ple_proj": nrm(ks[22], (L, PLE_DIM, D_MODEL), PLE_DIM ** -0.5),
    }


def reference(x, p, attn_norm, w_in, q_norm, k_norm, lambda_q1, lambda_k1, lambda_q2, lambda_k2,
              head_norm, conv_w, conv_b, conv_ln_g, conv_ln_b, w_out, ffn_norm, w_gate, w_up,
              w_down, ple_norm, w_ple_gate, w_ple_proj):
    B, S = x.shape[0], x.shape[1]
    splits = [ATTN_WIDTH, 2 * ATTN_WIDTH, 3 * ATTN_WIDTH, 3 * ATTN_WIDTH + CONV_WIDTH]
    for i in range(DEPTH):
        h = rmsnorm(x, attn_norm[i])
        proj = h @ w_in[i]
        q, k, v, conv_a, conv_g = jnp.split(proj, splits, axis=-1)

        q = rmsnorm(q.reshape(B, S, N_ATTN_HEADS, 2, DIFF_HEAD_DIM), q_norm[i])
        k = rmsnorm(k.reshape(B, S, N_ATTN_HEADS, 2, DIFF_HEAD_DIM), k_norm[i])
        v = v.reshape(B, S, N_ATTN_HEADS, V_HEAD_DIM)
        lam_init = 0.8 - 0.6 * math.exp(-0.3 * i)
        lam = (jnp.exp(jnp.sum(lambda_q1[i].astype(jnp.float32) * lambda_k1[i].astype(jnp.float32)))
               - jnp.exp(jnp.sum(lambda_q2[i].astype(jnp.float32) * lambda_k2[i].astype(jnp.float32)))
               + lam_init)
        o = diff_attention(q, k, v, lam)
        o = rmsnorm(o, head_norm[i]) * (1.0 - lam_init)
        attn_out = o.reshape(B, S, ATTN_WIDTH)

        conv_out = conformer_conv(conv_a, conv_g, conv_w[i], conv_b[i], conv_ln_g[i], conv_ln_b[i])

        mix = jnp.concatenate([attn_out, conv_out], axis=-1)
        x = x + mix @ w_out[i]

        h = rmsnorm(x, ffn_norm[i])
        x = x + (jax.nn.silu(h @ w_gate[i]) * (h @ w_up[i])) @ w_down[i]

        gate = jax.nn.sigmoid(rmsnorm(x, ple_norm[i]) @ w_ple_gate[i])
        x = x + gate * (p[i] @ w_ple_proj[i])
    return x
```

```cpp
#include <hip/hip_runtime.h>
#include <stdint.h>
#include <cstdio>

constexpr int M = 16384, DM = 1024, NIN = 2560, AW = 512, CW = 512, NH = 4, DH = 64, VH = 128, KC = 31, FF = 2816, PD = 256;
constexpr float EPS = 1e-6f;
constexpr float LOG2E = 1.4426950408889634f;
constexpr float QSCALE = 0.125f * LOG2E;
constexpr float LAM_INIT = 0.2f;

typedef unsigned short bf16_t;
__device__ __forceinline__ bf16_t f2bf(float f) { unsigned u = __builtin_bit_cast(unsigned, f); return (bf16_t)((u + 0x7fffu + ((u >> 16) & 1u)) >> 16); }
__device__ __forceinline__ float bf2f(bf16_t h) { return __builtin_bit_cast(float, (unsigned)h << 16); }

constexpr size_t MiB = 1u << 20;
constexpr size_t WS_SS1 = 29 * MiB, WS_SS2 = 30 * MiB;
constexpr size_t WS_XN = 32 * MiB;
constexpr size_t WS_Q = 64 * MiB, WS_K = 80 * MiB, WS_V = 96 * MiB, WS_U = 112 * MiB, WS_MIX = 128 * MiB;
constexpr size_t WS_HM = 64 * MiB;
constexpr size_t WS_PB = 160 * MiB, WS_PROJ = 168 * MiB, WS_END = 200 * MiB;

struct Ptrs {
    const float *x, *p, *attn_norm, *w_in, *q_norm, *k_norm, *lq1, *lk1, *lq2, *lk2, *head_norm, *conv_w, *conv_b, *conv_ln_g, *conv_ln_b,
        *w_out, *ffn_norm, *w_gate, *w_up, *w_down, *ple_norm, *w_ple_gate, *w_ple_proj;
    float* out; unsigned char* ws;
};

__device__ __forceinline__ float wave_sum(float v) {
#pragma unroll
    for (int o = 1; o < 64; o <<= 1) v += __shfl_xor(v, o);
    return v;
}

__global__ __launch_bounds__(256) void k_prep(Ptrs P) {
    const int lane = threadIdx.x & 63, w = threadIdx.x >> 6;
    bf16_t* XN = (bf16_t*)(P.ws + WS_XN); bf16_t* PB = (bf16_t*)(P.ws + WS_PB);
    for (int m = blockIdx.x * 4 + w; m < M; m += gridDim.x * 4) {
        const float4* xr = (const float4*)(P.x + (size_t)m * DM);
        float4 v[4]; float s = 0.f;
#pragma unroll
        for (int j = 0; j < 4; ++j) { v[j] = xr[lane + 64 * j]; s += v[j].x * v[j].x + v[j].y * v[j].y + v[j].z * v[j].z + v[j].w * v[j].w; }
        const float r = rsqrtf(wave_sum(s) * (1.f / DM) + EPS);
#pragma unroll
        for (int j = 0; j < 4; ++j) {
            const int c = (lane + 64 * j) * 4; const float4 g = *(const float4*)(P.attn_norm + c);
            ushort4 o; o.x = f2bf(v[j].x * r * g.x); o.y = f2bf(v[j].y * r * g.y); o.z = f2bf(v[j].z * r * g.z); o.w = f2bf(v[j].w * r * g.w);
            *(ushort4*)(XN + (size_t)m * DM + c) = o;
        }
        const float4 pv = ((const float4*)(P.p + (size_t)m * PD))[lane];
        ushort4 o; o.x = f2bf(pv.x); o.y = f2bf(pv.y); o.z = f2bf(pv.z); o.w = f2bf(pv.w);
        *(ushort4*)(PB + (size_t)m * PD + lane * 4) = o;
    }
}

template <class Epi, bool DUAL>
__global__ __launch_bounds__(256) void ngemm(const bf16_t* A, int lda, const float* B1, int ldb1, const float* B2, int ldb2, int K, Epi epi) {
    __shared__ float As[16][68];
    __shared__ float B1s[16][64];
    __shared__ float B2s[16][64];
    __shared__ float Cs[2][64][65];
    const int tid = threadIdx.x, tn = blockIdx.x, tm = blockIdx.y, tx = tid & 15, ty = tid >> 4;
    float c1[4][4], c2[4][4];
#pragma unroll
    for (int i = 0; i < 4; ++i)
#pragma unroll
        for (int j = 0; j < 4; ++j) { c1[i][j] = 0.f; c2[i][j] = 0.f; }
    const int ar = tid >> 2, ak = (tid & 3) * 4;
    const int bk = tid >> 4, bn = (tid & 15) * 4;
    for (int k0 = 0; k0 < K; k0 += 16) {
        const ushort4 a4 = *(const ushort4*)(A + (size_t)(tm * 64 + ar) * lda + k0 + ak);
        As[ak + 0][ar] = bf2f(a4.x); As[ak + 1][ar] = bf2f(a4.y); As[ak + 2][ar] = bf2f(a4.z); As[ak + 3][ar] = bf2f(a4.w);
        *(float4*)&B1s[bk][bn] = *(const float4*)(B1 + (size_t)(k0 + bk) * ldb1 + tn * 64 + bn);
        if (DUAL) *(float4*)&B2s[bk][bn] = *(const float4*)(B2 + (size_t)(k0 + bk) * ldb2 + tn * 64 + bn);
        __syncthreads();
#pragma unroll
        for (int kk = 0; kk < 16; ++kk) {
            float a[4], b[4], d[4];
#pragma unroll
            for (int i = 0; i < 4; ++i) { a[i] = As[kk][ty * 4 + i]; b[i] = B1s[kk][tx * 4 + i]; d[i] = DUAL ? B2s[kk][tx * 4 + i] : 0.f; }
#pragma unroll
            for (int i = 0; i < 4; ++i)
#pragma unroll
                for (int j = 0; j < 4; ++j) { c1[i][j] += a[i] * b[j]; if (DUAL) c2[i][j] += a[i] * d[j]; }
        }
        __syncthreads();
    }
#pragma unroll
    for (int i = 0; i < 4; ++i)
#pragma unroll
        for (int j = 0; j < 4; ++j) { Cs[0][ty * 4 + i][tx * 4 + j] = c1[i][j]; Cs[1][ty * 4 + i][tx * 4 + j] = c2[i][j]; }
    __syncthreads();
    if (tid < 64) epi(tm * 64 + tid, tn, &Cs[0][tid][0], &Cs[1][tid][0]);
}

struct EpiQKV {
    bf16_t *Q, *K, *V; const float *qn, *kn;
    __device__ void operator()(int m, int tn, const float* c, const float*) const {
        if (tn < 16) {
            float ss = 0.f; for (int j = 0; j < 64; ++j) ss += c[j] * c[j];
            const float r = rsqrtf(ss * (1.f / 64.f) + EPS);
            if (tn < 8) { for (int j = 0; j < 64; ++j) Q[(size_t)m * AW + tn * 64 + j] = f2bf(c[j] * r * qn[j] * QSCALE); }
            else { for (int j = 0; j < 64; ++j) K[(size_t)m * AW + (tn - 8) * 64 + j] = f2bf(c[j] * r * kn[j]); }
        } else { for (int j = 0; j < 64; ++j) V[(size_t)m * AW + (tn - 16) * 64 + j] = f2bf(c[j]); }
    }
};
struct EpiGLU {
    bf16_t* U;
    __device__ void operator()(int m, int tn, const float* a, const float* g) const {
        for (int j = 0; j < 64; ++j) U[(size_t)m * CW + tn * 64 + j] = f2bf(a[j] / (1.f + __expf(-g[j])));
    }
};
struct EpiRes {
    const float* base; float* out; bf16_t* An; const float* gain;
    __device__ void operator()(int m, int tn, const float* c, const float*) const {
        for (int j = 0; j < 64; ++j) { const int n = tn * 64 + j; const float v = base[(size_t)m * DM + n] + c[j]; out[(size_t)m * DM + n] = v; An[(size_t)m * DM + n] = f2bf(v * gain[n]); }
    }
};
struct EpiGU {
    bf16_t* HM; const float* SS;
    __device__ void operator()(int m, int tn, const float* g, const float* u) const {
        const float r = rsqrtf((SS[m * 4] + SS[m * 4 + 1] + SS[m * 4 + 2] + SS[m * 4 + 3]) * (1.f / DM) + EPS);
        for (int j = 0; j < 64; ++j) { const float gg = g[j] * r, uu = u[j] * r; HM[(size_t)m * FF + tn * 64 + j] = f2bf(gg / (1.f + __expf(-gg)) * uu); }
    }
};
struct EpiPP {
    bf16_t* PR;
    __device__ void operator()(int m, int tn, const float* c, const float*) const { for (int j = 0; j < 64; ++j) PR[(size_t)m * DM + tn * 64 + j] = f2bf(c[j]); }
};
struct EpiPG {
    float* out; const bf16_t* PR; const float* SS;
    __device__ void operator()(int m, int tn, const float* c, const float*) const {
        const float r = rsqrtf((SS[m * 4] + SS[m * 4 + 1] + SS[m * 4 + 2] + SS[m * 4 + 3]) * (1.f / DM) + EPS);
        for (int j = 0; j < 64; ++j) { const size_t o = (size_t)m * DM + tn * 64 + j; out[o] = out[o] + bf2f(PR[o]) / (1.f + __expf(-c[j] * r)); }
    }
};

__global__ __launch_bounds__(256) void k_rowss(const float* X, float* SS) {
    const int lane = threadIdx.x & 63, w = threadIdx.x >> 6;
    for (int m = blockIdx.x * 4 + w; m < M; m += gridDim.x * 4) {
        const float4* xr = (const float4*)(X + (size_t)m * DM); float s = 0.f;
#pragma unroll
        for (int j = 0; j < 4; ++j) { const float4 v = xr[lane + 64 * j]; s += v.x * v.x + v.y * v.y + v.z * v.z + v.w * v.w; }
        s = wave_sum(s);
        if (lane < 4) SS[m * 4 + lane] = lane == 0 ? s : 0.f;
    }
}

__global__ __launch_bounds__(256) void k_nattn(Ptrs P) {
    __shared__ bf16_t Ks[64][136];
    __shared__ bf16_t Vs[64][136];
    __shared__ float Qs[16][128];
    __shared__ float Ps[2][16][64];
    const bf16_t* Q = (const bf16_t*)(P.ws + WS_Q); const bf16_t* K = (const bf16_t*)(P.ws + WS_K); const bf16_t* V = (const bf16_t*)(P.ws + WS_V);
    bf16_t* MIX = (bf16_t*)(P.ws + WS_MIX);
    const int tid = threadIdx.x, h = blockIdx.y, q0 = blockIdx.x * 16;
    const int q = tid >> 4, g = tid & 15;
    float d1 = 0.f, d2 = 0.f;
    for (int j = 0; j < 64; ++j) { d1 += P.lq1[j] * P.lk1[j]; d2 += P.lq2[j] * P.lk2[j]; }
    const float lam = __expf(d1) - __expf(d2) + LAM_INIT;
    const float slope = exp2f(-8.f * (float)(h + 1) / (float)NH) * LOG2E;
    for (int i = tid; i < 16 * 128; i += 256) Qs[i >> 7][i & 127] = bf2f(Q[(size_t)(q0 + (i >> 7)) * AW + h * 128 + (i & 127)]);
    float acc1[8], acc2[8], l1 = 0.f, l2 = 0.f;
#pragma unroll
    for (int i = 0; i < 8; ++i) { acc1[i] = 0.f; acc2[i] = 0.f; }
    const int qi = q0 + q;
    for (int k0 = 0; k0 < M; k0 += 64) {
        __syncthreads();
        for (int i = tid; i < 64 * 16; i += 256) {
            const int r = i >> 4, c = (i & 15) * 8;
            *(uint4*)&Ks[r][c] = *(const uint4*)(K + (size_t)(k0 + r) * AW + h * 128 + c);
            *(uint4*)&Vs[r][c] = *(const uint4*)(V + (size_t)(k0 + r) * AW + h * 128 + c);
        }
        __syncthreads();
#pragma unroll
        for (int kk = 0; kk < 4; ++kk) {
            const int key = g + 16 * kk; float s1 = 0.f, s2 = 0.f;
            for (int d = 0; d < 64; ++d) { s1 += Qs[q][d] * bf2f(Ks[key][d]); s2 += Qs[q][64 + d] * bf2f(Ks[key][64 + d]); }
            const float bias = -slope * fabsf((float)(qi - (k0 + key)));
            const float p1 = exp2f(s1 + bias), p2 = exp2f(s2 + bias);
            l1 += p1; l2 += p2; Ps[0][q][key] = p1; Ps[1][q][key] = p2;
        }
        __syncthreads();
        for (int key = 0; key < 64; ++key) {
            const float p1 = Ps[0][q][key], p2 = Ps[1][q][key];
#pragma unroll
            for (int i = 0; i < 8; ++i) { const float v = bf2f(Vs[key][g * 8 + i]); acc1[i] += p1 * v; acc2[i] += p2 * v; }
        }
    }
#pragma unroll
    for (int o = 1; o < 16; o <<= 1) { l1 += __shfl_xor(l1, o); l2 += __shfl_xor(l2, o); }
    float o8[8], ss = 0.f;
#pragma unroll
    for (int i = 0; i < 8; ++i) { o8[i] = acc1[i] / l1 - lam * acc2[i] / l2; ss += o8[i] * o8[i]; }
#pragma unroll
    for (int o = 1; o < 16; o <<= 1) ss += __shfl_xor(ss, o);
    const float r = rsqrtf(ss * (1.f / 128.f) + EPS) * (1.f - LAM_INIT);
#pragma unroll
    for (int i = 0; i < 8; ++i) MIX[(size_t)qi * DM + h * 128 + g * 8 + i] = f2bf(o8[i] * r * P.head_norm[g * 8 + i]);
}

__global__ __launch_bounds__(256) void k_nconv(Ptrs P) {
    __shared__ float red[8];
    const bf16_t* U = (const bf16_t*)(P.ws + WS_U); bf16_t* MIX = (bf16_t*)(P.ws + WS_MIX);
    const int tid = threadIdx.x, m = blockIdx.x, lane = tid & 63, w = tid >> 6;
    float y[2];
#pragma unroll
    for (int i = 0; i < 2; ++i) {
        const int c = tid + 256 * i; float a = P.conv_b[c];
        for (int t = 0; t < KC; ++t) { const int r = m + t - KC / 2; if (r >= 0 && r < M) a += bf2f(U[(size_t)r * CW + c]) * P.conv_w[t * CW + c]; }
        y[i] = a;
    }
    float s = wave_sum(y[0] + y[1]);
    if (lane == 0) red[w] = s;
    __syncthreads();
    const float mu = (red[0] + red[1] + red[2] + red[3]) * (1.f / CW);
    const float e0 = y[0] - mu, e1 = y[1] - mu;
    float s2 = wave_sum(e0 * e0 + e1 * e1);
    if (lane == 0) red[4 + w] = s2;
    __syncthreads();
    const float r = rsqrtf((red[4] + red[5] + red[6] + red[7]) * (1.f / CW) + EPS);
#pragma unroll
    for (int i = 0; i < 2; ++i) {
        const int c = tid + 256 * i; const float z = (i ? e1 : e0) * r * P.conv_ln_g[c] + P.conv_ln_b[c];
        MIX[(size_t)m * DM + AW + c] = f2bf(z / (1.f + __expf(-z)));
    }
}

extern "C" void kernel_launch(void* const* d_in, const int* in_sizes, int n_in, void* d_out, int out_size, void* d_ws, size_t ws_size, hipStream_t stream) {
    if (n_in != 23 || out_size != M * DM || ws_size < WS_END) { fprintf(stderr, "kernel_launch: unexpected shapes n_in %d out %d ws %zu\n", n_in, out_size, ws_size); return; }
    Ptrs P{};
    const float** pp = (const float**)&P;
    for (int i = 0; i < 23; ++i) pp[i] = (const float*)d_in[i];
    P.out = (float*)d_out; P.ws = (unsigned char*)d_ws;
    unsigned char* ws = P.ws;
    bf16_t *XN = (bf16_t*)(ws + WS_XN), *Qb = (bf16_t*)(ws + WS_Q), *Kb = (bf16_t*)(ws + WS_K), *Vb = (bf16_t*)(ws + WS_V), *Ub = (bf16_t*)(ws + WS_U), *MIX = (bf16_t*)(ws + WS_MIX),
           *HM = (bf16_t*)(ws + WS_HM), *PB = (bf16_t*)(ws + WS_PB), *PR = (bf16_t*)(ws + WS_PROJ);
    float *SS1 = (float*)(ws + WS_SS1), *SS2 = (float*)(ws + WS_SS2);
    k_prep<<<1024, 256, 0, stream>>>(P);
    ngemm<EpiQKV, false><<<dim3(24, M / 64), 256, 0, stream>>>(XN, DM, P.w_in, NIN, nullptr, 0, DM, EpiQKV{Qb, Kb, Vb, P.q_norm, P.k_norm});
    ngemm<EpiGLU, true><<<dim3(8, M / 64), 256, 0, stream>>>(XN, DM, P.w_in + 1536, NIN, P.w_in + 2048, NIN, DM, EpiGLU{Ub});
    ngemm<EpiPP, false><<<dim3(16, M / 64), 256, 0, stream>>>(PB, PD, P.w_ple_proj, DM, nullptr, 0, PD, EpiPP{PR});
    k_nattn<<<dim3(M / 16, NH), 256, 0, stream>>>(P);
    k_nconv<<<M, 256, 0, stream>>>(P);
    ngemm<EpiRes, false><<<dim3(16, M / 64), 256, 0, stream>>>(MIX, DM, P.w_out, DM, nullptr, 0, DM, EpiRes{P.x, P.out, XN, P.ffn_norm});
    k_rowss<<<1024, 256, 0, stream>>>(P.out, SS1);
    ngemm<EpiGU, true><<<dim3(FF / 64, M / 64), 256, 0, stream>>>(XN, DM, P.w_gate, FF, P.w_up, FF, DM, EpiGU{HM, SS1});
    ngemm<EpiRes, false><<<dim3(16, M / 64), 256, 0, stream>>>(HM, FF, P.w_down, DM, nullptr, 0, FF, EpiRes{P.out, P.out, XN, P.ple_norm});
    k_rowss<<<1024, 256, 0, stream>>>(P.out, SS2);
    ngemm<EpiPG, false><<<dim3(16, M / 64), 256, 0, stream>>>(XN, DM, P.w_ple_gate, DM, nullptr, 0, DM, EpiPG{P.out, PR, SS2});
}
```

```cpp
#include <hip/hip_runtime.h>
#include <cstdio>
#include <cstdint>

#ifndef ATT_EXACT_ZERO
#define ATT_EXACT_ZERO 0
#endif
#ifndef MK_N_LAUNCHES
#define MK_N_LAUNCHES 1
#endif

constexpr int M = 16384, DM = 1024, NIN = 2560, AW = 512, CW = 512, NH = 4, DH = 64, VH = 128, KC = 31, FF = 2816, PD = 256;
constexpr float EPS = 1e-6f;
constexpr float LOG2E = 1.4426950408889634f;
constexpr float QSCALE = 0.125f * LOG2E;
constexpr float LAM_INIT = 0.2f;

__host__ __device__ __forceinline__ int v_st(int k, int c) { return ((c >> 5) * 4 + (k >> 4)) * 1024 + (k & 15) * 64 + (c & 31) * 2; }
__host__ __device__ __forceinline__ int k_st(int k, int c) { return (c >> 3) * 1024 + k * 16 + (c & 7) * 2; }
__device__ __forceinline__ float fsigmoid(float x) { return __builtin_amdgcn_rcpf(1.f + __builtin_amdgcn_exp2f(-LOG2E * x)); }

namespace pg8 {
#define PG8_LAS __attribute__((address_space(3)))
typedef unsigned short bf16_t;
typedef short bf16x8 __attribute__((ext_vector_type(8)));
typedef float f32x4 __attribute__((ext_vector_type(4)));
typedef unsigned u32x4 __attribute__((ext_vector_type(4)));
constexpr int BM = 256, BK = 64, HALF = 128, HTB = HALF * BK * 2  , STAGE_BYTES = 8 * HTB, NXCD = 8, WGM = 8;

__host__ __device__ __forceinline__ int lds_byte(int r, int c) { const int st = (r >> 4) * 2 + (c >> 5), rr = r & 15, cc = c & 31, ob = rr * 64 + cc * 2; return st * 1024 + (ob ^ (((ob >> 9) & 1) << 5)); }
__host__ __device__ __forceinline__ void stage_rc(int b, int& R, int& C) { const int st = b / 1024, sb = b % 1024, swz = sb ^ (((sb >> 9) & 1) << 5); R = (st >> 1) * 16 + swz / 64; C = (st & 1) * 32 + (swz % 64) / 2; }
__host__ __device__ __forceinline__ int perm32(int rho) { const int n = rho >> 4, i = rho & 15; return 8 * (i >> 2) + 4 * n + (i & 3); }

struct Unit { int pm, pn; };
struct Gemm { const bf16_t* A; const bf16_t* Bt; int M, N, K; };

struct StaticOrder {
    int nM, nN, nwg, G, c;
    __host__ __device__ void init(int M, int N, int G_, int c_) { nM = M / BM; nN = N / BM; nwg = nM * nN; G = G_; c = c_; }
    __host__ __device__ bool next(int i, Unit& u) const {
        const long L = (long)i * G + c; if (L >= nwg) return false;
        int wgid = (int)L; { const int q = nwg / NXCD, r = nwg % NXCD, xcd = wgid % NXCD, off = wgid / NXCD; wgid = (xcd < r ? xcd * (q + 1) : r * (q + 1) + (xcd - r) * q) + off; }
        const int nig = WGM * nN, gid = wgid / nig, fm = gid * WGM, gsz = (nM - fm) < WGM ? (nM - fm) : WGM;
        u.pm = fm + ((wgid % nig) % gsz); u.pn = (wgid % nig) / gsz; return true;
    }
    __device__ __forceinline__ void a_ready(const Unit&) const {}
    __device__ __forceinline__ void done(const Unit&) const {}
};


__device__ __forceinline__ float sum_fq(float v) {
    { auto r = __builtin_amdgcn_permlane32_swap(__float_as_uint(v), __float_as_uint(v), false, false); v = __uint_as_float(r[0]) + __uint_as_float(r[1]); }
    { auto r = __builtin_amdgcn_permlane16_swap(__float_as_uint(v), __float_as_uint(v), false, false); v = __uint_as_float(r[0]) + __uint_as_float(r[1]); }
    return v;
}
__device__ __forceinline__ unsigned cvt_pk_bf16(float lo, float hi) { unsigned r; asm volatile("v_cvt_pk_bf16_f32 %0, %1, %2" : "=v"(r) : "v"(lo), "v"(hi)); return r; }
typedef _Float16 half2_t __attribute__((ext_vector_type(2)));
__device__ __forceinline__ unsigned pkh(float lo, float hi) { return __builtin_bit_cast(unsigned, __builtin_amdgcn_cvt_pkrtz(lo, hi)); }
__device__ __forceinline__ u32x4 pack8_f16(const f32x4 a, const f32x4 b) { u32x4 w; w.x = pkh(a[0], a[1]); w.y = pkh(a[2], a[3]); w.z = pkh(b[0], b[1]); w.w = pkh(b[2], b[3]); return w; }
__device__ __forceinline__ u32x4 pack8(const f32x4 a, const f32x4 b) { u32x4 w; w.x = cvt_pk_bf16(a[0], a[1]); w.y = cvt_pk_bf16(a[2], a[3]); w.z = cvt_pk_bf16(b[0], b[1]); w.w = cvt_pk_bf16(b[2], b[3]); return w; }

struct EpiBf16 {
    static constexpr bool PERM = true, AFTER_DRAIN = false;
    bf16_t* O; int ldc;
    __device__ __forceinline__ void operator()(const f32x4 (&acc)[2][2][4][2], const Unit& u, int wr, int wc, int fr, int fq) const {
        const int row0 = u.pm * BM + wr * 64 + fr, col0 = u.pn * BM + wc * 32 + 8 * fq;
#pragma unroll
        for (int ai = 0; ai < 2; ++ai)
#pragma unroll
            for (int m = 0; m < 4; ++m) { bf16_t* rowp = O + (size_t)(row0 + ai * HALF + m * 16) * ldc + col0;
#pragma unroll
                for (int bj = 0; bj < 2; ++bj) *(u32x4*)(rowp + bj * HALF) = pack8(acc[ai][bj][m][0], acc[ai][bj][m][1]); }
    }
};

struct EpiIn {
    static constexpr bool PERM = true, AFTER_DRAIN = false;
    bf16_t* Q; unsigned char* Kimg; unsigned char* Vimg; bf16_t* U; const float* qn; const float* kn; unsigned* nmax; const float* SS0; const PG8_LAS float* rtab; int rtab_pm; const PG8_LAS float* gtab; PG8_LAS unsigned* nmax_lds;
    __device__ __forceinline__ void operator()(const f32x4 (&acc)[2][2][4][2], const Unit& u, int wr, int wc, int fr, int fq) const {
        const int row0 = u.pm * BM + wr * 64 + fr;
        float r0s[2][4];
        if (u.pm == rtab_pm) {
#pragma unroll
            for (int ai = 0; ai < 2; ++ai)
#pragma unroll
                for (int m = 0; m < 4; ++m) r0s[ai][m] = rtab[wr * 64 + fr + ai * HALF + m * 16];
        } else {
#pragma unroll
            for (int ai = 0; ai < 2; ++ai)
#pragma unroll
                for (int m = 0; m < 4; ++m) r0s[ai][m] = SS0[row0 + ai * HALF + m * 16];
#pragma unroll
            for (int ai = 0; ai < 2; ++ai)
#pragma unroll
                for (int m = 0; m < 4; ++m) r0s[ai][m] = rsqrtf(r0s[ai][m] * (1.f / DM) + EPS);
        }
        if (u.pn < 4) {
            float nn_max = 0.f;
            const bool isq = u.pn < 2; const PG8_LAS float* gn = gtab + (isq ? 0 : 64); const float sc = isq ? QSCALE : 1.f;
            const int gidx = (u.pn & 1) * 4 + wc;
            f32x4 g[2][2];
#pragma unroll
            for (int bj = 0; bj < 2; ++bj)
#pragma unroll
                for (int n = 0; n < 2; ++n) g[bj][n] = *(const PG8_LAS f32x4*)(gn + 32 * bj + 8 * fq + 4 * n);
            float kbar2_max = 0.f;
#pragma unroll
            for (int ai = 0; ai < 2; ++ai) {
                f32x4 cs[2][2];
#pragma unroll
                for (int bj = 0; bj < 2; ++bj) { cs[bj][0] = (f32x4){0.f, 0.f, 0.f, 0.f}; cs[bj][1] = (f32x4){0.f, 0.f, 0.f, 0.f}; }
#pragma unroll
                for (int m = 0; m < 4; ++m) {
                    float ss = 0.f;
#pragma unroll
                    for (int bj = 0; bj < 2; ++bj)
#pragma unroll
                        for (int n = 0; n < 2; ++n) { const f32x4 x = acc[ai][bj][m][n]; ss += (x[0] * x[0] + x[1] * x[1]) + (x[2] * x[2] + x[3] * x[3]); }
                    ss = sum_fq(ss);
                    const int row = row0 + ai * HALF + m * 16; float nn = 0.f;
                    const float r0 = r0s[ai][m];
                    const float r = rsqrtf(ss * (r0 * r0) * (1.f / 64.f) + EPS) * (r0 * sc);
#pragma unroll
                    for (int bj = 0; bj < 2; ++bj) {
                        const f32x4 v0 = acc[ai][bj][m][0] * r * g[bj][0], v1 = acc[ai][bj][m][1] * r * g[bj][1];
                        nn += (v0[0] * v0[0] + v0[1] * v0[1]) + (v0[2] * v0[2] + v0[3] * v0[3]) + (v1[0] * v1[0] + v1[1] * v1[1]) + (v1[2] * v1[2] + v1[3] * v1[3]);
                        if (!isq) { cs[bj][0] += v0; cs[bj][1] += v1; }
                        const u32x4 w = pack8(v0, v1);
                        if (isq) *(u32x4*)(Q + (size_t)row * AW + gidx * 64 + 32 * bj + 8 * fq) = w;
                        else *(u32x4*)(Kimg + (size_t)((gidx >> 1) * 256 + (row >> 6)) * 16384 + k_st(row & 63, (gidx & 1) * 64 + 32 * bj + 8 * fq)) = w;
                    }
                    nn = sum_fq(nn); nn_max = fmaxf(nn_max, nn);
                }
                if (!isq) {
                    float kb = 0.f;
#pragma unroll
                    for (int bj = 0; bj < 2; ++bj)
#pragma unroll
                        for (int n = 0; n < 2; ++n)
#pragma unroll
                            for (int e = 0; e < 4; ++e) { float c = cs[bj][n][e];
#pragma unroll
                                for (int o = 1; o < 16; o <<= 1) c += __shfl_xor(c, o);
                                kb += c * c; }
                    kb = sum_fq(kb);
                    kbar2_max = fmaxf(kbar2_max, kb * (1.f / 4096.f));
                }
            }
#pragma unroll
            for (int o = 1; o < 16; o <<= 1) nn_max = fmaxf(nn_max, __shfl_xor(nn_max, o));
            if ((threadIdx.x & 63) == 0) (void)__hip_atomic_fetch_max(nmax_lds + (isq ? 0 : 1), __float_as_uint(sqrtf(nn_max)), __ATOMIC_RELAXED, __HIP_MEMORY_SCOPE_WORKGROUP);
            if (!isq && (threadIdx.x & 63) == 0) (void)__hip_atomic_fetch_max(nmax_lds + 2, __float_as_uint(sqrtf(kbar2_max)), __ATOMIC_RELAXED, __HIP_MEMORY_SCOPE_WORKGROUP);
        } else if (u.pn < 6) {
#pragma unroll
            for (int ai = 0; ai < 2; ++ai)
#pragma unroll
                for (int m = 0; m < 4; ++m) { const int row = row0 + ai * HALF + m * 16; const float r0 = r0s[ai][m];
#pragma unroll
                    for (int bj = 0; bj < 2; ++bj) { const int h = (u.pn - 4) * 2 + bj;
                        *(u32x4*)(Vimg + (size_t)(h * 256 + (row >> 6)) * 16384 + v_st(row & 63, wc * 32 + 8 * fq)) = pack8(acc[ai][bj][m][0] * r0, acc[ai][bj][m][1] * r0); } }
        } else {
            const int ch0 = (u.pn - 6) * 128 + wc * 32 + 8 * fq;
#pragma unroll
            for (int ai = 0; ai < 2; ++ai)
#pragma unroll
                for (int m = 0; m < 4; ++m) { const int row = row0 + ai * HALF + m * 16; f32x4 v[2]; const float r0 = r0s[ai][m];
                    const float r2 = -LOG2E * r0, ir0 = __builtin_amdgcn_rcpf(r0);
#pragma unroll
                    for (int n = 0; n < 2; ++n) { const f32x4 a = acc[ai][0][m][n], gt = acc[ai][1][m][n];
                        const f32x4 t = gt * r2; const f32x4 ex = (f32x4){__builtin_amdgcn_exp2f(t[0]), __builtin_amdgcn_exp2f(t[1]), __builtin_amdgcn_exp2f(t[2]), __builtin_amdgcn_exp2f(t[3])};
                        const f32x4 den = ex * ir0 + ir0; v[n] = a * (f32x4){__builtin_amdgcn_rcpf(den[0]), __builtin_amdgcn_rcpf(den[1]), __builtin_amdgcn_rcpf(den[2]), __builtin_amdgcn_rcpf(den[3])}; }
                    *(u32x4*)(U + (size_t)row * CW + ch0) = pack8_f16(v[0], v[1]); }
        }
    }
};

template <bool F32BASE> struct EpiRes {
    static constexpr bool PERM = true, AFTER_DRAIN = false;
    const float* base; bf16_t* Xb; float* SS;
    __device__ __forceinline__ void operator()(const f32x4 (&acc)[2][2][4][2], const Unit& u, int wr, int wc, int fr, int fq) const {
        static_assert(!F32BASE, "the residual base is the bf16 stream");
        const int row0 = u.pm * BM + wr * 64 + fr, col0 = u.pn * BM + wc * 32 + 8 * fq;
        u32x4 bva[2][4][2];
#pragma unroll
        for (int ai = 0; ai < 2; ++ai)
#pragma unroll
            for (int m = 0; m < 4; ++m)
#pragma unroll
                for (int bj = 0; bj < 2; ++bj) bva[ai][m][bj] = *(const u32x4*)(Xb + (size_t)(row0 + ai * HALF + m * 16) * DM + col0 + bj * HALF);
        asm volatile("" :: "v"(bva[0][0][0]), "v"(bva[0][1][0]), "v"(bva[0][2][0]), "v"(bva[0][3][0]), "v"(bva[1][0][0]), "v"(bva[1][1][0]), "v"(bva[1][2][0]), "v"(bva[1][3][0]), "v"(bva[0][0][1]), "v"(bva[0][1][1]), "v"(bva[0][2][1]), "v"(bva[0][3][1]), "v"(bva[1][0][1]), "v"(bva[1][1][1]), "v"(bva[1][2][1]), "v"(bva[1][3][1]));
#pragma unroll
        for (int ai = 0; ai < 2; ++ai) {
#pragma unroll
            for (int m = 0; m < 4; ++m) { const int row = row0 + ai * HALF + m * 16; float ss = 0.f;
#pragma unroll
                for (int bj = 0; bj < 2; ++bj) { const size_t off = (size_t)row * DM + col0 + bj * HALF; const u32x4 b = bva[ai][m][bj];
                    f32x4 x0 = (f32x4){__builtin_bit_cast(float, b.x << 16), __builtin_bit_cast(float, b.x & 0xffff0000u), __builtin_bit_cast(float, b.y << 16), __builtin_bit_cast(float, b.y & 0xffff0000u)};
                    f32x4 x1 = (f32x4){__builtin_bit_cast(float, b.z << 16), __builtin_bit_cast(float, b.z & 0xffff0000u), __builtin_bit_cast(float, b.w << 16), __builtin_bit_cast(float, b.w & 0xffff0000u)};
                    x0 += acc[ai][bj][m][0]; x1 += acc[ai][bj][m][1];
                    ss += (x0[0] * x0[0] + x0[1] * x0[1]) + (x0[2] * x0[2] + x0[3] * x0[3]) + (x1[0] * x1[0] + x1[1] * x1[1]) + (x1[2] * x1[2] + x1[3] * x1[3]);
                    *(u32x4*)(Xb + off) = pack8(x0, x1); }
                ss = sum_fq(ss);
                if (fq == 0) SS[(size_t)row * 16 + u.pn * 4 + wc] = ss; }
        }
    }
};
__device__ __forceinline__ void row_rstd8(const float* SS, int row0, int fq, float (&rs)[2][4]) {
#pragma unroll
    for (int ai = 0; ai < 2; ++ai)
#pragma unroll
        for (int m = 0; m < 4; ++m) { const f32x4 t = *(const f32x4*)(SS + (size_t)(row0 + ai * HALF + m * 16) * 16 + 4 * fq); rs[ai][m] = (t[0] + t[1]) + (t[2] + t[3]); }
#pragma unroll
    for (int ai = 0; ai < 2; ++ai)
#pragma unroll
        for (int m = 0; m < 4; ++m) { float v = sum_fq(rs[ai][m]); rs[ai][m] = rsqrtf(v * (1.f / DM) + EPS); }
}
struct EpiGU {
    static constexpr bool PERM = true, AFTER_DRAIN = false;
    bf16_t* HM; const float* SS; const PG8_LAS float* rtab; int rtab_pm;
    __device__ __forceinline__ void operator()(const f32x4 (&acc)[2][2][4][2], const Unit& u, int wr, int wc, int fr, int fq) const {
        const int row0 = u.pm * BM + wr * 64 + fr, col0 = u.pn * HALF + wc * 32 + 8 * fq;
        float rs[2][4];
        if (u.pm == rtab_pm) {
#pragma unroll
            for (int ai = 0; ai < 2; ++ai)
#pragma unroll
                for (int m = 0; m < 4; ++m) rs[ai][m] = rtab[wr * 64 + fr + ai * HALF + m * 16];
        } else row_rstd8(SS, row0, fq, rs);
#pragma unroll
        for (int ai = 0; ai < 2; ++ai)
#pragma unroll
            for (int m = 0; m < 4; ++m) { const int row = row0 + ai * HALF + m * 16; const float r = rs[ai][m]; f32x4 v[2];
                const float r2 = -LOG2E * r, ir2 = __builtin_amdgcn_rcpf(r * r);
#pragma unroll
                for (int n = 0; n < 2; ++n) { const f32x4 gt = acc[ai][0][m][n], up = acc[ai][1][m][n];
                    const f32x4 t = gt * r2, gu = gt * up; f32x4 ex = (f32x4){__builtin_amdgcn_exp2f(t[0]), __builtin_amdgcn_exp2f(t[1]), __builtin_amdgcn_exp2f(t[2]), __builtin_amdgcn_exp2f(t[3])};
                    const f32x4 den = ex * ir2 + ir2; const f32x4 rc = (f32x4){__builtin_amdgcn_rcpf(den[0]), __builtin_amdgcn_rcpf(den[1]), __builtin_amdgcn_rcpf(den[2]), __builtin_amdgcn_rcpf(den[3])};
                    v[n] = gu * rc; }
                *(u32x4*)(HM + (size_t)row * FF + col0) = pack8(v[0], v[1]); }
    }
};
struct EpiPG {
    static constexpr bool PERM = true, AFTER_DRAIN = false;
    float* out; const bf16_t* Xb; const bf16_t* PR; const float* SS; const PG8_LAS float* rtab; int rtab_pm;
    __device__ __forceinline__ void operator()(const f32x4 (&acc)[2][2][4][2], const Unit& u, int wr, int wc, int fr, int fq) const {
        const int row0 = u.pm * BM + wr * 64 + fr, col0 = u.pn * BM + wc * 32 + 8 * fq;
        float rs[2][4];
        if (u.pm == rtab_pm) {
#pragma unroll
            for (int ai = 0; ai < 2; ++ai)
#pragma unroll
                for (int m = 0; m < 4; ++m) rs[ai][m] = rtab[wr * 64 + fr + ai * HALF + m * 16];
        } else row_rstd8(SS, row0, fq, rs);
#pragma unroll
        for (int ai = 0; ai < 2; ++ai) {
            u32x4 prv[4][2], xbv[4][2];
#pragma unroll
            for (int m = 0; m < 4; ++m)
#pragma unroll
                for (int bj = 0; bj < 2; ++bj) { const size_t off = (size_t)(row0 + ai * HALF + m * 16) * DM + col0 + bj * HALF; prv[m][bj] = *(const u32x4*)(PR + off); xbv[m][bj] = *(const u32x4*)(Xb + off); }
#pragma unroll
            for (int m = 0; m < 4; ++m) { const int row = row0 + ai * HALF + m * 16; const float r = rs[ai][m];
#pragma unroll
                for (int bj = 0; bj < 2; ++bj) { const size_t off = (size_t)row * DM + col0 + bj * HALF;
                    const u32x4 pr = prv[m][bj], xb = xbv[m][bj];
                    const float rl = -LOG2E * r;
                    const f32x4 t0 = acc[ai][bj][m][0] * rl, t1 = acc[ai][bj][m][1] * rl;
                    const f32x4 d0 = (f32x4){__builtin_amdgcn_exp2f(t0[0]), __builtin_amdgcn_exp2f(t0[1]), __builtin_amdgcn_exp2f(t0[2]), __builtin_amdgcn_exp2f(t0[3])} + 1.f;
                    const f32x4 d1 = (f32x4){__builtin_amdgcn_exp2f(t1[0]), __builtin_amdgcn_exp2f(t1[1]), __builtin_amdgcn_exp2f(t1[2]), __builtin_amdgcn_exp2f(t1[3])} + 1.f;
                    const f32x4 s0 = (f32x4){__builtin_amdgcn_rcpf(d0[0]), __builtin_amdgcn_rcpf(d0[1]), __builtin_amdgcn_rcpf(d0[2]), __builtin_amdgcn_rcpf(d0[3])}, s1 = (f32x4){__builtin_amdgcn_rcpf(d1[0]), __builtin_amdgcn_rcpf(d1[1]), __builtin_amdgcn_rcpf(d1[2]), __builtin_amdgcn_rcpf(d1[3])};
                    const f32x4 x0 = (f32x4){__builtin_bit_cast(float, xb.x << 16), __builtin_bit_cast(float, xb.x & 0xffff0000u), __builtin_bit_cast(float, xb.y << 16), __builtin_bit_cast(float, xb.y & 0xffff0000u)};
                    const f32x4 x1 = (f32x4){__builtin_bit_cast(float, xb.z << 16), __builtin_bit_cast(float, xb.z & 0xffff0000u), __builtin_bit_cast(float, xb.w << 16), __builtin_bit_cast(float, xb.w & 0xffff0000u)};
                    const f32x4 p0 = (f32x4){__builtin_bit_cast(float, pr.x << 16), __builtin_bit_cast(float, pr.x & 0xffff0000u), __builtin_bit_cast(float, pr.y << 16), __builtin_bit_cast(float, pr.y & 0xffff0000u)};
                    const f32x4 p1 = (f32x4){__builtin_bit_cast(float, pr.z << 16), __builtin_bit_cast(float, pr.z & 0xffff0000u), __builtin_bit_cast(float, pr.w << 16), __builtin_bit_cast(float, pr.w & 0xffff0000u)};
                    const f32x4 o0 = s0 * p0 + x0, o1 = s1 * p1 + x1;
                    __builtin_nontemporal_store(o0, (f32x4*)(out + off)); __builtin_nontemporal_store(o1, (f32x4*)(out + off + 4)); } }
        }
    }
};
struct HelperOrder {
    int G, c;
    __device__ __forceinline__ bool next(int i, Unit& u) const {
        const int h0 = G >> 1; if (c < h0) return false;
        if ((G & 15) == 0) {
            const int x = c & 7, rank = c >> 3, nr = G >> 3, r0 = nr >> 1, lu = (rank - r0) + (nr - r0) * i; if (lu >= 32) return false; u.pm = 8 * x + (lu >> 2); u.pn = lu & 3; return true; }
        const int L = (c - h0) + (G - h0) * i; if (L >= 256) return false; u.pm = L >> 2; u.pn = L & 3; return true; }
    __device__ __forceinline__ void a_ready(const Unit&) const {}
    __device__ __forceinline__ void done(const Unit&) const {}
};

template <class Epi, class Sched, bool ALIGN_EPI = false, bool SP2 = false>
__device__ __forceinline__ void gemm_phase(PG8_LAS unsigned char* lds, const Gemm g, const Sched& S, const Epi& E) {
    const int tid = threadIdx.x, wid = __builtin_amdgcn_readfirstlane(tid >> 6), lane = tid & 63, wr = wid >> 2, wc = wid & 3, fr = lane & 15, fq = lane >> 4;
    const int K = g.K, nt = K / BK;
    unsigned voffA[2], voffB[2];
#pragma unroll
    for (int i = 0; i < 2; ++i) { int R, C; stage_rc(tid * 16 + i * 8192, R, C); const int Rb = Epi::PERM ? ((R & ~31) + perm32(R & 31)) : R;
        voffA[i] = (unsigned)(R * K + C) * 2u; voffB[i] = (unsigned)(Rb * K + C) * 2u; }
    const size_t kstep = (size_t)(BK * 2);
    const size_t hstep = (size_t)HALF * K * 2;
    const size_t tstep = 2 * hstep;
    const unsigned ldsw = (unsigned)wid * 1024u;
    const int aoff = lds_byte(wr * 64 + fr, fq * 8), boff = lds_byte(wc * 32 + fr, fq * 8);
#define PG8_SA(b, h) (((b) * 2 + (h)) * HTB)
#define PG8_SB(b, h) ((4 + (b) * 2 + (h)) * HTB)
#define PG8_STAGE(bufoff, gbase, voff) do { _Pragma("unroll") for (int _i = 0; _i < 2; ++_i) \
        __builtin_amdgcn_global_load_lds((const unsigned*)((const char*)(gbase) + (voff)[_i]), (PG8_LAS unsigned*)(lds + (bufoff) + ldsw + _i * 8192), 16, 0, 0); } while (0)
#define PG8_LDA(dst, b, h) do { _Pragma("unroll") for (int m = 0; m < 4; ++m) _Pragma("unroll") for (int k = 0; k < 2; ++k) dst[m][k] = *(const PG8_LAS bf16x8*)(lds + PG8_SA(b, h) + aoff + m * 2048 + k * 1024); } while (0)
#define PG8_LDB(dst, b, h) do { _Pragma("unroll") for (int n = 0; n < 2; ++n) _Pragma("unroll") for (int k = 0; k < 2; ++k) dst[n][k] = *(const PG8_LAS bf16x8*)(lds + PG8_SB(b, h) + boff + n * 2048 + k * 1024); } while (0)
#define PG8_MMA(ai, bj, At, Bt) do { __builtin_amdgcn_s_setprio(1); _Pragma("unroll") for (int m = 0; m < 4; ++m) _Pragma("unroll") for (int n = 0; n < 2; ++n) _Pragma("unroll") for (int k = 0; k < 2; ++k) \
        acc[ai][bj][m][n] = __builtin_amdgcn_mfma_f32_16x16x32_bf16(Bt[n][k], At[m][k], acc[ai][bj][m][n], 0, 0, 0); __builtin_amdgcn_s_setprio(0); } while (0)
#define PG8_WAIT_V(n) asm volatile("s_waitcnt vmcnt(" #n ")" ::: "memory")
#define PG8_WAIT_L(n) asm volatile("s_waitcnt lgkmcnt(" #n ")" ::: "memory")
#define PG8_BAR __builtin_amdgcn_s_barrier()
#define PG8_SCHED __builtin_amdgcn_sched_barrier(0)
    Unit cur, nxt; int ui = 0;
    if (!S.next(0, cur)) return;
    f32x4 acc[2][2][4][2];
#pragma unroll
    for (int a = 0; a < 2; ++a)
#pragma unroll
        for (int b = 0; b < 2; ++b)
#pragma unroll
            for (int m = 0; m < 4; ++m)
#pragma unroll
                for (int n = 0; n < 2; ++n) acc[a][b][m][n] = (f32x4){0.f, 0.f, 0.f, 0.f};
    bf16x8 At[4][2], B0[2][2], B1[2][2];
    const char* cA = (const char*)g.A + (size_t)cur.pm * tstep; const char* cB = (const char*)g.Bt + (size_t)cur.pn * tstep;
    S.a_ready(cur);
    if constexpr (SP2) {
        PG8_STAGE(PG8_SB(0, 0), cB, voffB); PG8_STAGE(PG8_SB(0, 1), cB + hstep, voffB); PG8_STAGE(PG8_SA(0, 0), cA, voffA); PG8_STAGE(PG8_SA(0, 1), cA + hstep, voffA);
        if (wr == 1) PG8_BAR;
        PG8_WAIT_V(2); PG8_BAR;
        PG8_STAGE(PG8_SB(1, 0), cB + kstep, voffB); PG8_STAGE(PG8_SA(1, 0), cA + kstep, voffA); PG8_STAGE(PG8_SB(1, 1), cB + hstep + kstep, voffB);
        PG8_WAIT_V(6); PG8_BAR;
    } else {
        PG8_STAGE(PG8_SB(0, 0), cB, voffB); PG8_STAGE(PG8_SA(0, 0), cA, voffA); PG8_STAGE(PG8_SB(0, 1), cB + hstep, voffB); PG8_STAGE(PG8_SA(0, 1), cA + hstep, voffA);
        if (wr == 1) PG8_BAR;
        PG8_WAIT_V(4); PG8_BAR;
        PG8_STAGE(PG8_SB(1, 0), cB + kstep, voffB); PG8_STAGE(PG8_SA(1, 0), cA + kstep, voffA); PG8_STAGE(PG8_SB(1, 1), cB + hstep + kstep, voffB);
        PG8_WAIT_V(6); PG8_BAR;
    }
    for (;;) {
        const bool has_next = S.next(ui + 1, nxt);
        const char* nA = has_next ? (const char*)g.A + (size_t)nxt.pm * tstep : cA; const char* nB = has_next ? (const char*)g.Bt + (size_t)nxt.pn * tstep : cB;
        for (int t = 0; t < nt; t += 2) {
            const bool last = (t == nt - 2);
            const char* a1 = cA + (size_t)(t + 1) * kstep;
            const char* a2 = last ? nA : cA + (size_t)(t + 2) * kstep; const char* b2 = last ? nB : cB + (size_t)(t + 2) * kstep;
            const char* a3 = a2 + kstep; const char* b3 = b2 + kstep;
            if (last && has_next) S.a_ready(nxt);
            if constexpr (SP2) {
            PG8_LDB(B0, 0, 0); PG8_LDB(B1, 0, 1); PG8_SCHED; PG8_LDA(At, 0, 0); PG8_STAGE(PG8_SA(1, 1), a1 + hstep, voffA);
            PG8_WAIT_V(8); PG8_WAIT_L(0); PG8_BAR; PG8_MMA(0, 0, At, B0); PG8_MMA(0, 1, At, B1); PG8_BAR; PG8_SCHED;
            PG8_LDA(At, 0, 1); PG8_STAGE(PG8_SB(0, 0), b2, voffB); PG8_STAGE(PG8_SB(0, 1), b2 + hstep, voffB); PG8_STAGE(PG8_SA(0, 0), a2, voffA);
            PG8_WAIT_V(8); PG8_WAIT_L(0); PG8_BAR; PG8_MMA(1, 0, At, B0); PG8_MMA(1, 1, At, B1); PG8_BAR; PG8_SCHED;
            PG8_LDB(B0, 1, 0); PG8_LDB(B1, 1, 1); PG8_SCHED; PG8_LDA(At, 1, 0); PG8_STAGE(PG8_SA(0, 1), a2 + hstep, voffA);
            PG8_WAIT_V(8); PG8_WAIT_L(0); PG8_BAR; PG8_MMA(0, 0, At, B0); PG8_MMA(0, 1, At, B1); PG8_BAR; PG8_SCHED;
            PG8_LDA(At, 1, 1); PG8_STAGE(PG8_SB(1, 0), b3, voffB); PG8_STAGE(PG8_SB(1, 1), b3 + hstep, voffB); PG8_STAGE(PG8_SA(1, 0), a3, voffA);
            PG8_WAIT_V(8); PG8_WAIT_L(0); PG8_BAR; PG8_MMA(1, 0, At, B0); PG8_MMA(1, 1, At, B1); PG8_BAR; PG8_SCHED;
            } else {
            PG8_LDB(B0, 0, 0); PG8_SCHED; PG8_LDA(At, 0, 0); PG8_STAGE(PG8_SA(1, 1), a1 + hstep, voffA);
            PG8_WAIT_L(8); PG8_BAR; PG8_WAIT_L(0); PG8_MMA(0, 0, At, B0); PG8_BAR; PG8_SCHED;
            PG8_LDB(B1, 0, 1); PG8_STAGE(PG8_SB(0, 0), b2, voffB);
            PG8_BAR; PG8_WAIT_L(0); PG8_MMA(0, 1, At, B1); PG8_BAR;
            PG8_LDA(At, 0, 1); PG8_STAGE(PG8_SA(0, 0), a2, voffA);
            PG8_BAR; PG8_WAIT_L(0); PG8_MMA(1, 0, At, B0); PG8_BAR; PG8_SCHED;
            PG8_STAGE(PG8_SB(0, 1), b2 + hstep, voffB);
            PG8_WAIT_V(6); PG8_BAR; PG8_MMA(1, 1, At, B1); PG8_BAR;
            PG8_LDB(B0, 1, 0); PG8_SCHED; PG8_LDA(At, 1, 0); PG8_STAGE(PG8_SA(0, 1), a2 + hstep, voffA);
            PG8_WAIT_L(8); PG8_BAR; PG8_WAIT_L(0); PG8_MMA(0, 0, At, B0); PG8_BAR; PG8_SCHED;
            PG8_LDB(B1, 1, 1); PG8_STAGE(PG8_SB(1, 0), b3, voffB);
            PG8_BAR; PG8_WAIT_L(0); PG8_MMA(0, 1, At, B1); PG8_BAR;
            PG8_LDA(At, 1, 1); PG8_STAGE(PG8_SA(1, 0), a3, voffA);
            PG8_BAR; PG8_WAIT_L(0); PG8_MMA(1, 0, At, B0); PG8_BAR; PG8_SCHED;
            PG8_STAGE(PG8_SB(1, 1), b3 + hstep, voffB);
            PG8_WAIT_V(6); PG8_BAR; PG8_MMA(1, 1, At, B1); PG8_BAR;
            }
        }
        if constexpr (ALIGN_EPI) { if (wr == 0) PG8_BAR; }
        if constexpr (!Epi::AFTER_DRAIN) { E(acc, cur, wr, wc, fr, fq); S.done(cur); }
        if (!has_next) break;
#pragma unroll
        for (int a = 0; a < 2; ++a)
#pragma unroll
            for (int b = 0; b < 2; ++b)
#pragma unroll
                for (int m = 0; m < 4; ++m)
#pragma unroll
                    for (int n = 0; n < 2; ++n) acc[a][b][m][n] = (f32x4){0.f, 0.f, 0.f, 0.f};
        cur = nxt; cA = nA; cB = nB; ++ui;
        if constexpr (ALIGN_EPI) { if (wr == 1) PG8_BAR; }
    }
    PG8_WAIT_V(0);
    if constexpr (!ALIGN_EPI) { if (wr == 0) PG8_BAR; }
    PG8_BAR;
    if constexpr (Epi::AFTER_DRAIN) { E.fused(acc, cur, wr, wc, fr, fq, lds, wid, lane); S.done(cur); }
#undef PG8_SA
#undef PG8_SB
#undef PG8_STAGE
#undef PG8_LDA
#undef PG8_LDB
#undef PG8_MMA
#undef PG8_WAIT_V
#undef PG8_WAIT_L
#undef PG8_BAR
#undef PG8_SCHED
}
}

#ifndef PG8_SP2
#define PG8_SP2 true
#endif
#ifndef PG8_ALIGN
#define PG8_ALIGN true
#endif
#define GAS __attribute__((address_space(1)))
#define LAS __attribute__((address_space(3)))
typedef unsigned short bf16;
typedef unsigned v4u __attribute__((ext_vector_type(4)));
typedef float f32x4 __attribute__((ext_vector_type(4)));
typedef short bf16x8 __attribute__((ext_vector_type(8)));
typedef GAS unsigned gu32;
typedef GAS unsigned long long gu64;
#define RLX_AGENT __ATOMIC_RELAXED, __HIP_MEMORY_SCOPE_AGENT
#define LDS_WAIT() asm volatile("s_waitcnt lgkmcnt(0)" ::: "memory")
#define VM_WAIT() asm volatile("s_waitcnt vmcnt(0)" ::: "memory")
__device__ __forceinline__ unsigned long long rt() { return __builtin_amdgcn_s_memrealtime(); }
__device__ __forceinline__ unsigned f2bf(float f) { unsigned u = __builtin_bit_cast(unsigned, f); return (u + 0x7fffu + ((u >> 16) & 1u)) >> 16; }
__device__ __forceinline__ unsigned pk2(float lo, float hi) { return f2bf(lo) | (f2bf(hi) << 16); }

#define XB_TMO      128
#define XB_XCNT(j)  (256  + 64 * (j))
#define XB_XSUB(j)  (1280 + 64 * (j))
#define XB_XGEN(j)  (2304 + 64 * (j))
#define XB_TOP      3328
#define XB_TOPGEN   3392
#define XB_LSUB(j)  (3456 + 64 * (j))
#define XB_LGEN(j)  (4480 + 64 * (j))
#define XCD_BAR_WORDS 5504
#define XB_SPIN_CAP (1u << 18)

__device__ __forceinline__ unsigned xb_ld(unsigned* p)              { return __hip_atomic_load(p, __ATOMIC_RELAXED, __HIP_MEMORY_SCOPE_AGENT); }
__device__ __forceinline__ unsigned xb_add(unsigned* p, unsigned v) { return __hip_atomic_fetch_add(p, v, __ATOMIC_RELAXED, __HIP_MEMORY_SCOPE_AGENT); }
__device__ __forceinline__ unsigned xb_xcc_id() { return (unsigned)__builtin_amdgcn_s_getreg((3 << 11) | 20) & 0xFu; }
#define XB_SPIN(cond, bar) do { unsigned _sp = 0; while (cond) { __builtin_amdgcn_s_sleep(1); \
    if ((++_sp & 255u) == 0u) { if (xb_ld(&(bar)[XB_TMO])) break; if (_sp > XB_SPIN_CAP) { atomicAdd(&(bar)[XB_TMO], 1u); break; } } } } while (0)

struct XcdBarrier {
    unsigned* bar; unsigned x;
    volatile LAS unsigned* st;
};

__device__ __forceinline__ XcdBarrier xcd_barrier_post(unsigned* bar, volatile LAS unsigned* st) {
    XcdBarrier b; b.bar = bar; b.x = xb_xcc_id(); b.st = st;
    if (threadIdx.x == 0) st[2] = xb_add(&bar[XB_XCNT(b.x)], 1u);
    return b;
}
__device__ __forceinline__ void xcd_barrier_complete(unsigned* bar, unsigned x, unsigned& nloc, unsigned& nx, unsigned& uniform) {
    const unsigned G = gridDim.x * gridDim.y * gridDim.z;
    unsigned sum, cnt, mine, odd, sp = 0u;
    for (;;) {
        sum = 0u; cnt = 0u; mine = 0u; odd = 0u;
#pragma unroll
        for (unsigned j = 0; j < 16; ++j) { const unsigned c = xb_ld(&bar[XB_XCNT(j)]); sum += c; cnt += (c > 0u) ? 1u : 0u; mine = (j == x) ? c : mine; odd |= (j < 8u) ? (c * 8u != G ? 1u : 0u) : (c != 0u ? 1u : 0u); }
        if (sum == G) { uniform = odd ? 0u : 1u; break; }
        __builtin_amdgcn_s_sleep(1);
        if ((++sp & 255u) == 0u) { if (xb_ld(&bar[XB_TMO])) { uniform = 0u; break; } if (sp > XB_SPIN_CAP) { atomicAdd(&bar[XB_TMO], 1u); uniform = 0u; break; } }
    }
    nloc = mine > 0u ? mine : 1u; nx = cnt > 0u ? cnt : 1u;
}

__device__ __forceinline__ void xcd_barrier(const XcdBarrier& b) {
    asm volatile("s_waitcnt vmcnt(0)" ::: "memory");
    __syncthreads();
    if (threadIdx.x == 0) {
        unsigned* bar = b.bar;
        __builtin_amdgcn_s_waitcnt(0);
        unsigned nloc = b.st[0], nx = b.st[1];
        if (nloc == 0u) { unsigned uni = 0u; xcd_barrier_complete(bar, b.x, nloc, nx, uni); b.st[0] = nloc; b.st[1] = nx; b.st[3] = uni; }
        const unsigned old = xb_add(&bar[XB_XSUB(b.x)], 1u);
        const unsigned gen = old / nloc;
        if (old + 1u == (gen + 1u) * nloc) {
            __builtin_amdgcn_fence(__ATOMIC_RELEASE, "agent");
            asm volatile("s_waitcnt vmcnt(0)" ::: "memory");
            const unsigned og = xb_add(&bar[XB_TOP], 1u);
            const unsigned tg = og / nx;
            if (og + 1u == (tg + 1u) * nx) xb_add(&bar[XB_TOPGEN], 1u);
            else XB_SPIN(xb_ld(&bar[XB_TOPGEN]) == tg, bar);
            __builtin_amdgcn_fence(__ATOMIC_ACQUIRE, "agent");
            xb_add(&bar[XB_XGEN(b.x)], 1u);
            asm volatile("s_waitcnt vmcnt(0)" ::: "memory");
        } else {
            XB_SPIN(xb_ld(&bar[XB_XGEN(b.x)]) == gen, bar);
            __builtin_amdgcn_fence(__ATOMIC_ACQUIRE, "agent");
            asm volatile("s_waitcnt vmcnt(0)" ::: "memory");
        }
    }
    __syncthreads();
}

__device__ __forceinline__ void xcd_local_barrier(const XcdBarrier& b) {
    asm volatile("s_waitcnt vmcnt(0)" ::: "memory");
    __syncthreads();
    if (threadIdx.x == 0) {
        unsigned* bar = b.bar;
        __builtin_amdgcn_s_waitcnt(0);
        const unsigned nloc = b.st[0];
        const unsigned old = xb_add(&bar[XB_LSUB(b.x)], 1u);
        const unsigned gen = old / nloc;
        if (old + 1u == (gen + 1u) * nloc) (void)xb_add(&bar[XB_LGEN(b.x)], 1u);
        else XB_SPIN(xb_ld(&bar[XB_LGEN(b.x)]) == gen, bar);
        __builtin_amdgcn_fence(__ATOMIC_ACQUIRE, "agent");
        asm volatile("s_waitcnt vmcnt(0)" ::: "memory");
    }
    __syncthreads();
}


constexpr size_t MiB = 1u << 20;
constexpr size_t WS_CTL = 0, CTL_ZERO_BYTES = 1 * MiB;
constexpr size_t WS_WIN = 2 * MiB, WS_WOUT = 7 * MiB, WS_WGU = 9 * MiB, WS_WDN = 20 * MiB, WS_WPG = 26 * MiB, WS_WPP = 28 * MiB;
constexpr size_t WS_SS0 = 28 * MiB + 512 * 1024  , WS_SS1 = 29 * MiB, WS_SS2 = 30 * MiB;
constexpr size_t WS_XN = 32 * MiB;
constexpr size_t WS_Q = 64 * MiB, WS_KIMG = 80 * MiB, WS_VIMG = 96 * MiB, WS_U = 112 * MiB, WS_SLAB = 128 * MiB;
constexpr size_t WS_HM = 64 * MiB;
constexpr size_t WS_PB = 184 * MiB, WS_PROJ = 192 * MiB, WS_MIX = 224 * MiB, WS_END = 256 * MiB;
static_assert(WS_HM + (size_t)M * FF * 2 <= WS_PB && WS_SLAB + 56 * MiB <= WS_PB, "HM overlay");
constexpr int CW_TMO = 0, CW_CODE = 1, CW_QMAX = 32, CW_KMAX = 33, CW_KBAR = 34  , CW_QUEUE = 64, CW_UCNT = 1024  , CW_BAR = 4096;
constexpr int MAX_SPLIT_UNITS = 144;

constexpr int RING_OFF = 0, RING_BYTES = 131072;
constexpr int LDSCTL_OFF = RING_BYTES, MISC_OFF = LDSCTL_OFF + 320;
constexpr int LDS_BYTES = 147456;
constexpr int NWAVES = 8;

__device__ __forceinline__ float wave_sum(float v) {
#pragma unroll
    for (int o = 1; o < 64; o <<= 1) v += __shfl_xor(v, o);
    return v;
}
__device__ __forceinline__ float wave_max(float v) {
#pragma unroll
    for (int o = 1; o < 64; o <<= 1) v = fmaxf(v, __shfl_xor(v, o));
    return v;
}
__device__ __forceinline__ float bflo(unsigned w) { return __builtin_bit_cast(float, w << 16); }
__device__ __forceinline__ float bfhi(unsigned w) { return __builtin_bit_cast(float, w & 0xffff0000u); }

__device__ __forceinline__ void transpose_item(const float* W, int ldw, int K, bf16* WT, int k0, int n0, int dst0, LAS float* scr, int lane, const float* rowgain = nullptr) {
    float v[32];
#pragma unroll
    for (int i = 0; i < 32; ++i) { const int kk = 2 * i + (lane >> 5); v[i] = __builtin_nontemporal_load(&W[(size_t)(k0 + kk) * ldw + n0 + (lane & 31)]); }
    if (rowgain) {
#pragma unroll
        for (int i = 0; i < 32; ++i) v[i] *= rowgain[k0 + 2 * i + (lane >> 5)]; }
#pragma unroll
    for (int i = 0; i < 32; ++i) scr[(2 * i + (lane >> 5)) * 33 + (lane & 31)] = v[i];
    LDS_WAIT(); asm volatile("" ::: "memory");
    const int c = lane & 7;
#pragma unroll
    for (int j = 0; j < 4; ++j) { const int n = (lane >> 3) + 8 * j; const LAS float* s = scr + (8 * c) * 33 + n;
        v4u o; o.x = pk2(s[0 * 33], s[1 * 33]); o.y = pk2(s[2 * 33], s[3 * 33]); o.z = pk2(s[4 * 33], s[5 * 33]); o.w = pk2(s[6 * 33], s[7 * 33]);
        *(GAS v4u*)(WT + (size_t)(dst0 + n) * K + k0 + 8 * c) = o; }
    LDS_WAIT(); asm volatile("" ::: "memory");
}
__device__ __forceinline__ int in_dst_row(int s) {
    if (s < 1024) { const int part = s >> 9, sp = s & 511, tp = sp >> 8, sl = sp & 255, wc = sl >> 6, bj = (sl >> 5) & 1; return (part * 2 + tp) * 256 + 128 * bj + 32 * wc; }
    if (s < 1536) return s;
    if (s < 2048) { const int ch = s - 1536; return 1536 + 256 * (ch >> 7) + (ch & 127); }
    const int ch = s - 2048; return 1536 + 256 * (ch >> 7) + 128 + (ch & 127);
}
struct Args { const float* in[23]; float* out; unsigned char* ws; int ph_lo, ph_hi, li, pad; };

__device__ __forceinline__ void p0_prologue(const Args& a, LAS unsigned char* lds, int vcu, int G, int wave, int lane) {
    LAS float* scr = (LAS float*)(lds + RING_OFF + wave * 16384);
    const int gw = vcu * NWAVES + wave, NGW = G * NWAVES;
    unsigned char* ws = a.ws;
    constexpr int I_IN = 16 * 80, I_PP = 4 * 32;
    for (int it = gw; it < I_IN + I_PP; it += NGW) {
        if (it < I_IN) { const int kb = it / 80, nb = it % 80; transpose_item(a.in[3], NIN, DM, (bf16*)(ws + WS_WIN), 64 * kb, 32 * nb, in_dst_row(32 * nb), scr, lane, a.in[2]); }
        else { const int r = it - I_IN, kb = r / 32, nb = r % 32; transpose_item(a.in[22], DM, PD, (bf16*)(ws + WS_WPP), 64 * kb, 32 * nb, 32 * nb, scr, lane); }
    }
    const float* x = a.in[0]; const float* p = a.in[1];
    bf16* XN = (bf16*)(ws + WS_XN); bf16* PB = (bf16*)(ws + WS_PB); float* SS0 = (float*)(ws + WS_SS0);
    for (int m = gw; m < M; m += NGW) {
        const GAS f32x4* xr = (const GAS f32x4*)(x + (size_t)m * DM) + lane;
        f32x4 v[4]; float s = 0.f;
#pragma unroll
        for (int j = 0; j < 4; ++j) { v[j] = __builtin_nontemporal_load(&xr[64 * j]); s += (v[j].x * v[j].x + v[j].y * v[j].y) + (v[j].z * v[j].z + v[j].w * v[j].w); }
        GAS unsigned long long* o8 = (GAS unsigned long long*)(XN + (size_t)m * DM) + lane;
#pragma unroll
        for (int j = 0; j < 4; ++j) o8[64 * j] = (unsigned long long)pk2(v[j].x, v[j].y) | ((unsigned long long)pk2(v[j].z, v[j].w) << 32);
        const f32x4 pv = __builtin_nontemporal_load(&((const GAS f32x4*)(p + (size_t)m * PD))[lane]);
        ((GAS unsigned long long*)(PB + (size_t)m * PD))[lane] = (unsigned long long)pk2(pv.x, pv.y) | ((unsigned long long)pk2(pv.z, pv.w) << 32);
        s = wave_sum(s);
        if (lane == 0) SS0[m] = s;
    }
}
constexpr int WI_OUT = 16 * 32, WI_G = 16 * 88, WI_DN = 44 * 32, WI_PG = 16 * 32, W_ITEMS = WI_OUT + 2 * WI_G + WI_DN + WI_PG, N_W_UNITS = (W_ITEMS + 31) / 32;
__device__ __forceinline__ void weight_unit(int wu, const Args& a, LAS unsigned char* lds, int wave, int lane) {
    asm volatile("" : "+v"(lane));
    LAS float* scr = (LAS float*)(lds + RING_OFF + wave * 16384);
    unsigned char* ws = a.ws;
    for (int q = 0; q < 4; ++q) {
        asm volatile("" : "+v"(lane));
        int r = wu * 32 + wave * 4 + q; if (r >= W_ITEMS) break;
        if (r < WI_OUT) { const int kb = r / 32, nb = r % 32; transpose_item(a.in[15], DM, DM, (bf16*)(ws + WS_WOUT), 64 * kb, 32 * nb, 32 * nb, scr, lane); continue; } r -= WI_OUT;
        if (r < WI_G) { const int kb = r / 88, nb = r % 88, n0 = 32 * nb; transpose_item(a.in[17], FF, DM, (bf16*)(ws + WS_WGU), 64 * kb, n0, 256 * (n0 >> 7) + (n0 & 127), scr, lane, a.in[16]); continue; } r -= WI_G;
        if (r < WI_G) { const int kb = r / 88, nb = r % 88, n0 = 32 * nb; transpose_item(a.in[18], FF, DM, (bf16*)(ws + WS_WGU), 64 * kb, n0, 256 * (n0 >> 7) + 128 + (n0 & 127), scr, lane, a.in[16]); continue; } r -= WI_G;
        if (r < WI_DN) { const int kb = r / 32, nb = r % 32; transpose_item(a.in[19], DM, FF, (bf16*)(ws + WS_WDN), 64 * kb, 32 * nb, 32 * nb, scr, lane); continue; } r -= WI_DN;
        { const int kb = r / 32, nb = r % 32; transpose_item(a.in[21], DM, DM, (bf16*)(ws + WS_WPG), 64 * kb, 32 * nb, 32 * nb, scr, lane, a.in[20]); }
    }
    __syncthreads();
}

constexpr int CONV_W_LDS = 96 * 1024;
__device__ __forceinline__ void conv_unit(int cu, const bf16* U, const float* cw, const float* cb, const float* lg, const float* lb, bf16* MIX, LAS unsigned char* lds, int tid, int wave, int lane, bool& w_staged) {
    asm volatile("" : "+v"(tid), "+v"(lane));
    const int r0 = cu * 64;
    const f32x4 b0 = *(const f32x4*)(cb + 8 * lane), b1 = *(const f32x4*)(cb + 8 * lane + 4);
    const f32x4 g0 = *(const f32x4*)(lg + 8 * lane), g1 = *(const f32x4*)(lg + 8 * lane + 4), c0 = *(const f32x4*)(lb + 8 * lane), c1 = *(const f32x4*)(lb + 8 * lane + 4);
    if (!w_staged) {
        f32x4 wv[4][2];
#pragma unroll
        for (int k = 0; k < 4; ++k) { const int i = tid + 512 * k; if (i < KC * 64) { wv[k][0] = *(const f32x4*)(cw + 8 * i); wv[k][1] = *(const f32x4*)(cw + 8 * i + 4); } }
#pragma unroll
        for (int k = 0; k < 4; ++k) { const int i = tid + 512 * k; if (i < KC * 64) { v4u o;
            o.x = __builtin_bit_cast(unsigned, __builtin_amdgcn_cvt_pkrtz(wv[k][0].x, wv[k][0].y)); o.y = __builtin_bit_cast(unsigned, __builtin_amdgcn_cvt_pkrtz(wv[k][0].z, wv[k][0].w));
            o.z = __builtin_bit_cast(unsigned, __builtin_amdgcn_cvt_pkrtz(wv[k][1].x, wv[k][1].y)); o.w = __builtin_bit_cast(unsigned, __builtin_amdgcn_cvt_pkrtz(wv[k][1].z, wv[k][1].w));
            *(LAS v4u*)(lds + CONV_W_LDS + i * 16) = o; } }
        w_staged = true;
    }
    { v4u uv[12];
#pragma unroll
      for (int k = 0; k < 12; ++k) { const int i = tid + 512 * k, rr = i >> 6, pc = i & 63, r = r0 - 15 + rr, rc = r < 0 ? 0 : (r > M - 1 ? M - 1 : r);
          uv[k] = *(const GAS v4u*)(U + (size_t)rc * CW + pc * 8); }
#pragma unroll
      for (int k = 0; k < 12; ++k) { const int i = tid + 512 * k, rr = i >> 6, pc = i & 63, r = r0 - 15 + rr; const bool in = r >= 0 && r < M;
          v4u v = uv[k]; v.x = in ? v.x : 0u; v.y = in ? v.y : 0u; v.z = in ? v.z : 0u; v.w = in ? v.w : 0u;
          if (i < 94 * 64) *(LAS v4u*)(lds + rr * 1024 + pc * 16) = v; } }
    __syncthreads();
    typedef _Float16 h2 __attribute__((ext_vector_type(2)));
    h2 hacc[8][4];
    { const h2 i0 = __builtin_bit_cast(h2, __builtin_amdgcn_cvt_pkrtz(b0.x, b0.y)), i1 = __builtin_bit_cast(h2, __builtin_amdgcn_cvt_pkrtz(b0.z, b0.w)), i2 = __builtin_bit_cast(h2, __builtin_amdgcn_cvt_pkrtz(b1.x, b1.y)), i3 = __builtin_bit_cast(h2, __builtin_amdgcn_cvt_pkrtz(b1.z, b1.w));
#pragma unroll
      for (int j = 0; j < 8; ++j) { hacc[j][0] = i0; hacc[j][1] = i1; hacc[j][2] = i2; hacc[j][3] = i3; } }
    {
        typedef _Float16 h8 __attribute__((ext_vector_type(8)));
        const LAS unsigned char* ub = lds + (wave * 8) * 1024 + lane * 16; const LAS unsigned char* wb = lds + CONV_W_LDS + lane * 16;
        h8 uu[8];
#pragma unroll
        for (int j = 0; j < 7; ++j) uu[j] = *(const LAS h8*)(ub + j * 1024);
        h8 kw = *(const LAS h8*)(wb);
#pragma unroll
        for (int t = 0; t < KC; ++t) {
            uu[(t + 7) & 7] = *(const LAS h8*)(ub + (t + 7) * 1024);
            const h8 kwn = *(const LAS h8*)(wb + (t + 1 < KC ? t + 1 : t) * 1024);
            const h2 k0 = __builtin_shufflevector(kw, kw, 0, 1), k1 = __builtin_shufflevector(kw, kw, 2, 3), k2 = __builtin_shufflevector(kw, kw, 4, 5), k3 = __builtin_shufflevector(kw, kw, 6, 7);
#pragma unroll
            for (int j = 0; j < 8; ++j) { const h8 u = uu[(t + j) & 7];
                hacc[j][0] = __builtin_shufflevector(u, u, 0, 1) * k0 + hacc[j][0]; hacc[j][1] = __builtin_shufflevector(u, u, 2, 3) * k1 + hacc[j][1];
                hacc[j][2] = __builtin_shufflevector(u, u, 4, 5) * k2 + hacc[j][2]; hacc[j][3] = __builtin_shufflevector(u, u, 6, 7) * k3 + hacc[j][3]; }
            kw = kwn;
        }
    }
    float acc[8][8];
#pragma unroll
    for (int j = 0; j < 8; ++j)
#pragma unroll
        for (int k = 0; k < 4; ++k) { acc[j][2 * k] = (float)hacc[j][k][0]; acc[j][2 * k + 1] = (float)hacc[j][k][1]; }
#pragma unroll
    for (int j = 0; j < 8; ++j) {
        float s = ((acc[j][0] + acc[j][1]) + (acc[j][2] + acc[j][3])) + ((acc[j][4] + acc[j][5]) + (acc[j][6] + acc[j][7]));
        const float mu = wave_sum(s) * (1.f / CW); float q = 0.f;
#pragma unroll
        for (int e = 0; e < 8; ++e) { acc[j][e] -= mu; q += acc[j][e] * acc[j][e]; }
        const float r = rsqrtf(wave_sum(q) * (1.f / CW) + EPS);
        float z[8];
        z[0] = acc[j][0] * r * g0.x + c0.x; z[1] = acc[j][1] * r * g0.y + c0.y; z[2] = acc[j][2] * r * g0.z + c0.z; z[3] = acc[j][3] * r * g0.w + c0.w;
        z[4] = acc[j][4] * r * g1.x + c1.x; z[5] = acc[j][5] * r * g1.y + c1.y; z[6] = acc[j][6] * r * g1.z + c1.z; z[7] = acc[j][7] * r * g1.w + c1.w;
#pragma unroll
        for (int e = 0; e < 8; ++e) z[e] = z[e] * fsigmoid(z[e]);
        v4u o; o.x = pk2(z[0], z[1]); o.y = pk2(z[2], z[3]); o.z = pk2(z[4], z[5]); o.w = pk2(z[6], z[7]);
        *(GAS v4u*)(MIX + (size_t)(r0 + wave * 8 + j) * DM + AW + 8 * lane) = o;
    }
    __syncthreads();
}

namespace att {
typedef short bf16x8 __attribute__((ext_vector_type(8)));
typedef short s16x4 __attribute__((ext_vector_type(4)));
typedef float f32x16 __attribute__((ext_vector_type(16)));
typedef float f32x4 __attribute__((ext_vector_type(4)));
typedef unsigned u32x4 __attribute__((ext_vector_type(4)));
constexpr int LDS_HN = 8 * 16384 + 13312;
constexpr int SLOT = 16384, LDS_K = 0, LDS_V = 4 * SLOT, LDS_WS = 8 * SLOT + 4096  , XSTRIDE = 132, SLAB_FLOATS = 8 * 4160;
typedef __attribute__((address_space(3))) const char* lds_cptr;
typedef short v4i16_t __attribute__((ext_vector_type(4)));
__device__ __forceinline__ int crow(int r, int hi) { return (r & 3) + 8 * (r >> 2) + 4 * hi; }
__device__ __forceinline__ int x_idx(int lr, int col) { return lr * 128 + ((((col >> 2) ^ lr) & 31) << 2) + (col & 3); }
__device__ __forceinline__ void glds2k(const unsigned char* sbase, unsigned voff, unsigned lds_dst) { unsigned keep; const unsigned lds_dst2 = lds_dst + 1024u, voff2 = voff + 1024u;
    asm volatile("s_mov_b32 %0, m0\n\ts_mov_b32 m0, %3\n\ts_nop 0\n\tglobal_load_lds_dwordx4 %1, %2\n\ts_nop 0\n\ts_mov_b32 m0, %4\n\ts_nop 0\n\tglobal_load_lds_dwordx4 %5, %2\n\ts_nop 0\n\ts_mov_b32 m0, %0"
                 : "=&s"(keep) : "v"(voff), "s"(sbase), "s"(lds_dst), "s"(lds_dst2), "v"(voff2) : "memory"); }
#define ATT_WAIT_BAR(N) asm volatile("s_waitcnt vmcnt(" #N ") lgkmcnt(0)\n\ts_barrier" ::: "memory")
#define ATT_LDS_BAR() asm volatile("s_waitcnt lgkmcnt(0)\n\ts_barrier" ::: "memory")
__device__ __forceinline__ unsigned cvtpk(float lo, float hi) { unsigned r; asm volatile("v_cvt_pk_bf16_f32 %0, %1, %2" : "=v"(r) : "v"(lo), "v"(hi)); return r; }
__device__ __forceinline__ int v_rd_base(int lane) { return ((lane >> 4) & 1) * 32 + (lane & 3) * 8 + (4 * (lane >> 5) + ((lane & 15) >> 2)) * 64; }
__device__ __forceinline__ s16x4 vtr(lds_cptr p) { return __builtin_bit_cast(s16x4, __builtin_amdgcn_ds_read_tr16_b64_v4i16((__attribute__((address_space(3))) v4i16_t*)p)); }
#define SBAR() __builtin_amdgcn_sched_barrier(0)
__device__ __forceinline__ void qkt_acc(f32x16& p0, f32x16& p1, lds_cptr kp, const bf16x8* qr) {
#pragma unroll
    for (int d0 = 0; d0 < 4; ++d0) {
        const bf16x8 b0 = *(const __attribute__((address_space(3))) bf16x8*)(kp + d0 * 2048);
        const bf16x8 b1 = *(const __attribute__((address_space(3))) bf16x8*)(kp + d0 * 2048 + 512);
        p0 = __builtin_amdgcn_mfma_f32_32x32x16_bf16(b0, qr[d0], p0, 0, 0, 0);
        p1 = __builtin_amdgcn_mfma_f32_32x32x16_bf16(b1, qr[d0], p1, 0, 0, 0);
    }
}
__device__ __forceinline__ void bias_general(f32x16& p0, f32x16& p1, float dq, float nslope2, float shift2) {
#pragma unroll
    for (int r = 0; r < 16; ++r) { const float c = (float)((r & 3) + 8 * (r >> 2)); p0[r] = __builtin_fmaf(nslope2, __builtin_fabsf(dq - c), -shift2); p1[r] = __builtin_fmaf(nslope2, __builtin_fabsf(dq - (c + 32.f)), -shift2); }
}
__device__ __forceinline__ void softmax_first(f32x16& p0, f32x16& p1, bf16x8& pa0, bf16x8& pa1, bf16x8& pa2) {
#pragma unroll
    for (int r = 0; r < 16; ++r) { p0[r] = __builtin_amdgcn_exp2f(p0[r]); p1[r] = __builtin_amdgcn_exp2f(p1[r]); }
    { u32x4 w = {cvtpk(p0[0], p0[1]), cvtpk(p0[2], p0[3]), cvtpk(p0[4], p0[5]), cvtpk(p0[6], p0[7])}; pa0 = __builtin_bit_cast(bf16x8, w); }
    { u32x4 w = {cvtpk(p0[8], p0[9]), cvtpk(p0[10], p0[11]), cvtpk(p0[12], p0[13]), cvtpk(p0[14], p0[15])}; pa1 = __builtin_bit_cast(bf16x8, w); }
    { u32x4 w = {cvtpk(p1[0], p1[1]), cvtpk(p1[2], p1[3]), cvtpk(p1[4], p1[5]), cvtpk(p1[6], p1[7])}; pa2 = __builtin_bit_cast(bf16x8, w); }
}
template <int KBITS> __device__ __forceinline__ float fmamk_s(float a, float c) { float r; asm("v_fmamk_f32 %0, %1, %2, %3" : "=v"(r) : "v"(a), "n"(KBITS), "v"(c)); return r; }
#define ATT_ROT3(x) do { (x) = ((x) + SLOT) & (4 * SLOT - 1); } while (0)
#define ATT_DMA2(src, tile, dstoff) do { int t_ = (tile); t_ = t_ < t_hi ? t_ : t_hi; glds2k((src) + (size_t)t_ * SLOT, lane16, (unsigned)(dstoff)); } while (0)
#define ATT_ISSUE_DMA() do { ATT_DMA2(ksrc, tj + 4, kdst + sk_dma); ATT_DMA2(vsrc, tj + 2, vdst + sv_dma); ++tj; } while (0)
#define ATT_STEP(P0, P1, X0, X1, DO_EXP, DO_QK, JJ) do { \
    if (lead_half || (JJ) == 0) { ATT_WAIT_BAR(4); } \
    ATT_ISSUE_DMA(); \
    { const lds_cptr vb_ = vp0 + sv_cur; const lds_cptr kb_ = kp0 + sk_cur; \
      s16x4 vl0, vh0, vl1, vh1, vl2, vh2; bf16x8 kf0, kf1, kf2; unsigned t0_, t1_, t2_, t3_; \
      const int k02_ = (tj + 1) * 64  ; const bool right_ = k02_ >= qw0 + 31, mixed_ = !right_ && (k02_ + 63 > qw0); \
      const float dq2_ = dq1 - 64.f, ss_ = right_ ? nslope2 : -nslope2, xl0_ = __builtin_fmaf(-ss_, dq2_, -shift2), xl1_ = __builtin_fmaf(ss_, 32.f, xl0_); \
      vl0 = vtr(vb_ + 0); vh0 = vtr(vb_ + 512); vl1 = vtr(vb_ + 4096); vh1 = vtr(vb_ + 4608); SBAR(); \
      vl2 = vtr(vb_ + 8192); vh2 = vtr(vb_ + 8704); o[0] = __builtin_amdgcn_mfma_f32_32x32x16_bf16(pa0, (bf16x8){vl0[0], vl0[1], vl0[2], vl0[3], vh0[0], vh0[1], vh0[2], vh0[3]}, o[0], 0, 0, 0); if (DO_EXP) { X0[0] = __builtin_amdgcn_exp2f(X0[0]); } t0_ = cvtpk(P1[8], P1[9]); t1_ = cvtpk(P1[10], P1[11]); SBAR(); \
      vl0 = vtr(vb_ + 12288); vh0 = vtr(vb_ + 12800); o[1] = __builtin_amdgcn_mfma_f32_32x32x16_bf16(pa0, (bf16x8){vl1[0], vl1[1], vl1[2], vl1[3], vh1[0], vh1[1], vh1[2], vh1[3]}, o[1], 0, 0, 0); if (DO_EXP) { X0[1] = __builtin_amdgcn_exp2f(X0[1]); } t2_ = cvtpk(P1[12], P1[13]); t3_ = cvtpk(P1[14], P1[15]); { u32x4 w_ = {t0_, t1_, t2_, t3_}; pa3 = __builtin_bit_cast(bf16x8, w_); } SBAR(); \
      vl1 = vtr(vb_ + 1024); vh1 = vtr(vb_ + 1536); o[2] = __builtin_amdgcn_mfma_f32_32x32x16_bf16(pa0, (bf16x8){vl2[0], vl2[1], vl2[2], vl2[3], vh2[0], vh2[1], vh2[2], vh2[3]}, o[2], 0, 0, 0); if (DO_EXP) { X0[2] = __builtin_amdgcn_exp2f(X0[2]); } if (DO_EXP) { X0[3] = __builtin_amdgcn_exp2f(X0[3]); } SBAR(); \
      vl2 = vtr(vb_ + 5120); vh2 = vtr(vb_ + 5632); o[3] = __builtin_amdgcn_mfma_f32_32x32x16_bf16(pa0, (bf16x8){vl0[0], vl0[1], vl0[2], vl0[3], vh0[0], vh0[1], vh0[2], vh0[3]}, o[3], 0, 0, 0); lacc4 = __builtin_amdgcn_mfma_f32_16x16x32_bf16(lmask, pa0, lacc4, 0, 0, 0); if (DO_EXP) { X0[4] = __builtin_amdgcn_exp2f(X0[4]); } if (DO_QK) { P0[0] = fmamk_s<0>(ss_, xl0_); } if (DO_QK) { P0[1] = fmamk_s<1065353216>(ss_, xl0_); } if (DO_QK) { P0[2] = fmamk_s<1073741824>(ss_, xl0_); } SBAR(); \
      vl0 = vtr(vb_ + 9216); vh0 = vtr(vb_ + 9728); o[0] = __builtin_amdgcn_mfma_f32_32x32x16_bf16(pa1, (bf16x8){vl1[0], vl1[1], vl1[2], vl1[3], vh1[0], vh1[1], vh1[2], vh1[3]}, o[0], 0, 0, 0); if (DO_EXP) { X0[5] = __builtin_amdgcn_exp2f(X0[5]); } if (DO_QK) { P0[3] = fmamk_s<1077936128>(ss_, xl0_); } if (DO_QK) { P0[4] = fmamk_s<1090519040>(ss_, xl0_); } SBAR(); \
      vl1 = vtr(vb_ + 13312); vh1 = vtr(vb_ + 13824); o[1] = __builtin_amdgcn_mfma_f32_32x32x16_bf16(pa1, (bf16x8){vl2[0], vl2[1], vl2[2], vl2[3], vh2[0], vh2[1], vh2[2], vh2[3]}, o[1], 0, 0, 0); if (DO_EXP) { X0[6] = __builtin_amdgcn_exp2f(X0[6]); } if (DO_EXP) { X0[7] = __builtin_amdgcn_exp2f(X0[7]); } if (DO_QK) { P0[5] = fmamk_s<1091567616>(ss_, xl0_); } if (DO_QK) { P0[6] = fmamk_s<1092616192>(ss_, xl0_); } if (DO_QK) { P0[7] = fmamk_s<1093664768>(ss_, xl0_); } SBAR(); \
      vl2 = vtr(vb_ + 2048); vh2 = vtr(vb_ + 2560); o[2] = __builtin_amdgcn_mfma_f32_32x32x16_bf16(pa1, (bf16x8){vl0[0], vl0[1], vl0[2], vl0[3], vh0[0], vh0[1], vh0[2], vh0[3]}, o[2], 0, 0, 0); if (DO_EXP) { X0[8] = __builtin_amdgcn_exp2f(X0[8]); } if (DO_EXP) { t0_ = cvtpk(X0[0], X0[1]); t1_ = cvtpk(X0[2], X0[3]); } if (DO_QK) { P0[8] = fmamk_s<1098907648>(ss_, xl0_); } if (DO_QK) { P0[9] = fmamk_s<1099431936>(ss_, xl0_); } SBAR(); \
      vl0 = vtr(vb_ + 6144); vh0 = vtr(vb_ + 6656); o[3] = __builtin_amdgcn_mfma_f32_32x32x16_bf16(pa1, (bf16x8){vl1[0], vl1[1], vl1[2], vl1[3], vh1[0], vh1[1], vh1[2], vh1[3]}, o[3], 0, 0, 0); lacc4 = __builtin_amdgcn_mfma_f32_16x16x32_bf16(lmask, pa1, lacc4, 0, 0, 0); if (DO_EXP) { X0[9] = __builtin_amdgcn_exp2f(X0[9]); } if (DO_EXP) { t2_ = cvtpk(X0[4], X0[5]); t3_ = cvtpk(X0[6], X0[7]); { u32x4 w_ = {t0_, t1_, t2_, t3_}; pa0 = __builtin_bit_cast(bf16x8, w_); } } if (DO_QK) { P0[10] = fmamk_s<1099956224>(ss_, xl0_); } if (DO_QK) { P0[11] = fmamk_s<1100480512>(ss_, xl0_); } if (DO_QK) { P0[12] = fmamk_s<1103101952>(ss_, xl0_); } SBAR(); \
      vl1 = vtr(vb_ + 10240); vh1 = vtr(vb_ + 10752); o[0] = __builtin_amdgcn_mfma_f32_32x32x16_bf16(pa2, (bf16x8){vl2[0], vl2[1], vl2[2], vl2[3], vh2[0], vh2[1], vh2[2], vh2[3]}, o[0], 0, 0, 0); if (DO_EXP) { X0[10] = __builtin_amdgcn_exp2f(X0[10]); } if (DO_EXP) { X0[11] = __builtin_amdgcn_exp2f(X0[11]); } if (DO_QK) { P0[13] = fmamk_s<1103626240>(ss_, xl0_); } if (DO_QK) { P0[14] = fmamk_s<1104150528>(ss_, xl0_); } SBAR(); \
      vl2 = vtr(vb_ + 14336); vh2 = vtr(vb_ + 14848); o[1] = __builtin_amdgcn_mfma_f32_32x32x16_bf16(pa2, (bf16x8){vl0[0], vl0[1], vl0[2], vl0[3], vh0[0], vh0[1], vh0[2], vh0[3]}, o[1], 0, 0, 0); if (DO_EXP) { X0[12] = __builtin_amdgcn_exp2f(X0[12]); } if (DO_QK) { P0[15] = fmamk_s<1104674816>(ss_, xl0_); } if (DO_QK) { P1[0] = fmamk_s<0>(ss_, xl1_); } if (DO_QK) { P1[1] = fmamk_s<1065353216>(ss_, xl1_); } SBAR(); \
      vl0 = vtr(vb_ + 3072); vh0 = vtr(vb_ + 3584); o[2] = __builtin_amdgcn_mfma_f32_32x32x16_bf16(pa2, (bf16x8){vl1[0], vl1[1], vl1[2], vl1[3], vh1[0], vh1[1], vh1[2], vh1[3]}, o[2], 0, 0, 0); if (DO_EXP) { X0[13] = __builtin_amdgcn_exp2f(X0[13]); } if (DO_QK) { P1[2] = fmamk_s<1073741824>(ss_, xl1_); } if (DO_QK) { P1[3] = fmamk_s<1077936128>(ss_, xl1_); } SBAR(); \
      vl1 = vtr(vb_ + 7168); vh1 = vtr(vb_ + 7680); o[3] = __builtin_amdgcn_mfma_f32_32x32x16_bf16(pa2, (bf16x8){vl2[0], vl2[1], vl2[2], vl2[3], vh2[0], vh2[1], vh2[2], vh2[3]}, o[3], 0, 0, 0); lacc4 = __builtin_amdgcn_mfma_f32_16x16x32_bf16(lmask, pa2, lacc4, 0, 0, 0); if (DO_EXP) { X0[14] = __builtin_amdgcn_exp2f(X0[14]); } if (DO_EXP) { X0[15] = __builtin_amdgcn_exp2f(X0[15]); } if (DO_QK) { P1[4] = fmamk_s<1090519040>(ss_, xl1_); } if (DO_QK) { P1[5] = fmamk_s<1091567616>(ss_, xl1_); } if (DO_QK) { P1[6] = fmamk_s<1092616192>(ss_, xl1_); } SBAR(); \
      if (!lead_half && (JJ) + 1 < NT) { ATT_WAIT_BAR(4); }     \
      vl2 = vtr(vb_ + 11264); vh2 = vtr(vb_ + 11776); o[0] = __builtin_amdgcn_mfma_f32_32x32x16_bf16(pa3, (bf16x8){vl0[0], vl0[1], vl0[2], vl0[3], vh0[0], vh0[1], vh0[2], vh0[3]}, o[0], 0, 0, 0); if (DO_EXP) { X1[0] = __builtin_amdgcn_exp2f(X1[0]); } if (DO_EXP) { t0_ = cvtpk(X0[8], X0[9]); t1_ = cvtpk(X0[10], X0[11]); } if (DO_QK) { P1[7] = fmamk_s<1093664768>(ss_, xl1_); } if (DO_QK) { P1[8] = fmamk_s<1098907648>(ss_, xl1_); } SBAR(); \
      vl0 = vtr(vb_ + 15360); vh0 = vtr(vb_ + 15872); o[1] = __builtin_amdgcn_mfma_f32_32x32x16_bf16(pa3, (bf16x8){vl1[0], vl1[1], vl1[2], vl1[3], vh1[0], vh1[1], vh1[2], vh1[3]}, o[1], 0, 0, 0); if (DO_EXP) { X1[1] = __builtin_amdgcn_exp2f(X1[1]); } if (DO_EXP) { t2_ = cvtpk(X0[12], X0[13]); t3_ = cvtpk(X0[14], X0[15]); { u32x4 w_ = {t0_, t1_, t2_, t3_}; pa1 = __builtin_bit_cast(bf16x8, w_); } } if (DO_QK) { P1[9] = fmamk_s<1099431936>(ss_, xl1_); } if (DO_QK) { P1[10] = fmamk_s<1099956224>(ss_, xl1_); } if (DO_QK) { P1[11] = fmamk_s<1100480512>(ss_, xl1_); } SBAR(); \
      if (DO_QK) kf0 = *(const __attribute__((address_space(3))) bf16x8*)(kb_ + 0); o[2] = __builtin_amdgcn_mfma_f32_32x32x16_bf16(pa3, (bf16x8){vl2[0], vl2[1], vl2[2], vl2[3], vh2[0], vh2[1], vh2[2], vh2[3]}, o[2], 0, 0, 0); if (DO_EXP) { X1[2] = __builtin_amdgcn_exp2f(X1[2]); } if (DO_EXP) { X1[3] = __builtin_amdgcn_exp2f(X1[3]); } if (DO_QK) { P1[12] = fmamk_s<1103101952>(ss_, xl1_); } if (DO_QK) { P1[13] = fmamk_s<1103626240>(ss_, xl1_); } SBAR(); \
      if (DO_QK) kf1 = *(const __attribute__((address_space(3))) bf16x8*)(kb_ + 512); o[3] = __builtin_amdgcn_mfma_f32_32x32x16_bf16(pa3, (bf16x8){vl0[0], vl0[1], vl0[2], vl0[3], vh0[0], vh0[1], vh0[2], vh0[3]}, o[3], 0, 0, 0); lacc4 = __builtin_amdgcn_mfma_f32_16x16x32_bf16(lmask, pa3, lacc4, 0, 0, 0); if (DO_EXP) { X1[4] = __builtin_amdgcn_exp2f(X1[4]); } if (DO_QK) { P1[14] = fmamk_s<1104150528>(ss_, xl1_); } if (DO_QK) { P1[15] = fmamk_s<1104674816>(ss_, xl1_); } SBAR(); if (DO_QK && mixed_) { const float c2_ = -2.f * nslope2; P0[0] += c2_ * __builtin_fminf(dq2_ - 0.f, 0.f); P0[1] += c2_ * __builtin_fminf(dq2_ - 1.f, 0.f); P0[2] += c2_ * __builtin_fminf(dq2_ - 2.f, 0.f); P0[3] += c2_ * __builtin_fminf(dq2_ - 3.f, 0.f); P0[4] += c2_ * __builtin_fminf(dq2_ - 8.f, 0.f); P0[5] += c2_ * __builtin_fminf(dq2_ - 9.f, 0.f); P0[6] += c2_ * __builtin_fminf(dq2_ - 10.f, 0.f); P0[7] += c2_ * __builtin_fminf(dq2_ - 11.f, 0.f); P0[8] += c2_ * __builtin_fminf(dq2_ - 16.f, 0.f); P0[9] += c2_ * __builtin_fminf(dq2_ - 17.f, 0.f); P0[10] += c2_ * __builtin_fminf(dq2_ - 18.f, 0.f); P0[11] += c2_ * __builtin_fminf(dq2_ - 19.f, 0.f); P0[12] += c2_ * __builtin_fminf(dq2_ - 24.f, 0.f); P0[13] += c2_ * __builtin_fminf(dq2_ - 25.f, 0.f); P0[14] += c2_ * __builtin_fminf(dq2_ - 26.f, 0.f); P0[15] += c2_ * __builtin_fminf(dq2_ - 27.f, 0.f); P1[0] += c2_ * __builtin_fminf(dq2_ - 32.f, 0.f); P1[1] += c2_ * __builtin_fminf(dq2_ - 33.f, 0.f); P1[2] += c2_ * __builtin_fminf(dq2_ - 34.f, 0.f); P1[3] += c2_ * __builtin_fminf(dq2_ - 35.f, 0.f); P1[4] += c2_ * __builtin_fminf(dq2_ - 40.f, 0.f); P1[5] += c2_ * __builtin_fminf(dq2_ - 41.f, 0.f); P1[6] += c2_ * __builtin_fminf(dq2_ - 42.f, 0.f); P1[7] += c2_ * __builtin_fminf(dq2_ - 43.f, 0.f); P1[8] += c2_ * __builtin_fminf(dq2_ - 48.f, 0.f); P1[9] += c2_ * __builtin_fminf(dq2_ - 49.f, 0.f); P1[10] += c2_ * __builtin_fminf(dq2_ - 50.f, 0.f); P1[11] += c2_ * __builtin_fminf(dq2_ - 51.f, 0.f); P1[12] += c2_ * __builtin_fminf(dq2_ - 56.f, 0.f); P1[13] += c2_ * __builtin_fminf(dq2_ - 57.f, 0.f); P1[14] += c2_ * __builtin_fminf(dq2_ - 58.f, 0.f); P1[15] += c2_ * __builtin_fminf(dq2_ - 59.f, 0.f); } SBAR(); \
      if (DO_QK) kf2 = *(const __attribute__((address_space(3))) bf16x8*)(kb_ + 2048); if (DO_QK) P0 = __builtin_amdgcn_mfma_f32_32x32x16_bf16(kf0, qr[0], P0, 0, 0, 0); if (DO_EXP) { X1[5] = __builtin_amdgcn_exp2f(X1[5]); } SBAR(); \
      if (DO_QK) kf0 = *(const __attribute__((address_space(3))) bf16x8*)(kb_ + 2560); if (DO_QK) P1 = __builtin_amdgcn_mfma_f32_32x32x16_bf16(kf1, qr[0], P1, 0, 0, 0); if (DO_EXP) { X1[6] = __builtin_amdgcn_exp2f(X1[6]); } if (DO_EXP) { X1[7] = __builtin_amdgcn_exp2f(X1[7]); } SBAR(); \
      if (DO_QK) kf1 = *(const __attribute__((address_space(3))) bf16x8*)(kb_ + 4096); if (DO_QK) P0 = __builtin_amdgcn_mfma_f32_32x32x16_bf16(kf2, qr[1], P0, 0, 0, 0); if (DO_EXP) { X1[8] = __builtin_amdgcn_exp2f(X1[8]); } if (DO_EXP) { t0_ = cvtpk(X1[0], X1[1]); t1_ = cvtpk(X1[2], X1[3]); } SBAR(); \
      if (DO_QK) kf2 = *(const __attribute__((address_space(3))) bf16x8*)(kb_ + 4608); if (DO_QK) P1 = __builtin_amdgcn_mfma_f32_32x32x16_bf16(kf0, qr[1], P1, 0, 0, 0); if (DO_EXP) { X1[9] = __builtin_amdgcn_exp2f(X1[9]); } if (DO_EXP) { t2_ = cvtpk(X1[4], X1[5]); t3_ = cvtpk(X1[6], X1[7]); { u32x4 w_ = {t0_, t1_, t2_, t3_}; pa2 = __builtin_bit_cast(bf16x8, w_); } } SBAR(); \
      if (DO_QK) kf0 = *(const __attribute__((address_space(3))) bf16x8*)(kb_ + 6144); if (DO_QK) P0 = __builtin_amdgcn_mfma_f32_32x32x16_bf16(kf1, qr[2], P0, 0, 0, 0); if (DO_EXP) { X1[10] = __builtin_amdgcn_exp2f(X1[10]); } if (DO_EXP) { X1[11] = __builtin_amdgcn_exp2f(X1[11]); } SBAR(); \
      if (DO_QK) kf1 = *(const __attribute__((address_space(3))) bf16x8*)(kb_ + 6656); if (DO_QK) P1 = __builtin_amdgcn_mfma_f32_32x32x16_bf16(kf2, qr[2], P1, 0, 0, 0); if (DO_EXP) { X1[12] = __builtin_amdgcn_exp2f(X1[12]); } SBAR(); \
      if (DO_QK) P0 = __builtin_amdgcn_mfma_f32_32x32x16_bf16(kf0, qr[3], P0, 0, 0, 0); if (DO_EXP) { X1[13] = __builtin_amdgcn_exp2f(X1[13]); } SBAR(); \
      if (DO_QK) P1 = __builtin_amdgcn_mfma_f32_32x32x16_bf16(kf1, qr[3], P1, 0, 0, 0); if (DO_EXP) { X1[14] = __builtin_amdgcn_exp2f(X1[14]); } if (DO_EXP) { X1[15] = __builtin_amdgcn_exp2f(X1[15]); } SBAR(); \
    } \
    dq1 -= 64.f; ATT_ROT3(sk_cur); ATT_ROT3(sv_cur); ATT_ROT3(sk_dma); ATT_ROT3(sv_dma); } while (0)

struct UnitDesc { int u, h, qb, nc, ci, sid, t_lo, t_hi; float slope; };
constexpr int ITEM_FROM_PRE = 8192 - 1024;
__device__ __forceinline__ float att_window(float Bn, float Cn, float slope) {
    const float a1 = 2.f * Bn + 18.2f, a2 = Bn + Cn + 63.f * slope + __logf(1.f / (64.f * slope)) + 18.2f;
    return (ATT_EXACT_ZERO ? 104.f + 2.f * Bn : fminf(a1, a2)) / slope;
}
__device__ __forceinline__ UnitDesc decode_unit(int idx, float Bn, float Cn, const __attribute__((address_space(3))) unsigned short* pre, const __attribute__((address_space(3))) unsigned short* sidx) {
    UnitDesc d;
    const unsigned it_ = (unsigned)__builtin_amdgcn_readfirstlane((int)((const __attribute__((address_space(3))) unsigned*)((const __attribute__((address_space(3))) unsigned char*)pre + ITEM_FROM_PRE))[idx]);
    d.u = (int)(it_ & 511u); d.ci = (int)((it_ >> 10) & 3u); d.nc = (int)((it_ >> 12) & 3u); d.sid = __builtin_amdgcn_readfirstlane((int)sidx[d.u]);
    const int k = d.u & 127; d.h = 3 - (d.u >> 7); d.qb = (k & 1) ? 63 - (k >> 1) : 64 + (k >> 1);
    d.slope = __uint_as_float((unsigned)(127 - 2 * (d.h + 1)) << 23);
    d.t_lo = (int)((it_ >> 14) & 255u); d.t_hi = (int)((it_ >> 22) & 255u);
    return d;
}
__device__ __forceinline__ void attn_unit(int idx, float Bn, float Cn, float lam, const __attribute__((address_space(3))) unsigned short* pre, const __attribute__((address_space(3))) unsigned short* sidx,
                                          const unsigned short* Q, const unsigned char* Kimg, const unsigned char* Vimg, unsigned short* MIX, const float* hn, char* shm,
                                          float* slabs, unsigned* cnts, volatile __attribute__((address_space(3))) unsigned* bcast,
                                          unsigned nx_idx, int n_att, int& kpre, bf16x8 (&qpre)[4]) {
    const int tid = threadIdx.x, lane = tid & 63, r32 = lane & 31, hi = lane >> 5; const int wid = __builtin_amdgcn_readfirstlane(tid >> 6), rg = wid >> 1, mp = wid & 1;
    const bool warm = (kpre == idx);
    const UnitDesc D = decode_unit(idx, Bn, Cn, pre, sidx);
    const int h = D.h, t_lo = D.t_lo, t_hi = D.t_hi; const float slope2 = D.slope * LOG2E;
    const float shift2 = fmaxf(0.f, Bn * LOG2E - 24.f);
    const int q0 = D.qb * 128, NT = t_hi - t_lo + 1;
    const unsigned lds0 = (unsigned)(uintptr_t)shm;
    const unsigned char* ksrc = Kimg + (size_t)h * 256 * SLOT + wid * 2048;
    const unsigned char* vsrc = Vimg + (size_t)h * 256 * SLOT + wid * 2048;
    const unsigned lane16 = (unsigned)lane * 16u;
    const unsigned kdst = lds0 + LDS_K + wid * 2048, vdst = lds0 + LDS_V + wid * 2048;
    const unsigned short* Qw = Q + (size_t)(q0 + rg * 32 + r32) * AW + h * 128 + mp * 64 + hi * 8;
    bf16x8 qr[4];
    int tj = t_lo;
    if (warm) {
#pragma unroll
        for (int d0 = 0; d0 < 4; ++d0) qr[d0] = qpre[d0];
        ATT_DMA2(ksrc, tj + 3, kdst + 3 * SLOT); ATT_DMA2(vsrc, tj + 1, vdst + SLOT);
    } else {
#pragma unroll
        for (int d0 = 0; d0 < 4; ++d0) asm volatile("global_load_dwordx4 %0, %1, off" : "=v"(qr[d0]) : "v"(Qw + d0 * 16) : "memory");
        ATT_DMA2(ksrc, tj, kdst); ATT_DMA2(ksrc, tj + 1, kdst + SLOT); ATT_DMA2(vsrc, tj, vdst); ATT_DMA2(ksrc, tj + 2, kdst + 2 * SLOT); ATT_DMA2(ksrc, tj + 3, kdst + 3 * SLOT); ATT_DMA2(vsrc, tj + 1, vdst + SLOT);
    }
    const lds_cptr shm3 = (lds_cptr)shm;
    const lds_cptr kp0 = shm3 + LDS_K + (8 * mp + hi) * 1024 + r32 * 16;
    const lds_cptr vp0 = shm3 + LDS_V + v_rd_base(lane);
    const float dq0 = (float)(q0 + rg * 32 + r32 - t_lo * 64 - 4 * hi);
    const int qw0 = q0 + rg * 32;
    const float nslope2 = -slope2;
    f32x16 o[4]; o[0] = f32x16{}; o[1] = f32x16{}; o[2] = f32x16{}; o[3] = f32x16{};
    f32x4 lacc4 = f32x4{0.f, 0.f, 0.f, 0.f};
    bf16x8 lmask; { const int row_ = lane & 15, kg_ = lane >> 4; const bool on_ = (((row_ & 7) == 0) && ((kg_ & 1) == 0)) || (((row_ & 7) == 4) && ((kg_ & 1) == 1));
                    const short one_ = on_ ? (short)0x3F80 : (short)0; lmask = (bf16x8){one_, one_, one_, one_, one_, one_, one_, one_}; }
    f32x16 sA0, sA1, sB0, sB1; bf16x8 pa0, pa1, pa2, pa3 = bf16x8{};
    bias_general(sA0, sA1, dq0, nslope2, shift2);
    bias_general(sB0, sB1, dq0 - 64.f, nslope2, shift2);
    if (warm) { ATT_WAIT_BAR(4); } else { ATT_WAIT_BAR(8); }
    SBAR();
    qkt_acc(sA0, sA1, kp0, qr);
    qkt_acc(sB0, sB1, kp0 + SLOT, qr);
    softmax_first(sA0, sA1, pa0, pa1, pa2);
    float dq1 = dq0 - 64.f;
    int sk_cur = 2 * SLOT, sv_cur = 0, sk_dma = 0, sv_dma = 2 * SLOT;
    const bool lead_half = wid < 4;
    if (wid >= 4) __builtin_amdgcn_s_setprio(1);
    int j = 0;
    for (; j + 2 < NT; j += 2) { ATT_STEP(sA0, sA1, sB0, sB1, true, true, j); ATT_STEP(sB0, sB1, sA0, sA1, true, true, j + 1); }
    if (NT - j == 2) { ATT_STEP(sA0, sA1, sB0, sB1, true, true, j);
#pragma unroll
        for (int r = 8; r < 16; ++r) sA1[r] = sB1[r];
        ATT_STEP(sA0, sA1, sB0, sB1, false, false, j + 1); }
    else { ATT_STEP(sA0, sA1, sB0, sB1, false, false, j); }
    __builtin_amdgcn_s_setprio(0);
    float l_acc = lacc4[0];
    if (tid == 0) bcast[1] = nx_idx;
    ATT_WAIT_BAR(0);
    { int tid_n = threadIdx.x; asm volatile("" : "+v"(tid_n));
      const int nidx = __builtin_amdgcn_readfirstlane((int)bcast[1]);
      kpre = -1;
#pragma unroll
      for (int d0 = 0; d0 < 4; ++d0) qpre[d0] = bf16x8{};
      if (nidx < n_att) {
          const int lane_n = tid_n & 63, wid_n = __builtin_amdgcn_readfirstlane(tid_n >> 6);
          const UnitDesc Nn = decode_unit(nidx, Bn, Cn, pre, sidx);
          const unsigned char* ks_n = Kimg + (size_t)Nn.h * 256 * SLOT + wid_n * 2048; const unsigned char* vs_n = Vimg + (size_t)Nn.h * 256 * SLOT + wid_n * 2048;
          const unsigned l16_n = (unsigned)lane_n * 16u, kd_n = (unsigned)(uintptr_t)shm + LDS_K + wid_n * 2048, vd_n = (unsigned)(uintptr_t)shm + LDS_V + wid_n * 2048;
          const int c1 = Nn.t_lo + 1 < Nn.t_hi ? Nn.t_lo + 1 : Nn.t_hi, c2 = Nn.t_lo + 2 < Nn.t_hi ? Nn.t_lo + 2 : Nn.t_hi;
          glds2k(ks_n + (size_t)Nn.t_lo * SLOT, l16_n, kd_n); glds2k(ks_n + (size_t)c1 * SLOT, l16_n, kd_n + SLOT); glds2k(vs_n + (size_t)Nn.t_lo * SLOT, l16_n, vd_n); glds2k(ks_n + (size_t)c2 * SLOT, l16_n, kd_n + 2 * SLOT);
          const unsigned short* Qn = Q + (size_t)(Nn.qb * 128 + (wid_n >> 1) * 32 + (lane_n & 31)) * AW + Nn.h * 128 + (wid_n & 1) * 64 + (lane_n >> 5) * 8;
#pragma unroll
          for (int d0 = 0; d0 < 4; ++d0) asm volatile("global_load_dwordx4 %0, %1, off" : "=v"(qpre[d0]) : "v"(Qn + d0 * 16) : "memory");
          kpre = nidx;
      } }
    int idx_e = idx; asm volatile("" : "+s"(idx_e));
    int tid_e = threadIdx.x; asm volatile("" : "+v"(tid_e));
    const int lane_e = tid_e & 63, r32_e = lane_e & 31, hi_e = lane_e >> 5, wid_e = __builtin_amdgcn_readfirstlane(tid_e >> 6), rg_e = wid_e >> 1, mp_e = wid_e & 1;
    const UnitDesc E = decode_unit(idx_e, Bn, Cn, pre, sidx);
    const int nc = E.nc, ci = E.ci, h_e = E.h, q0_e = E.qb * 128;
    float* slab_u = slabs + (size_t)E.sid * 3 * SLAB_FLOATS; unsigned* cnt_u = cnts + E.u;
    if (nc > 1) {
        float* sl = slab_u + (size_t)ci * SLAB_FLOATS + wid_e * 4160;
#pragma unroll
        for (int d0 = 0; d0 < 4; ++d0)
#pragma unroll
            for (int i = 0; i < 4; ++i) { const f32x4 v_ = (f32x4){o[d0][4 * i], o[d0][4 * i + 1], o[d0][4 * i + 2], o[d0][4 * i + 3]};
                asm volatile("global_store_dwordx4 %0, %1, off sc1\n\ts_nop 1" :: "v"(sl + ((d0 * 4 + i) * 64 + lane_e) * 4), "v"(v_) : "memory"); }
        asm volatile("global_store_dword %0, %1, off sc1\n\ts_nop 1" :: "v"(sl + 4096 + lane_e), "v"(l_acc) : "memory");
        asm volatile("s_waitcnt vmcnt(0)" ::: "memory");
        __syncthreads();
        if (tid_e == 0) bcast[0] = __hip_atomic_fetch_add(cnt_u, 1u, __ATOMIC_RELAXED, __HIP_MEMORY_SCOPE_AGENT);
        __syncthreads();
        const unsigned old = bcast[0];
        __syncthreads();
        if ((int)old != nc - 1) return;
        if (tid_e == 0) { __builtin_amdgcn_fence(__ATOMIC_ACQUIRE, "agent"); asm volatile("s_waitcnt vmcnt(0)" ::: "memory"); }
        __syncthreads();
        o[0] = f32x16{}; o[1] = f32x16{}; o[2] = f32x16{}; o[3] = f32x16{}; l_acc = 0.f;
        for (int cc = 0; cc < nc; ++cc) { const float* rs = slab_u + (size_t)cc * SLAB_FLOATS + wid_e * 4160;
            f32x4 sv[16];
#pragma unroll
            for (int k = 0; k < 16; ++k) sv[k] = *(const f32x4*)(rs + (k * 64 + lane_e) * 4);
            const float sl_l = rs[4096 + lane_e];
            asm volatile("" :: "v"(sv[0]), "v"(sv[1]), "v"(sv[2]), "v"(sv[3]), "v"(sv[4]), "v"(sv[5]), "v"(sv[6]), "v"(sv[7]), "v"(sv[8]), "v"(sv[9]), "v"(sv[10]), "v"(sv[11]), "v"(sv[12]), "v"(sv[13]), "v"(sv[14]), "v"(sv[15]));
#pragma unroll
            for (int d0 = 0; d0 < 4; ++d0)
#pragma unroll
                for (int i = 0; i < 4; ++i) { const f32x4 v = sv[d0 * 4 + i]; o[d0][4 * i] += v[0]; o[d0][4 * i + 1] += v[1]; o[d0][4 * i + 2] += v[2]; o[d0][4 * i + 3] += v[3]; }
            l_acc += sl_l; }
    }
    float* wsf = (float*)(shm + LDS_WS) + wid_e * 64;
    if (hi_e == 0) wsf[r32_e] = l_acc;
    asm volatile("s_waitcnt lgkmcnt(0)" ::: "memory");
    float rli[16];
#pragma unroll
    for (int r = 0; r < 16; ++r) rli[r] = __builtin_amdgcn_rcpf(wsf[crow(r, hi_e)]);
    float* X = (float*)(shm + (rg_e == 0 ? LDS_K + 3 * SLOT : LDS_V + rg_e * SLOT));
    if (mp_e == 1) {
#pragma unroll
        for (int r = 0; r < 16; ++r)
#pragma unroll
            for (int d0 = 0; d0 < 4; ++d0) X[x_idx(crow(r, hi_e), d0 * 32 + r32_e)] = lam * o[d0][r] * rli[r];
    }
    ATT_LDS_BAR();
    if (mp_e == 0) {
#pragma unroll
        for (int r = 0; r < 16; ++r)
#pragma unroll
            for (int d0 = 0; d0 < 4; ++d0) { float* xp = X + x_idx(crow(r, hi_e), d0 * 32 + r32_e); *xp = o[d0][r] * rli[r] - *xp; }
        asm volatile("s_waitcnt lgkmcnt(0)" ::: "memory");
        f32x4 v[16]; float ss = 0.f;
#pragma unroll
        for (int i = 0; i < 16; ++i) { v[i] = *(const f32x4*)(X + x_idx(r32_e, hi_e * 64 + 4 * i)); ss += (v[i][0] * v[i][0] + v[i][1] * v[i][1]) + (v[i][2] * v[i][2] + v[i][3] * v[i][3]); }
        { auto rr = __builtin_amdgcn_permlane32_swap(__float_as_uint(ss), __float_as_uint(ss), false, false); ss = __uint_as_float(rr[0]) + __uint_as_float(rr[1]); }
        const float rn = rsqrtf(ss * (1.f / 128.f) + EPS) * (1.f - LAM_INIT);
        unsigned short* orow = MIX + (size_t)(q0_e + rg_e * 32 + r32_e) * DM + h_e * 128 + hi_e * 64;
        const __attribute__((address_space(3))) f32x4* g = (const __attribute__((address_space(3))) f32x4*)((lds_cptr)shm + LDS_HN + hi_e * 256);
#pragma unroll
        for (int i = 0; i < 8; ++i) { const f32x4 g0 = g[2 * i], g1 = g[2 * i + 1]; const f32x4 a = v[2 * i] * rn * g0, b = v[2 * i + 1] * rn * g1;
            u32x4 w; w.x = cvtpk(a[0], a[1]); w.y = cvtpk(a[2], a[3]); w.z = cvtpk(b[0], b[1]); w.w = cvtpk(b[2], b[3]); *(u32x4*)(orow + 8 * i) = w; }
    }
    ATT_LDS_BAR();
}
}

constexpr int N_LAUNCHES = MK_N_LAUNCHES, PER_PHASE = 7;
constexpr int N_ATT_UNITS = NH * (M / 128), N_CONV_UNITS = M / 64;

__global__ void __launch_bounds__(NWAVES * 64, 2) fwd(Args args) {
    extern __shared__ __attribute__((aligned(16))) unsigned char lds_raw[];
    LAS unsigned char* lds = (LAS unsigned char*)lds_raw;
    volatile LAS unsigned* MISC = (volatile LAS unsigned*)(lds + MISC_OFF);
    const int tid = threadIdx.x, lane = tid & 63, wave = __builtin_amdgcn_readfirstlane(tid >> 6);
    const int G = gridDim.x; const int bx = blockIdx.x; const int vcu = (G % 8 == 0) ? (bx % 8) * (G / 8) + bx / 8 : bx;
    unsigned char* ws = args.ws;
    gu32* ctl = (gu32*)(ws + WS_CTL);
    for (int u = tid; u < (LDS_BYTES - LDSCTL_OFF) / 4; u += NWAVES * 64) ((LAS unsigned*)(lds + LDSCTL_OFF))[u] = 0u;
    __syncthreads();
    XcdBarrier bar; bar.bar = (unsigned*)(ctl + CW_BAR); bar.x = 0; bar.st = nullptr;
    if (N_LAUNCHES != PER_PHASE) bar = xcd_barrier_post((unsigned*)(ctl + CW_BAR), MISC + 8);
#define GRID_BAR() do { if (N_LAUNCHES != PER_PHASE) xcd_barrier(bar); } while (0)
    const int lo = args.ph_lo, hi = args.ph_hi;
#define IN(k) (lo <= (k) && (k) < hi)
#define BOTH(k) (IN(k) && IN((k) + 1))
    bf16* XN = (bf16*)(ws + WS_XN); bf16* Qb = (bf16*)(ws + WS_Q); unsigned char* Kimg = ws + WS_KIMG; unsigned char* Vimg = ws + WS_VIMG; bf16* Ub = (bf16*)(ws + WS_U);
    bf16* MIX = (bf16*)(ws + WS_MIX); bf16* HM = (bf16*)(ws + WS_HM); bf16* PB = (bf16*)(ws + WS_PB); bf16* PR = (bf16*)(ws + WS_PROJ);
    float* SS1 = (float*)(ws + WS_SS1); float* SS2 = (float*)(ws + WS_SS2);

    if (IN(0)) { p0_prologue(args, lds, vcu, G, wave, lane); if (BOTH(0)) GRID_BAR(); }
    int vc = bx; bool xl = false;
    if (N_LAUNCHES == 1 && IN(0)) { xl = __builtin_amdgcn_readfirstlane((int)MISC[11]) != 0; if (xl) vc = (int)bar.x + 8 * __builtin_amdgcn_readfirstlane((int)MISC[10]); }
#define XCD_BAR() do { if (N_LAUNCHES != PER_PHASE) { if (xl) xcd_local_barrier(bar); else xcd_barrier(bar); } } while (0)

    constexpr int NT1 = (M / 256) * (NIN / 256);
    const int first_idle = NT1 - ((NT1 + G - 1) / G - 1) * G, w_p1 = (N_LAUNCHES == 1) ? ((G - first_idle) < N_W_UNITS ? (G - first_idle) : N_W_UNITS) : 0, w_p2 = N_W_UNITS - w_p1;
    if (IN(1)) {
        { pg8::Gemm g{XN, (const bf16*)(ws + WS_WIN), M, NIN, DM}; pg8::StaticOrder S; S.init(M, NIN, G, bx);
          LAS float* rtab = (LAS float*)(lds + LDSCTL_OFF + 12288); int rpm = -1;
          LAS float* gtab = (LAS float*)(lds + LDSCTL_OFF + 13824);
          if (tid >= 256 && tid < 384) gtab[tid - 256] = tid < 320 ? args.in[4][tid - 256] : args.in[5][tid - 320];
          { pg8::Unit u0; if (S.next(0, u0)) { rpm = u0.pm; if (tid < 256) rtab[tid] = rsqrtf(((const float*)(ws + WS_SS0))[rpm * 256 + tid] * (1.f / DM) + EPS); } __syncthreads(); }
          pg8::EpiIn E{Qb, Kimg, Vimg, Ub, args.in[4], args.in[5], (unsigned*)(ctl + CW_QMAX), (const float*)(ws + WS_SS0), rtab, rpm, gtab, (LAS unsigned*)(lds + LDSCTL_OFF + 14400)};
          pg8::gemm_phase<pg8::EpiIn, pg8::StaticOrder, PG8_ALIGN, PG8_SP2>(lds + RING_OFF, g, S, E);
          __syncthreads();
          if (tid < 3) { const unsigned v = ((LAS unsigned*)(lds + LDSCTL_OFF + 14400))[tid]; if (v) atomicMax((unsigned*)(ctl + CW_QMAX) + tid, v); } }
        if (w_p1 > 0 && bx >= first_idle && bx - first_idle < w_p1) weight_unit(bx - first_idle, args, lds, wave, lane);
        if (BOTH(1)) GRID_BAR();
    }

    if (IN(2)) {
        const unsigned mx3 = __hip_atomic_load((unsigned*)(ctl + CW_QMAX) + (lane < 3 ? lane : 0), __ATOMIC_RELAXED, __HIP_MEMORY_SCOPE_AGENT);
        const float qmax = __uint_as_float(__builtin_amdgcn_readlane(mx3, 0)), kmax = __uint_as_float(__builtin_amdgcn_readlane(mx3, 1)), kbar = __uint_as_float(__builtin_amdgcn_readlane(mx3, 2));
        const float Bn = qmax * kmax * (1.02f / LOG2E);
        const float Cn = qmax * kbar * (1.02f / LOG2E) + 0.05f;
        const float d1 = wave_sum(args.in[6][lane] * args.in[7][lane]), d2 = wave_sum(args.in[8][lane] * args.in[9][lane]);
        const float lam = __expf(d1) - __expf(d2) + LAM_INIT;
        LAS unsigned short* pre = (LAS unsigned short*)(lds + LDSCTL_OFF + 1024);
        LAS unsigned short* sidx = (LAS unsigned short*)(lds + LDSCTL_OFF + 2112);
        LAS unsigned* wtot = (LAS unsigned*)(lds + LDSCTL_OFF + 3200);
        if (tid < 128) ((LAS float*)(lds + att::LDS_HN))[tid] = args.in[10][tid];
        { const int u = tid, h = 3 - (u >> 7), k = u & 127, qb = (k & 1) ? 63 - (k >> 1) : 64 + (k >> 1);
          const float slope = exp2f(-2.f * (float)(h + 1));
          const float Rf = att::att_window(Bn, Cn, slope);
          const int R = Rf < 20000.f ? (int)Rf + 1 : 20000;
          const int q0 = qb * 128; const int klo = q0 - R < 0 ? 0 : q0 - R, khi = q0 + 127 + R > M - 1 ? M - 1 : q0 + 127 + R;
          const int my_nt = (khi >> 6) - (klo >> 6) + 1, want = my_nt > 100 ? 1 : 0;
          int v = want;
#pragma unroll
          for (int o = 1; o < 64; o <<= 1) { const int t = __shfl_up(v, o); if (lane >= o) v += t; }
          if (lane == 63) wtot[wave] = (unsigned)v;
          __syncthreads();
          int off = 0;
          for (int w = 0; w < wave; ++w) off += (int)wtot[w];
          const int sid = off + v - want;
          const int my_nc = (want && sid < MAX_SPLIT_UNITS) ? ((my_nt + 63) / 64 < 3 ? (my_nt + 63) / 64 : 3) : 1;
          sidx[u] = (unsigned short)sid;
          v = my_nc;
#pragma unroll
          for (int o = 1; o < 64; o <<= 1) { const int t = __shfl_up(v, o); if (lane >= o) v += t; }
          if (lane == 63) wtot[8 + wave] = (unsigned)v;
          __syncthreads();
          off = 0;
          for (int w = 0; w < wave; ++w) off += (int)wtot[8 + w];
          pre[u] = (unsigned short)(off + v - my_nc);
          if (u == 511) pre[512] = (unsigned short)(off + v);
          { LAS unsigned* item = (LAS unsigned*)(lds + LDSCTL_OFF + 8192);
            const int tlo_ = klo >> 6, base_ = my_nt / my_nc, rem_ = my_nt - base_ * my_nc;
            for (int ci = 0; ci < my_nc; ++ci) { const int t0_ = tlo_ + ci * base_ + (ci < rem_ ? ci : rem_), t1_ = t0_ + base_ + (ci < rem_ ? 1 : 0) - 1;
                item[off + v - my_nc + ci] = (unsigned)u | ((unsigned)ci << 10) | ((unsigned)my_nc << 12) | ((unsigned)t0_ << 14) | ((unsigned)t1_ << 22); } }
          __syncthreads(); }
        const int n_att = (int)pre[512];
        unsigned* slabs_cnt = (unsigned*)(ctl + CW_UCNT);
        bool conv_w_staged = false;
        unsigned nx = 0;
        int kpre = -1; att::bf16x8 qpre[4] = {};
        if (tid == 0) nx = __hip_atomic_fetch_add(ctl + CW_QUEUE, 1u, __ATOMIC_RELAXED, __HIP_MEMORY_SCOPE_AGENT);
        for (;;) {
            if (tid == 0) MISC[16] = nx;
            ATT_LDS_BAR();
            const int idx = __builtin_amdgcn_readfirstlane((int)MISC[16]);
            ATT_LDS_BAR();
            if (idx >= n_att + w_p2 + N_CONV_UNITS) break;
            if (tid == 0) nx = __hip_atomic_fetch_add(ctl + CW_QUEUE, 1u, __ATOMIC_RELAXED, __HIP_MEMORY_SCOPE_AGENT);
            if (idx < n_att) {
                att::attn_unit(idx, Bn, Cn, lam, pre, sidx, Qb, Kimg, Vimg, MIX, args.in[10], (char*)lds_raw, (float*)(ws + WS_SLAB), slabs_cnt, MISC + 17, nx, n_att, kpre, qpre);
            } else if (idx < n_att + w_p2) {
                weight_unit(w_p1 + idx - n_att, args, lds, wave, lane);
                qpre[0] = att::bf16x8{}; qpre[1] = att::bf16x8{}; qpre[2] = att::bf16x8{}; qpre[3] = att::bf16x8{};
            } else {
                conv_unit(idx - n_att - w_p2, Ub, args.in[11], args.in[12], args.in[13], args.in[14], MIX, lds, tid, wave, lane, conv_w_staged);
                qpre[0] = att::bf16x8{}; qpre[1] = att::bf16x8{}; qpre[2] = att::bf16x8{}; qpre[3] = att::bf16x8{};
            }
        }
        if (BOTH(2)) GRID_BAR();
    }

    if (IN(3)) {
        pg8::Gemm g{MIX, (const bf16*)(ws + WS_WOUT), M, DM, DM}; pg8::StaticOrder S; S.init(M, DM, G, vc);
        pg8::EpiRes<false> E{nullptr, XN, SS1};
        pg8::gemm_phase<pg8::EpiRes<false>, pg8::StaticOrder, PG8_ALIGN, PG8_SP2>(lds + RING_OFF, g, S, E);
        if (BOTH(3)) XCD_BAR();
    }
    if (IN(4)) {
        { pg8::Gemm g{XN, (const bf16*)(ws + WS_WGU), M, 2 * FF, DM}; pg8::StaticOrder S; S.init(M, 2 * FF, G, vc);
          LAS float* rtab = (LAS float*)(lds + LDSCTL_OFF + 12288); int rpm = -1;
          { pg8::Unit u0; if (S.next(0, u0)) { rpm = u0.pm; if (tid < 256) { const f32x4* sp = (const f32x4*)(SS1 + (size_t)(rpm * 256 + tid) * 16); const f32x4 a = sp[0], b = sp[1], c = sp[2], d = sp[3];
                rtab[tid] = rsqrtf((((a[0] + a[1]) + (a[2] + a[3])) + ((b[0] + b[1]) + (b[2] + b[3])) + ((c[0] + c[1]) + (c[2] + c[3])) + ((d[0] + d[1]) + (d[2] + d[3]))) * (1.f / DM) + EPS); } } __syncthreads(); }
          pg8::EpiGU E{HM, SS1, rtab, rpm};
          pg8::gemm_phase<pg8::EpiGU, pg8::StaticOrder, PG8_ALIGN, PG8_SP2>(lds + RING_OFF, g, S, E); }
        { int kproj = PD; asm volatile("" : "+s"(kproj));
          pg8::Gemm g{PB, (const bf16*)(ws + WS_WPP), M, DM, kproj}; pg8::HelperOrder S{G, vc};
          pg8::EpiBf16 E{PR, DM};
          pg8::gemm_phase<pg8::EpiBf16, pg8::HelperOrder, PG8_ALIGN, PG8_SP2>(lds + RING_OFF, g, S, E); }
        if (BOTH(4)) XCD_BAR();
    }
    if (IN(5)) {
        pg8::Gemm g{HM, (const bf16*)(ws + WS_WDN), M, DM, FF}; pg8::StaticOrder S; S.init(M, DM, G, vc);
        pg8::EpiRes<false> E{nullptr, XN, SS2};
        pg8::gemm_phase<pg8::EpiRes<false>, pg8::StaticOrder, PG8_ALIGN, PG8_SP2>(lds + RING_OFF, g, S, E);
        if (BOTH(5)) XCD_BAR();
    }
    if (IN(6)) {
        pg8::Gemm g{XN, (const bf16*)(ws + WS_WPG), M, DM, DM}; pg8::StaticOrder S; S.init(M, DM, G, vc);
        LAS float* rtab = (LAS float*)(lds + LDSCTL_OFF + 12288); int rpm = -1;
        { pg8::Unit u0; if (S.next(0, u0)) { rpm = u0.pm; if (tid < 256) { const f32x4* sp = (const f32x4*)(SS2 + (size_t)(rpm * 256 + tid) * 16); const f32x4 a = sp[0], b = sp[1], c = sp[2], d = sp[3];
              rtab[tid] = rsqrtf((((a[0] + a[1]) + (a[2] + a[3])) + ((b[0] + b[1]) + (b[2] + b[3])) + ((c[0] + c[1]) + (c[2] + c[3])) + ((d[0] + d[1]) + (d[2] + d[3]))) * (1.f / DM) + EPS); } } __syncthreads(); }
        pg8::EpiPG E{args.out, XN, PR, SS2, rtab, rpm};
        pg8::gemm_phase<pg8::EpiPG, pg8::StaticOrder, PG8_ALIGN, PG8_SP2>(lds + RING_OFF, g, S, E);
    }
#undef IN
#undef BOTH
#undef GRID_BAR
#undef XCD_BAR
}

extern "C" void kernel_launch(void* const* d_in, const int* in_sizes, int n_in, void* d_out, int out_size, void* d_ws, size_t ws_size, hipStream_t stream) {
    static int grid = 0;
    if (grid == 0) {
        if (n_in != 23 || in_sizes[0] != M * DM || out_size != M * DM || ws_size < WS_END) { fprintf(stderr, "kernel_launch: unexpected shapes (n_in %d, out %d, ws %zu); nothing launched\n", n_in, out_size, ws_size); grid = -1; return; }
        int dev = 0, cus = 0, per_cu = 0;
        if (hipGetDevice(&dev) != hipSuccess || hipDeviceGetAttribute(&cus, hipDeviceAttributeMultiprocessorCount, dev) != hipSuccess) { grid = -1; return; }
        if (hipFuncSetAttribute((const void*)fwd, hipFuncAttributeMaxDynamicSharedMemorySize, LDS_BYTES) != hipSuccess) { fprintf(stderr, "kernel_launch: hipFuncSetAttribute failed\n"); grid = -1; return; }
        const hipError_t oe = hipOccupancyMaxActiveBlocksPerMultiprocessor(&per_cu, (const void*)fwd, NWAVES * 64, LDS_BYTES);
        (void)hipGetLastError();
        if (oe == hipSuccess && per_cu < 1) { fprintf(stderr, "kernel_launch: the occupancy query admits no workgroup of this kernel per CU; nothing launched\n"); grid = -1; return; }
        grid = cus;
    }
    if (grid < 0) return;
    if (hipMemsetAsync((char*)d_ws + WS_CTL, 0, CTL_ZERO_BYTES, stream) != hipSuccess) { fprintf(stderr, "kernel_launch: memset failed\n"); return; }
    Args a{};
    for (int i = 0; i < 23; ++i) a.in[i] = (const float*)d_in[i];
    a.out = (float*)d_out; a.ws = (unsigned char*)d_ws;
    for (int li = 0; li < N_LAUNCHES; ++li) {
        a.ph_lo = (N_LAUNCHES == PER_PHASE) ? li : 0; a.ph_hi = (N_LAUNCHES == PER_PHASE) ? li + 1 : PER_PHASE; a.li = li;
        hipLaunchKernelGGL(fwd, dim3(grid), dim3(NWAVES * 64), LDS_BYTES, stream, a);
        const hipError_t le = hipPeekAtLastError();
        if (le != hipSuccess) { fprintf(stderr, "kernel_launch: launch %d failed: %s\n", li, hipGetErrorName(le)); break; }
    }
}
```

```cpp
#include <hip/hip_runtime.h>
#include <cstdio>
#include <cstdint>

#ifndef ATT_EXACT_ZERO
#define ATT_EXACT_ZERO 0
#endif
#ifndef MK_N_LAUNCHES
#define MK_N_LAUNCHES 1
#endif

constexpr int M = 16384, DM = 1024, NIN = 2560, AW = 512, CW = 512, NH = 4, DH = 64, VH = 128, KC = 31, FF = 2816, PD = 256;
constexpr float EPS = 1e-6f;
constexpr float LOG2E = 1.4426950408889634f;
constexpr float QSCALE = 0.125f * LOG2E;
constexpr float LAM_INIT = 0.2f;

__host__ __device__ __forceinline__ int v_st(int k, int c) { const int j = k & 15; return (((k >> 4) * 128 + c) * 16 + ((j >> 2) & 1) * 8 + (j & 3) + 4 * (j >> 3)) * 2; }
__host__ __device__ __forceinline__ int k_st(int k, int c) { return (c >> 3) * 1024 + k * 16 + (c & 7) * 2; }
__device__ __forceinline__ float fsigmoid(float x) { return __builtin_amdgcn_rcpf(1.f + __builtin_amdgcn_exp2f(-LOG2E * x)); }

namespace pg8 {
#define PG8_LAS __attribute__((address_space(3)))
typedef unsigned short bf16_t;
typedef short bf16x8 __attribute__((ext_vector_type(8)));
typedef float f32x4 __attribute__((ext_vector_type(4)));
typedef unsigned u32x4 __attribute__((ext_vector_type(4)));
constexpr int BM = 256, BK = 64, HALF = 128, HTB = HALF * BK * 2  , STAGE_BYTES = 8 * HTB, NXCD = 8, WGM = 8;

__host__ __device__ __forceinline__ int lds_byte(int r, int c) { const int st = (r >> 4) * 2 + (c >> 5), rr = r & 15, cc = c & 31, ob = rr * 64 + cc * 2; return st * 1024 + (ob ^ (((ob >> 9) & 1) << 5)); }
__host__ __device__ __forceinline__ void stage_rc(int b, int& R, int& C) { const int st = b / 1024, sb = b % 1024, swz = sb ^ (((sb >> 9) & 1) << 5); R = (st >> 1) * 16 + swz / 64; C = (st & 1) * 32 + (swz % 64) / 2; }
__host__ __device__ __forceinline__ int perm32(int rho) { const int n = rho >> 4, i = rho & 15; return 8 * (i >> 2) + 4 * n + (i & 3); }

struct Unit { int pm, pn; };
struct Gemm { const bf16_t* A; const bf16_t* Bt; int M, N, K; };

struct StaticOrder {
    int nM, nN, nwg, G, c;
    __host__ __device__ void init(int M, int N, int G_, int c_) { nM = M / BM; nN = N / BM; nwg = nM * nN; G = G_; c = c_; }
    __host__ __device__ bool next(int i, Unit& u) const {
        const long L = (long)i * G + c; if (L >= nwg) return false;
        int wgid = (int)L; { const int q = nwg / NXCD, r = nwg % NXCD, xcd = wgid % NXCD, off = wgid / NXCD; wgid = (xcd < r ? xcd * (q + 1) : r * (q + 1) + (xcd - r) * q) + off; }
        const int nig = WGM * nN, gid = wgid / nig, fm = gid * WGM, gsz = (nM - fm) < WGM ? (nM - fm) : WGM;
        u.pm = fm + ((wgid % nig) % gsz); u.pn = (wgid % nig) / gsz; return true;
    }
    __device__ __forceinline__ void a_ready(const Unit&) const {}
    __device__ __forceinline__ void done(const Unit&) const {}
};


__device__ __forceinline__ float sum_fq(float v) {
    { auto r = __builtin_amdgcn_permlane32_swap(__float_as_uint(v), __float_as_uint(v), false, false); v = __uint_as_float(r[0]) + __uint_as_float(r[1]); }
    { auto r = __builtin_amdgcn_permlane16_swap(__float_as_uint(v), __float_as_uint(v), false, false); v = __uint_as_float(r[0]) + __uint_as_float(r[1]); }
    return v;
}
__device__ __forceinline__ unsigned cvt_pk_bf16(float lo, float hi) { unsigned r; asm volatile("v_cvt_pk_bf16_f32 %0, %1, %2" : "=v"(r) : "v"(lo), "v"(hi)); return r; }
typedef _Float16 half2_t __attribute__((ext_vector_type(2)));
__device__ __forceinline__ unsigned pkh(float lo, float hi) { return __builtin_bit_cast(unsigned, __builtin_amdgcn_cvt_pkrtz(lo, hi)); }
__device__ __forceinline__ u32x4 pack8_f16(const f32x4 a, const f32x4 b) { u32x4 w; w.x = pkh(a[0], a[1]); w.y = pkh(a[2], a[3]); w.z = pkh(b[0], b[1]); w.w = pkh(b[2], b[3]); return w; }
__device__ __forceinline__ u32x4 pack8(const f32x4 a, const f32x4 b) { u32x4 w; w.x = cvt_pk_bf16(a[0], a[1]); w.y = cvt_pk_bf16(a[2], a[3]); w.z = cvt_pk_bf16(b[0], b[1]); w.w = cvt_pk_bf16(b[2], b[3]); return w; }

struct EpiBf16 {
    static constexpr bool PERM = true, AFTER_DRAIN = false;
    bf16_t* O; int ldc;
    __device__ __forceinline__ void operator()(const f32x4 (&acc)[2][2][4][2], const Unit& u, int wr, int wc, int fr, int fq) const {
        const int row0 = u.pm * BM + wr * 64 + fr, col0 = u.pn * BM + wc * 32 + 8 * fq;
#pragma unroll
        for (int ai = 0; ai < 2; ++ai)
#pragma unroll
            for (int m = 0; m < 4; ++m) { bf16_t* rowp = O + (size_t)(row0 + ai * HALF + m * 16) * ldc + col0;
#pragma unroll
                for (int bj = 0; bj < 2; ++bj) *(u32x4*)(rowp + bj * HALF) = pack8(acc[ai][bj][m][0], acc[ai][bj][m][1]); }
    }
};

struct EpiIn {
    static constexpr bool PERM = true, AFTER_DRAIN = false;
    bf16_t* Q; unsigned char* Kimg; unsigned char* Vimg; bf16_t* U; const float* qn; const float* kn; unsigned* nmax; const float* SS0; const PG8_LAS float* rtab; int rtab_pm; const PG8_LAS float* gtab; PG8_LAS unsigned* nmax_lds;
    __device__ __forceinline__ void operator()(const f32x4 (&acc)[2][2][4][2], const Unit& u, int wr, int wc, int fr, int fq) const {
        const int row0 = u.pm * BM + wr * 64 + fr;
        float r0s[2][4];
        if (u.pm == rtab_pm) {
#pragma unroll
            for (int ai = 0; ai < 2; ++ai)
#pragma unroll
                for (int m = 0; m < 4; ++m) r0s[ai][m] = rtab[wr * 64 + fr + ai * HALF + m * 16];
        } else {
#pragma unroll
            for (int ai = 0; ai < 2; ++ai)
#pragma unroll
                for (int m = 0; m < 4; ++m) r0s[ai][m] = SS0[row0 + ai * HALF + m * 16];
#pragma unroll
            for (int ai = 0; ai < 2; ++ai)
#pragma unroll
                for (int m = 0; m < 4; ++m) r0s[ai][m] = rsqrtf(r0s[ai][m] * (1.f / DM) + EPS);
        }
        if (u.pn < 4) {
            float nn_max = 0.f;
            const bool isq = u.pn < 2; const PG8_LAS float* gn = gtab + (isq ? 0 : 64); const float sc = isq ? QSCALE : 1.f;
            const int gidx = (u.pn & 1) * 4 + wc;
            f32x4 g[2][2];
#pragma unroll
            for (int bj = 0; bj < 2; ++bj)
#pragma unroll
                for (int n = 0; n < 2; ++n) g[bj][n] = *(const PG8_LAS f32x4*)(gn + 32 * bj + 8 * fq + 4 * n);
            float kbar2_max = 0.f;
#pragma unroll
            for (int ai = 0; ai < 2; ++ai) {
                f32x4 cs[2][2];
#pragma unroll
                for (int bj = 0; bj < 2; ++bj) { cs[bj][0] = (f32x4){0.f, 0.f, 0.f, 0.f}; cs[bj][1] = (f32x4){0.f, 0.f, 0.f, 0.f}; }
#pragma unroll
                for (int m = 0; m < 4; ++m) {
                    float ss = 0.f;
#pragma unroll
                    for (int bj = 0; bj < 2; ++bj)
#pragma unroll
                        for (int n = 0; n < 2; ++n) { const f32x4 x = acc[ai][bj][m][n]; ss += (x[0] * x[0] + x[1] * x[1]) + (x[2] * x[2] + x[3] * x[3]); }
                    ss = sum_fq(ss);
                    const int row = row0 + ai * HALF + m * 16; float nn = 0.f;
                    const float r0 = r0s[ai][m];
                    const float r = rsqrtf(ss * (r0 * r0) * (1.f / 64.f) + EPS) * (r0 * sc);
#pragma unroll
                    for (int bj = 0; bj < 2; ++bj) {
                        const f32x4 v0 = acc[ai][bj][m][0] * r * g[bj][0], v1 = acc[ai][bj][m][1] * r * g[bj][1];
                        nn += (v0[0] * v0[0] + v0[1] * v0[1]) + (v0[2] * v0[2] + v0[3] * v0[3]) + (v1[0] * v1[0] + v1[1] * v1[1]) + (v1[2] * v1[2] + v1[3] * v1[3]);
                        if (!isq) { cs[bj][0] += v0; cs[bj][1] += v1; }
                        const u32x4 w = pack8(v0, v1);
                        if (isq) *(u32x4*)(Q + (size_t)row * AW + gidx * 64 + 32 * bj + 8 * fq) = w;
                        else *(u32x4*)(Kimg + (size_t)((gidx >> 1) * 256 + (row >> 6)) * 16384 + k_st(row & 63, (gidx & 1) * 64 + 32 * bj + 8 * fq)) = w;
                    }
                    nn = sum_fq(nn); nn_max = fmaxf(nn_max, nn);
                }
                if (!isq) {
                    float kb = 0.f;
#pragma unroll
                    for (int bj = 0; bj < 2; ++bj)
#pragma unroll
                        for (int n = 0; n < 2; ++n)
#pragma unroll
                            for (int e = 0; e < 4; ++e) { float c = cs[bj][n][e];
#pragma unroll
                                for (int o = 1; o < 16; o <<= 1) c += __shfl_xor(c, o);
                                kb += c * c; }
                    kb = sum_fq(kb);
                    kbar2_max = fmaxf(kbar2_max, kb * (1.f / 4096.f));
                }
            }
#pragma unroll
            for (int o = 1; o < 16; o <<= 1) nn_max = fmaxf(nn_max, __shfl_xor(nn_max, o));
            if ((threadIdx.x & 63) == 0) (void)__hip_atomic_fetch_max(nmax_lds + (isq ? 0 : 1), __float_as_uint(sqrtf(nn_max)), __ATOMIC_RELAXED, __HIP_MEMORY_SCOPE_WORKGROUP);
            if (!isq && (threadIdx.x & 63) == 0) (void)__hip_atomic_fetch_max(nmax_lds + 2, __float_as_uint(sqrtf(kbar2_max)), __ATOMIC_RELAXED, __HIP_MEMORY_SCOPE_WORKGROUP);
        } else if (u.pn < 6) {
#pragma unroll
            for (int ai = 0; ai < 2; ++ai)
#pragma unroll
                for (int m = 0; m < 4; ++m) { const int row = row0 + ai * HALF + m * 16; const float r0 = r0s[ai][m];
#pragma unroll
                    for (int bj = 0; bj < 2; ++bj) { const int h = (u.pn - 4) * 2 + bj;
                        const u32x4 w = pack8(acc[ai][bj][m][0] * r0, acc[ai][bj][m][1] * r0);
                        unsigned char* vt = Vimg + (size_t)(h * 256 + (row >> 6)) * 16384 + v_st(row & 63, wc * 32 + 8 * fq);
                        *(bf16_t*)(vt) = (bf16_t)(w.x & 0xffffu); *(bf16_t*)(vt + 32) = (bf16_t)(w.x >> 16); *(bf16_t*)(vt + 64) = (bf16_t)(w.y & 0xffffu); *(bf16_t*)(vt + 96) = (bf16_t)(w.y >> 16);
                        *(bf16_t*)(vt + 128) = (bf16_t)(w.z & 0xffffu); *(bf16_t*)(vt + 160) = (bf16_t)(w.z >> 16); *(bf16_t*)(vt + 192) = (bf16_t)(w.w & 0xffffu); *(bf16_t*)(vt + 224) = (bf16_t)(w.w >> 16); } }
        } else {
            const int ch0 = (u.pn - 6) * 128 + wc * 32 + 8 * fq;
#pragma unroll
            for (int ai = 0; ai < 2; ++ai)
#pragma unroll
                for (int m = 0; m < 4; ++m) { const int row = row0 + ai * HALF + m * 16; f32x4 v[2]; const float r0 = r0s[ai][m];
                    const float r2 = -LOG2E * r0, ir0 = __builtin_amdgcn_rcpf(r0);
#pragma unroll
                    for (int n = 0; n < 2; ++n) { const f32x4 a = acc[ai][0][m][n], gt = acc[ai][1][m][n];
                        const f32x4 t = gt * r2; const f32x4 ex = (f32x4){__builtin_amdgcn_exp2f(t[0]), __builtin_amdgcn_exp2f(t[1]), __builtin_amdgcn_exp2f(t[2]), __builtin_amdgcn_exp2f(t[3])};
                        const f32x4 den = ex * ir0 + ir0; v[n] = a * (f32x4){__builtin_amdgcn_rcpf(den[0]), __builtin_amdgcn_rcpf(den[1]), __builtin_amdgcn_rcpf(den[2]), __builtin_amdgcn_rcpf(den[3])}; }
                    *(u32x4*)(U + (size_t)row * CW + ch0) = pack8_f16(v[0], v[1]); }
        }
    }
};

template <bool F32BASE> struct EpiRes {
    static constexpr bool PERM = true, AFTER_DRAIN = false;
    const float* base; bf16_t* Xb; float* SS;
    __device__ __forceinline__ void operator()(const f32x4 (&acc)[2][2][4][2], const Unit& u, int wr, int wc, int fr, int fq) const {
        static_assert(!F32BASE, "the residual base is the bf16 stream");
        const int row0 = u.pm * BM + wr * 64 + fr, col0 = u.pn * BM + wc * 32 + 8 * fq;
        u32x4 bva[2][4][2];
#pragma unroll
        for (int ai = 0; ai < 2; ++ai)
#pragma unroll
            for (int m = 0; m < 4; ++m)
#pragma unroll
                for (int bj = 0; bj < 2; ++bj) bva[ai][m][bj] = *(const u32x4*)(Xb + (size_t)(row0 + ai * HALF + m * 16) * DM + col0 + bj * HALF);
        asm volatile("" :: "v"(bva[0][0][0]), "v"(bva[0][1][0]), "v"(bva[0][2][0]), "v"(bva[0][3][0]), "v"(bva[1][0][0]), "v"(bva[1][1][0]), "v"(bva[1][2][0]), "v"(bva[1][3][0]), "v"(bva[0][0][1]), "v"(bva[0][1][1]), "v"(bva[0][2][1]), "v"(bva[0][3][1]), "v"(bva[1][0][1]), "v"(bva[1][1][1]), "v"(bva[1][2][1]), "v"(bva[1][3][1]));
#pragma unroll
        for (int ai = 0; ai < 2; ++ai) {
#pragma unroll
            for (int m = 0; m < 4; ++m) { const int row = row0 + ai * HALF + m * 16; float ss = 0.f;
#pragma unroll
                for (int bj = 0; bj < 2; ++bj) { const size_t off = (size_t)row * DM + col0 + bj * HALF; const u32x4 b = bva[ai][m][bj];
                    f32x4 x0 = (f32x4){__builtin_bit_cast(float, b.x << 16), __builtin_bit_cast(float, b.x & 0xffff0000u), __builtin_bit_cast(float, b.y << 16), __builtin_bit_cast(float, b.y & 0xffff0000u)};
                    f32x4 x1 = (f32x4){__builtin_bit_cast(float, b.z << 16), __builtin_bit_cast(float, b.z & 0xffff0000u), __builtin_bit_cast(float, b.w << 16), __builtin_bit_cast(float, b.w & 0xffff0000u)};
                    x0 += acc[ai][bj][m][0]; x1 += acc[ai][bj][m][1];
                    ss += (x0[0] * x0[0] + x0[1] * x0[1]) + (x0[2] * x0[2] + x0[3] * x0[3]) + (x1[0] * x1[0] + x1[1] * x1[1]) + (x1[2] * x1[2] + x1[3] * x1[3]);
                    *(u32x4*)(Xb + off) = pack8(x0, x1); }
                ss = sum_fq(ss);
                if (fq == 0) SS[(size_t)row * 16 + u.pn * 4 + wc] = ss; }
        }
    }
};
__device__ __forceinline__ void row_rstd8(const float* SS, int row0, int fq, float (&rs)[2][4]) {
#pragma unroll
    for (int ai = 0; ai < 2; ++ai)
#pragma unroll
        for (int m = 0; m < 4; ++m) { const f32x4 t = *(const f32x4*)(SS + (size_t)(row0 + ai * HALF + m * 16) * 16 + 4 * fq); rs[ai][m] = (t[0] + t[1]) + (t[2] + t[3]); }
#pragma unroll
    for (int ai = 0; ai < 2; ++ai)
#pragma unroll
        for (int m = 0; m < 4; ++m) { float v = sum_fq(rs[ai][m]); rs[ai][m] = rsqrtf(v * (1.f / DM) + EPS); }
}
struct EpiGU {
    static constexpr bool PERM = true, AFTER_DRAIN = false;
    bf16_t* HM; const float* SS; const PG8_LAS float* rtab; int rtab_pm;
    __device__ __forceinline__ void operator()(const f32x4 (&acc)[2][2][4][2], const Unit& u, int wr, int wc, int fr, int fq) const {
        const int row0 = u.pm * BM + wr * 64 + fr, col0 = u.pn * HALF + wc * 32 + 8 * fq;
        float rs[2][4];
        if (u.pm == rtab_pm) {
#pragma unroll
            for (int ai = 0; ai < 2; ++ai)
#pragma unroll
                for (int m = 0; m < 4; ++m) rs[ai][m] = rtab[wr * 64 + fr + ai * HALF + m * 16];
        } else row_rstd8(SS, row0, fq, rs);
#pragma unroll
        for (int ai = 0; ai < 2; ++ai)
#pragma unroll
            for (int m = 0; m < 4; ++m) { const int row = row0 + ai * HALF + m * 16; const float r = rs[ai][m]; f32x4 v[2];
                const float r2 = -LOG2E * r, ir2 = __builtin_amdgcn_rcpf(r * r);
#pragma unroll
                for (int n = 0; n < 2; ++n) { const f32x4 gt = acc[ai][0][m][n], up = acc[ai][1][m][n];
                    const f32x4 t = gt * r2, gu = gt * up; f32x4 ex = (f32x4){__builtin_amdgcn_exp2f(t[0]), __builtin_amdgcn_exp2f(t[1]), __builtin_amdgcn_exp2f(t[2]), __builtin_amdgcn_exp2f(t[3])};
                    const f32x4 den = ex * ir2 + ir2; const f32x4 rc = (f32x4){__builtin_amdgcn_rcpf(den[0]), __builtin_amdgcn_rcpf(den[1]), __builtin_amdgcn_rcpf(den[2]), __builtin_amdgcn_rcpf(den[3])};
                    v[n] = gu * rc; }
                *(u32x4*)(HM + (size_t)row * FF + col0) = pack8(v[0], v[1]); }
    }
};
struct EpiPG {
    static constexpr bool PERM = true, AFTER_DRAIN = false;
    float* out; const bf16_t* Xb; const bf16_t* PR; const float* SS; const PG8_LAS float* rtab; int rtab_pm;
    __device__ __forceinline__ void operator()(const f32x4 (&acc)[2][2][4][2], const Unit& u, int wr, int wc, int fr, int fq) const {
        const int row0 = u.pm * BM + wr * 64 + fr, col0 = u.pn * BM + wc * 32 + 8 * fq;
        float rs[2][4];
        if (u.pm == rtab_pm) {
#pragma unroll
            for (int ai = 0; ai < 2; ++ai)
#pragma unroll
                for (int m = 0; m < 4; ++m) rs[ai][m] = rtab[wr * 64 + fr + ai * HALF + m * 16];
        } else row_rstd8(SS, row0, fq, rs);
#pragma unroll
        for (int ai = 0; ai < 2; ++ai) {
            u32x4 prv[4][2], xbv[4][2];
#pragma unroll
            for (int m = 0; m < 4; ++m)
#pragma unroll
                for (int bj = 0; bj < 2; ++bj) { const size_t off = (size_t)(row0 + ai * HALF + m * 16) * DM + col0 + bj * HALF; prv[m][bj] = *(const u32x4*)(PR + off); xbv[m][bj] = *(const u32x4*)(Xb + off); }
#pragma unroll
            for (int m = 0; m < 4; ++m) { const int row = row0 + ai * HALF + m * 16; const float r = rs[ai][m];
#pragma unroll
                for (int bj = 0; bj < 2; ++bj) { const size_t off = (size_t)row * DM + col0 + bj * HALF;
                    const u32x4 pr = prv[m][bj], xb = xbv[m][bj];
                    const float rl = -LOG2E * r;
                    const f32x4 t0 = acc[ai][bj][m][0] * rl, t1 = acc[ai][bj][m][1] * rl;
                    const f32x4 d0 = (f32x4){__builtin_amdgcn_exp2f(t0[0]), __builtin_amdgcn_exp2f(t0[1]), __builtin_amdgcn_exp2f(t0[2]), __builtin_amdgcn_exp2f(t0[3])} + 1.f;
                    const f32x4 d1 = (f32x4){__builtin_amdgcn_exp2f(t1[0]), __builtin_amdgcn_exp2f(t1[1]), __builtin_amdgcn_exp2f(t1[2]), __builtin_amdgcn_exp2f(t1[3])} + 1.f;
                    const f32x4 s0 = (f32x4){__builtin_amdgcn_rcpf(d0[0]), __builtin_amdgcn_rcpf(d0[1]), __builtin_amdgcn_rcpf(d0[2]), __builtin_amdgcn_rcpf(d0[3])}, s1 = (f32x4){__builtin_amdgcn_rcpf(d1[0]), __builtin_amdgcn_rcpf(d1[1]), __builtin_amdgcn_rcpf(d1[2]), __builtin_amdgcn_rcpf(d1[3])};
                    const f32x4 x0 = (f32x4){__builtin_bit_cast(float, xb.x << 16), __builtin_bit_cast(float, xb.x & 0xffff0000u), __builtin_bit_cast(float, xb.y << 16), __builtin_bit_cast(float, xb.y & 0xffff0000u)};
                    const f32x4 x1 = (f32x4){__builtin_bit_cast(float, xb.z << 16), __builtin_bit_cast(float, xb.z & 0xffff0000u), __builtin_bit_cast(float, xb.w << 16), __builtin_bit_cast(float, xb.w & 0xffff0000u)};
                    const f32x4 p0 = (f32x4){__builtin_bit_cast(float, pr.x << 16), __builtin_bit_cast(float, pr.x & 0xffff0000u), __builtin_bit_cast(float, pr.y << 16), __builtin_bit_cast(float, pr.y & 0xffff0000u)};
                    const f32x4 p1 = (f32x4){__builtin_bit_cast(float, pr.z << 16), __builtin_bit_cast(float, pr.z & 0xffff0000u), __builtin_bit_cast(float, pr.w << 16), __builtin_bit_cast(float, pr.w & 0xffff0000u)};
                    const f32x4 o0 = s0 * p0 + x0, o1 = s1 * p1 + x1;
                    __builtin_nontemporal_store(o0, (f32x4*)(out + off)); __builtin_nontemporal_store(o1, (f32x4*)(out + off + 4)); } }
        }
    }
};
struct HelperOrder {
    int G, c;
    __device__ __forceinline__ bool next(int i, Unit& u) const {
        const int h0 = G >> 1; if (c < h0) return false;
        if ((G & 15) == 0) {
            const int x = c & 7, rank = c >> 3, nr = G >> 3, r0 = nr >> 1, lu = (rank - r0) + (nr - r0) * i; if (lu >= 32) return false; u.pm = 8 * x + (lu >> 2); u.pn = lu & 3; return true; }
        const int L = (c - h0) + (G - h0) * i; if (L >= 256) return false; u.pm = L >> 2; u.pn = L & 3; return true; }
    __device__ __forceinline__ void a_ready(const Unit&) const {}
    __device__ __forceinline__ void done(const Unit&) const {}
};

template <class Epi, class Sched, bool ALIGN_EPI = false, bool SP2 = false>
__device__ __forceinline__ void gemm_phase(PG8_LAS unsigned char* lds, const Gemm g, const Sched& S, const Epi& E) {
    const int tid = threadIdx.x, wid = __builtin_amdgcn_readfirstlane(tid >> 6), lane = tid & 63, wr = wid >> 2, wc = wid & 3, fr = lane & 15, fq = lane >> 4;
    const int K = g.K, nt = K / BK;
    unsigned voffA[2], voffB[2];
#pragma unroll
    for (int i = 0; i < 2; ++i) { int R, C; stage_rc(tid * 16 + i * 8192, R, C); const int Rb = Epi::PERM ? ((R & ~31) + perm32(R & 31)) : R;
        voffA[i] = (unsigned)(R * K + C) * 2u; voffB[i] = (unsigned)(Rb * K + C) * 2u; }
    const size_t kstep = (size_t)(BK * 2);
    const size_t hstep = (size_t)HALF * K * 2;
    const size_t tstep = 2 * hstep;
    const unsigned ldsw = (unsigned)wid * 1024u;
    const int aoff = lds_byte(wr * 64 + fr, fq * 8), boff = lds_byte(wc * 32 + fr, fq * 8);
#define PG8_SA(b, h) (((b) * 2 + (h)) * HTB)
#define PG8_SB(b, h) ((4 + (b) * 2 + (h)) * HTB)
#define PG8_STAGE(bufoff, gbase, voff) do { _Pragma("unroll") for (int _i = 0; _i < 2; ++_i) \
        __builtin_amdgcn_global_load_lds((const unsigned*)((const char*)(gbase) + (voff)[_i]), (PG8_LAS unsigned*)(lds + (bufoff) + ldsw + _i * 8192), 16, 0, 0); } while (0)
#define PG8_LDA(dst, b, h) do { _Pragma("unroll") for (int m = 0; m < 4; ++m) _Pragma("unroll") for (int k = 0; k < 2; ++k) dst[m][k] = *(const PG8_LAS bf16x8*)(lds + PG8_SA(b, h) + aoff + m * 2048 + k * 1024); } while (0)
#define PG8_LDB(dst, b, h) do { _Pragma("unroll") for (int n = 0; n < 2; ++n) _Pragma("unroll") for (int k = 0; k < 2; ++k) dst[n][k] = *(const PG8_LAS bf16x8*)(lds + PG8_SB(b, h) + boff + n * 2048 + k * 1024); } while (0)
#define PG8_MMA(ai, bj, At, Bt) do { __builtin_amdgcn_s_setprio(1); _Pragma("unroll") for (int m = 0; m < 4; ++m) _Pragma("unroll") for (int n = 0; n < 2; ++n) _Pragma("unroll") for (int k = 0; k < 2; ++k) \
        acc[ai][bj][m][n] = __builtin_amdgcn_mfma_f32_16x16x32_bf16(Bt[n][k], At[m][k], acc[ai][bj][m][n], 0, 0, 0); __builtin_amdgcn_s_setprio(0); } while (0)
#define PG8_WAIT_V(n) asm volatile("s_waitcnt vmcnt(" #n ")" ::: "memory")
#define PG8_WAIT_L(n) asm volatile("s_waitcnt lgkmcnt(" #n ")" ::: "memory")
#define PG8_BAR __builtin_amdgcn_s_barrier()
#define PG8_SCHED __builtin_amdgcn_sched_barrier(0)
    Unit cur, nxt; int ui = 0;
    if (!S.next(0, cur)) return;
    f32x4 acc[2][2][4][2];
#pragma unroll
    for (int a = 0; a < 2; ++a)
#pragma unroll
        for (int b = 0; b < 2; ++b)
#pragma unroll
            for (int m = 0; m < 4; ++m)
#pragma unroll
                for (int n = 0; n < 2; ++n) acc[a][b][m][n] = (f32x4){0.f, 0.f, 0.f, 0.f};
    bf16x8 At[4][2], B0[2][2], B1[2][2];
    const char* cA = (const char*)g.A + (size_t)cur.pm * tstep; const char* cB = (const char*)g.Bt + (size_t)cur.pn * tstep;
    S.a_ready(cur);
    if constexpr (SP2) {
        PG8_STAGE(PG8_SB(0, 0), cB, voffB); PG8_STAGE(PG8_SB(0, 1), cB + hstep, voffB); PG8_STAGE(PG8_SA(0, 0), cA, voffA); PG8_STAGE(PG8_SA(0, 1), cA + hstep, voffA);
        if (wr == 1) PG8_BAR;
        PG8_WAIT_V(2); PG8_BAR;
        PG8_STAGE(PG8_SB(1, 0), cB + kstep, voffB); PG8_STAGE(PG8_SA(1, 0), cA + kstep, voffA); PG8_STAGE(PG8_SB(1, 1), cB + hstep + kstep, voffB);
        PG8_WAIT_V(6); PG8_BAR;
    } else {
        PG8_STAGE(PG8_SB(0, 0), cB, voffB); PG8_STAGE(PG8_SA(0, 0), cA, voffA); PG8_STAGE(PG8_SB(0, 1), cB + hstep, voffB); PG8_STAGE(PG8_SA(0, 1), cA + hstep, voffA);
        if (wr == 1) PG8_BAR;
        PG8_WAIT_V(4); PG8_BAR;
        PG8_STAGE(PG8_SB(1, 0), cB + kstep, voffB); PG8_STAGE(PG8_SA(1, 0), cA + kstep, voffA); PG8_STAGE(PG8_SB(1, 1), cB + hstep + kstep, voffB);
        PG8_WAIT_V(6); PG8_BAR;
    }
    for (;;) {
        const bool has_next = S.next(ui + 1, nxt);
        const char* nA = has_next ? (const char*)g.A + (size_t)nxt.pm * tstep : cA; const char* nB = has_next ? (const char*)g.Bt + (size_t)nxt.pn * tstep : cB;
        for (int t = 0; t < nt; t += 2) {
            const bool last = (t == nt - 2);
            const char* a1 = cA + (size_t)(t + 1) * kstep;
            const char* a2 = last ? nA : cA + (size_t)(t + 2) * kstep; const char* b2 = last ? nB : cB + (size_t)(t + 2) * kstep;
            const char* a3 = a2 + kstep; const char* b3 = b2 + kstep;
            if (last && has_next) S.a_ready(nxt);
            if constexpr (SP2) {
            PG8_LDB(B0, 0, 0); PG8_LDB(B1, 0, 1); PG8_SCHED; PG8_LDA(At, 0, 0); PG8_STAGE(PG8_SA(1, 1), a1 + hstep, voffA);
            PG8_WAIT_V(8); PG8_WAIT_L(0); PG8_BAR; PG8_MMA(0, 0, At, B0); PG8_MMA(0, 1, At, B1); PG8_BAR; PG8_SCHED;
            PG8_LDA(At, 0, 1); PG8_STAGE(PG8_SB(0, 0), b2, voffB); PG8_STAGE(PG8_SB(0, 1), b2 + hstep, voffB); PG8_STAGE(PG8_SA(0, 0), a2, voffA);
            PG8_WAIT_V(8); PG8_WAIT_L(0); PG8_BAR; PG8_MMA(1, 0, At, B0); PG8_MMA(1, 1, At, B1); PG8_BAR; PG8_SCHED;
            PG8_LDB(B0, 1, 0); PG8_LDB(B1, 1, 1); PG8_SCHED; PG8_LDA(At, 1, 0); PG8_STAGE(PG8_SA(0, 1), a2 + hstep, voffA);
            PG8_WAIT_V(8); PG8_WAIT_L(0); PG8_BAR; PG8_MMA(0, 0, At, B0); PG8_MMA(0, 1, At, B1); PG8_BAR; PG8_SCHED;
            PG8_LDA(At, 1, 1); PG8_STAGE(PG8_SB(1, 0), b3, voffB); PG8_STAGE(PG8_SB(1, 1), b3 + hstep, voffB); PG8_STAGE(PG8_SA(1, 0), a3, voffA);
            PG8_WAIT_V(8); PG8_WAIT_L(0); PG8_BAR; PG8_MMA(1, 0, At, B0); PG8_MMA(1, 1, At, B1); PG8_BAR; PG8_SCHED;
            } else {
            PG8_LDB(B0, 0, 0); PG8_SCHED; PG8_LDA(At, 0, 0); PG8_STAGE(PG8_SA(1, 1), a1 + hstep, voffA);
            PG8_WAIT_L(8); PG8_BAR; PG8_WAIT_L(0); PG8_MMA(0, 0, At, B0); PG8_BAR; PG8_SCHED;
            PG8_LDB(B1, 0, 1); PG8_STAGE(PG8_SB(0, 0), b2, voffB);
            PG8_BAR; PG8_WAIT_L(0); PG8_MMA(0, 1, At, B1); PG8_BAR;
            PG8_LDA(At, 0, 1); PG8_STAGE(PG8_SA(0, 0), a2, voffA);
            PG8_BAR; PG8_WAIT_L(0); PG8_MMA(1, 0, At, B0); PG8_BAR; PG8_SCHED;
            PG8_STAGE(PG8_SB(0, 1), b2 + hstep, voffB);
            PG8_WAIT_V(6); PG8_BAR; PG8_MMA(1, 1, At, B1); PG8_BAR;
            PG8_LDB(B0, 1, 0); PG8_SCHED; PG8_LDA(At, 1, 0); PG8_STAGE(PG8_SA(0, 1), a2 + hstep, voffA);
            PG8_WAIT_L(8); PG8_BAR; PG8_WAIT_L(0); PG8_MMA(0, 0, At, B0); PG8_BAR; PG8_SCHED;
            PG8_LDB(B1, 1, 1); PG8_STAGE(PG8_SB(1, 0), b3, voffB);
            PG8_BAR; PG8_WAIT_L(0); PG8_MMA(0, 1, At, B1); PG8_BAR;
            PG8_LDA(At, 1, 1); PG8_STAGE(PG8_SA(1, 0), a3, voffA);
            PG8_BAR; PG8_WAIT_L(0); PG8_MMA(1, 0, At, B0); PG8_BAR; PG8_SCHED;
            PG8_STAGE(PG8_SB(1, 1), b3 + hstep, voffB);
            PG8_WAIT_V(6); PG8_BAR; PG8_MMA(1, 1, At, B1); PG8_BAR;
            }
        }
        if constexpr (ALIGN_EPI) { if (wr == 0) PG8_BAR; }
        if constexpr (!Epi::AFTER_DRAIN) { E(acc, cur, wr, wc, fr, fq); S.done(cur); }
        if (!has_next) break;
#pragma unroll
        for (int a = 0; a < 2; ++a)
#pragma unroll
            for (int b = 0; b < 2; ++b)
#pragma unroll
                for (int m = 0; m < 4; ++m)
#pragma unroll
                    for (int n = 0; n < 2; ++n) acc[a][b][m][n] = (f32x4){0.f, 0.f, 0.f, 0.f};
        cur = nxt; cA = nA; cB = nB; ++ui;
        if constexpr (ALIGN_EPI) { if (wr == 1) PG8_BAR; }
    }
    PG8_WAIT_V(0);
    if constexpr (!ALIGN_EPI) { if (wr == 0) PG8_BAR; }
    PG8_BAR;
    if constexpr (Epi::AFTER_DRAIN) { E.fused(acc, cur, wr, wc, fr, fq, lds, wid, lane); S.done(cur); }
#undef PG8_SA
#undef PG8_SB
#undef PG8_STAGE
#undef PG8_LDA
#undef PG8_LDB
#undef PG8_MMA
#undef PG8_WAIT_V
#undef PG8_WAIT_L
#undef PG8_BAR
#undef PG8_SCHED
}
}

#ifndef PG8_SP2
#define PG8_SP2 true
#endif
#ifndef PG8_ALIGN
#define PG8_ALIGN true
#endif
#define GAS __attribute__((address_space(1)))
#define LAS __attribute__((address_space(3)))
typedef unsigned short bf16;
typedef unsigned v4u __attribute__((ext_vector_type(4)));
typedef float f32x4 __attribute__((ext_vector_type(4)));
typedef short bf16x8 __attribute__((ext_vector_type(8)));
typedef GAS unsigned gu32;
typedef GAS unsigned long long gu64;
#define RLX_AGENT __ATOMIC_RELAXED, __HIP_MEMORY_SCOPE_AGENT
#define LDS_WAIT() asm volatile("s_waitcnt lgkmcnt(0)" ::: "memory")
#define VM_WAIT() asm volatile("s_waitcnt vmcnt(0)" ::: "memory")
__device__ __forceinline__ unsigned long long rt() { return __builtin_amdgcn_s_memrealtime(); }
__device__ __forceinline__ unsigned f2bf(float f) { unsigned u = __builtin_bit_cast(unsigned, f); return (u + 0x7fffu + ((u >> 16) & 1u)) >> 16; }
__device__ __forceinline__ unsigned pk2(float lo, float hi) { return f2bf(lo) | (f2bf(hi) << 16); }

#define XB_TMO      128
#define XB_XCNT(j)  (256  + 64 * (j))
#define XB_XSUB(j)  (1280 + 64 * (j))
#define XB_XGEN(j)  (2304 + 64 * (j))
#define XB_TOP      3328
#define XB_TOPGEN   3392
#define XB_LSUB(j)  (3456 + 64 * (j))
#define XB_LGEN(j)  (4480 + 64 * (j))
#define XCD_BAR_WORDS 5504
#define XB_SPIN_CAP (1u << 18)

__device__ __forceinline__ unsigned xb_ld(unsigned* p)              { return __hip_atomic_load(p, __ATOMIC_RELAXED, __HIP_MEMORY_SCOPE_AGENT); }
__device__ __forceinline__ unsigned xb_add(unsigned* p, unsigned v) { return __hip_atomic_fetch_add(p, v, __ATOMIC_RELAXED, __HIP_MEMORY_SCOPE_AGENT); }
__device__ __forceinline__ unsigned xb_xcc_id() { return (unsigned)__builtin_amdgcn_s_getreg((3 << 11) | 20) & 0xFu; }
#define XB_SPIN(cond, bar) do { unsigned _sp = 0; while (cond) { __builtin_amdgcn_s_sleep(1); \
    if ((++_sp & 255u) == 0u) { if (xb_ld(&(bar)[XB_TMO])) break; if (_sp > XB_SPIN_CAP) { atomicAdd(&(bar)[XB_TMO], 1u); break; } } } } while (0)

struct XcdBarrier {
    unsigned* bar; unsigned x;
    volatile LAS unsigned* st;
};

__device__ __forceinline__ XcdBarrier xcd_barrier_post(unsigned* bar, volatile LAS unsigned* st) {
    XcdBarrier b; b.bar = bar; b.x = xb_xcc_id(); b.st = st;
    if (threadIdx.x == 0) st[2] = xb_add(&bar[XB_XCNT(b.x)], 1u);
    return b;
}
__device__ __forceinline__ void xcd_barrier_complete(unsigned* bar, unsigned x, unsigned& nloc, unsigned& nx, unsigned& uniform) {
    const unsigned G = gridDim.x * gridDim.y * gridDim.z;
    unsigned sum, cnt, mine, odd, sp = 0u;
    for (;;) {
        sum = 0u; cnt = 0u; mine = 0u; odd = 0u;
#pragma unroll
        for (unsigned j = 0; j < 16; ++j) { const unsigned c = xb_ld(&bar[XB_XCNT(j)]); sum += c; cnt += (c > 0u) ? 1u : 0u; mine = (j == x) ? c : mine; odd |= (j < 8u) ? (c * 8u != G ? 1u : 0u) : (c != 0u ? 1u : 0u); }
        if (sum == G) { uniform = odd ? 0u : 1u; break; }
        __builtin_amdgcn_s_sleep(1);
        if ((++sp & 255u) == 0u) { if (xb_ld(&bar[XB_TMO])) { uniform = 0u; break; } if (sp > XB_SPIN_CAP) { atomicAdd(&bar[XB_TMO], 1u); uniform = 0u; break; } }
    }
    nloc = mine > 0u ? mine : 1u; nx = cnt > 0u ? cnt : 1u;
}

__device__ __forceinline__ void xcd_barrier(const XcdBarrier& b) {
    asm volatile("s_waitcnt vmcnt(0)" ::: "memory");
    __syncthreads();
    if (threadIdx.x == 0) {
        unsigned* bar = b.bar;
        __builtin_amdgcn_s_waitcnt(0);
        unsigned nloc = b.st[0], nx = b.st[1];
        if (nloc == 0u) { unsigned uni = 0u; xcd_barrier_complete(bar, b.x, nloc, nx, uni); b.st[0] = nloc; b.st[1] = nx; b.st[3] = uni; }
        const unsigned old = xb_add(&bar[XB_XSUB(b.x)], 1u);
        const unsigned gen = old / nloc;
        if (old + 1u == (gen + 1u) * nloc) {
            __builtin_amdgcn_fence(__ATOMIC_RELEASE, "agent");
            asm volatile("s_waitcnt vmcnt(0)" ::: "memory");
            const unsigned og = xb_add(&bar[XB_TOP], 1u);
            const unsigned tg = og / nx;
            if (og + 1u == (tg + 1u) * nx) xb_add(&bar[XB_TOPGEN], 1u);
            else XB_SPIN(xb_ld(&bar[XB_TOPGEN]) == tg, bar);
            __builtin_amdgcn_fence(__ATOMIC_ACQUIRE, "agent");
            xb_add(&bar[XB_XGEN(b.x)], 1u);
            asm volatile("s_waitcnt vmcnt(0)" ::: "memory");
        } else {
            XB_SPIN(xb_ld(&bar[XB_XGEN(b.x)]) == gen, bar);
            __builtin_amdgcn_fence(__ATOMIC_ACQUIRE, "agent");
            asm volatile("s_waitcnt vmcnt(0)" ::: "memory");
        }
    }
    __syncthreads();
}

__device__ __forceinline__ void xcd_local_barrier(const XcdBarrier& b) {
    asm volatile("s_waitcnt vmcnt(0)" ::: "memory");
    __syncthreads();
    if (threadIdx.x == 0) {
        unsigned* bar = b.bar;
        __builtin_amdgcn_s_waitcnt(0);
        const unsigned nloc = b.st[0];
        const unsigned old = xb_add(&bar[XB_LSUB(b.x)], 1u);
        const unsigned gen = old / nloc;
        if (old + 1u == (gen + 1u) * nloc) (void)xb_add(&bar[XB_LGEN(b.x)], 1u);
        else XB_SPIN(xb_ld(&bar[XB_LGEN(b.x)]) == gen, bar);
        __builtin_amdgcn_fence(__ATOMIC_ACQUIRE, "agent");
        asm volatile("s_waitcnt vmcnt(0)" ::: "memory");
    }
    __syncthreads();
}


constexpr size_t MiB = 1u << 20;
constexpr size_t WS_CTL = 0, CTL_ZERO_BYTES = 1 * MiB;
constexpr size_t WS_WIN = 2 * MiB, WS_WOUT = 7 * MiB, WS_WGU = 9 * MiB, WS_WDN = 20 * MiB, WS_WPG = 26 * MiB, WS_WPP = 28 * MiB;
constexpr size_t WS_SS0 = 28 * MiB + 512 * 1024  , WS_SS1 = 29 * MiB, WS_SS2 = 30 * MiB;
constexpr size_t WS_XN = 32 * MiB;
constexpr size_t WS_Q = 64 * MiB, WS_KIMG = 80 * MiB, WS_VIMG = 96 * MiB, WS_U = 112 * MiB, WS_SLAB = 128 * MiB;
constexpr size_t WS_HM = 64 * MiB;
constexpr size_t WS_PB = 184 * MiB, WS_PROJ = 192 * MiB, WS_MIX = 224 * MiB, WS_END = 256 * MiB;
static_assert(WS_HM + (size_t)M * FF * 2 <= WS_PB && WS_SLAB + 56 * MiB <= WS_PB, "HM overlay");
constexpr int CW_TMO = 0, CW_CODE = 1, CW_QMAX = 32, CW_KMAX = 33, CW_KBAR = 34  , CW_QUEUE = 64, CW_UCNT = 1024  , CW_BAR = 4096;
constexpr int MAX_SPLIT_UNITS = 144;

constexpr int RING_OFF = 0, RING_BYTES = 131072;
constexpr int LDSCTL_OFF = RING_BYTES, MISC_OFF = LDSCTL_OFF + 320;
constexpr int LDS_BYTES = 147456;
constexpr int NWAVES = 8;

__device__ __forceinline__ float wave_sum(float v) {
#pragma unroll
    for (int o = 1; o < 64; o <<= 1) v += __shfl_xor(v, o);
    return v;
}
__device__ __forceinline__ float wave_max(float v) {
#pragma unroll
    for (int o = 1; o < 64; o <<= 1) v = fmaxf(v, __shfl_xor(v, o));
    return v;
}
__device__ __forceinline__ float bflo(unsigned w) { return __builtin_bit_cast(float, w << 16); }
__device__ __forceinline__ float bfhi(unsigned w) { return __builtin_bit_cast(float, w & 0xffff0000u); }

__device__ __forceinline__ void transpose_item(const float* W, int ldw, int K, bf16* WT, int k0, int n0, int dst0, LAS float* scr, int lane, const float* rowgain = nullptr) {
    float v[32];
#pragma unroll
    for (int i = 0; i < 32; ++i) { const int kk = 2 * i + (lane >> 5); v[i] = __builtin_nontemporal_load(&W[(size_t)(k0 + kk) * ldw + n0 + (lane & 31)]); }
    if (rowgain) {
#pragma unroll
        for (int i = 0; i < 32; ++i) v[i] *= rowgain[k0 + 2 * i + (lane >> 5)]; }
#pragma unroll
    for (int i = 0; i < 32; ++i) scr[(2 * i + (lane >> 5)) * 33 + (lane & 31)] = v[i];
    LDS_WAIT(); asm volatile("" ::: "memory");
    const int c = lane & 7;
#pragma unroll
    for (int j = 0; j < 4; ++j) { const int n = (lane >> 3) + 8 * j; const LAS float* s = scr + (8 * c) * 33 + n;
        v4u o; o.x = pk2(s[0 * 33], s[1 * 33]); o.y = pk2(s[2 * 33], s[3 * 33]); o.z = pk2(s[4 * 33], s[5 * 33]); o.w = pk2(s[6 * 33], s[7 * 33]);
        *(GAS v4u*)(WT + (size_t)(dst0 + n) * K + k0 + 8 * c) = o; }
    LDS_WAIT(); asm volatile("" ::: "memory");
}
__device__ __forceinline__ int in_dst_row(int s) {
    if (s < 1024) { const int part = s >> 9, sp = s & 511, tp = sp >> 8, sl = sp & 255, wc = sl >> 6, bj = (sl >> 5) & 1; return (part * 2 + tp) * 256 + 128 * bj + 32 * wc; }
    if (s < 1536) return s;
    if (s < 2048) { const int ch = s - 1536; return 1536 + 256 * (ch >> 7) + (ch & 127); }
    const int ch = s - 2048; return 1536 + 256 * (ch >> 7) + 128 + (ch & 127);
}
struct Args { const float* in[23]; float* out; unsigned char* ws; int ph_lo, ph_hi, li, pad; };

__device__ __forceinline__ void p0_prologue(const Args& a, LAS unsigned char* lds, int vcu, int G, int wave, int lane) {
    LAS float* scr = (LAS float*)(lds + RING_OFF + wave * 16384);
    const int gw = vcu * NWAVES + wave, NGW = G * NWAVES;
    unsigned char* ws = a.ws;
    constexpr int I_IN = 16 * 80, I_PP = 4 * 32;
    for (int it = gw; it < I_IN + I_PP; it += NGW) {
        if (it < I_IN) { const int kb = it / 80, nb = it % 80; transpose_item(a.in[3], NIN, DM, (bf16*)(ws + WS_WIN), 64 * kb, 32 * nb, in_dst_row(32 * nb), scr, lane, a.in[2]); }
        else { const int r = it - I_IN, kb = r / 32, nb = r % 32; transpose_item(a.in[22], DM, PD, (bf16*)(ws + WS_WPP), 64 * kb, 32 * nb, 32 * nb, scr, lane); }
    }
    const float* x = a.in[0]; const float* p = a.in[1];
    bf16* XN = (bf16*)(ws + WS_XN); bf16* PB = (bf16*)(ws + WS_PB); float* SS0 = (float*)(ws + WS_SS0);
    for (int m = gw; m < M; m += NGW) {
        const GAS f32x4* xr = (const GAS f32x4*)(x + (size_t)m * DM) + lane;
        f32x4 v[4]; float s = 0.f;
#pragma unroll
        for (int j = 0; j < 4; ++j) { v[j] = __builtin_nontemporal_load(&xr[64 * j]); s += (v[j].x * v[j].x + v[j].y * v[j].y) + (v[j].z * v[j].z + v[j].w * v[j].w); }
        GAS unsigned long long* o8 = (GAS unsigned long long*)(XN + (size_t)m * DM) + lane;
#pragma unroll
        for (int j = 0; j < 4; ++j) o8[64 * j] = (unsigned long long)pk2(v[j].x, v[j].y) | ((unsigned long long)pk2(v[j].z, v[j].w) << 32);
        const f32x4 pv = __builtin_nontemporal_load(&((const GAS f32x4*)(p + (size_t)m * PD))[lane]);
        ((GAS unsigned long long*)(PB + (size_t)m * PD))[lane] = (unsigned long long)pk2(pv.x, pv.y) | ((unsigned long long)pk2(pv.z, pv.w) << 32);
        s = wave_sum(s);
        if (lane == 0) SS0[m] = s;
    }
}
constexpr int WI_OUT = 16 * 32, WI_G = 16 * 88, WI_DN = 44 * 32, WI_PG = 16 * 32, W_ITEMS = WI_OUT + 2 * WI_G + WI_DN + WI_PG, N_W_UNITS = (W_ITEMS + 31) / 32;
__device__ __forceinline__ void weight_unit(int wu, const Args& a, LAS unsigned char* lds, int wave, int lane) {
    asm volatile("" : "+v"(lane));
    LAS float* scr = (LAS float*)(lds + RING_OFF + wave * 16384);
    unsigned char* ws = a.ws;
    for (int q = 0; q < 4; ++q) {
        int r = wu * 32 + wave * 4 + q; if (r >= W_ITEMS) break;
        if (r < WI_OUT) { const int kb = r / 32, nb = r % 32; transpose_item(a.in[15], DM, DM, (bf16*)(ws + WS_WOUT), 64 * kb, 32 * nb, 32 * nb, scr, lane); continue; } r -= WI_OUT;
        if (r < WI_G) { const int kb = r / 88, nb = r % 88, n0 = 32 * nb; transpose_item(a.in[17], FF, DM, (bf16*)(ws + WS_WGU), 64 * kb, n0, 256 * (n0 >> 7) + (n0 & 127), scr, lane, a.in[16]); continue; } r -= WI_G;
        if (r < WI_G) { const int kb = r / 88, nb = r % 88, n0 = 32 * nb; transpose_item(a.in[18], FF, DM, (bf16*)(ws + WS_WGU), 64 * kb, n0, 256 * (n0 >> 7) + 128 + (n0 & 127), scr, lane, a.in[16]); continue; } r -= WI_G;
        if (r < WI_DN) { const int kb = r / 32, nb = r % 32; transpose_item(a.in[19], DM, FF, (bf16*)(ws + WS_WDN), 64 * kb, 32 * nb, 32 * nb, scr, lane); continue; } r -= WI_DN;
        { const int kb = r / 32, nb = r % 32; transpose_item(a.in[21], DM, DM, (bf16*)(ws + WS_WPG), 64 * kb, 32 * nb, 32 * nb, scr, lane, a.in[20]); }
    }
    __syncthreads();
}

constexpr int CONV_W_LDS = 96 * 1024;
__device__ __forceinline__ void conv_unit(int cu, const bf16* U, const float* cw, const float* cb, const float* lg, const float* lb, bf16* MIX, LAS unsigned char* lds, int tid, int wave, int lane, bool& w_staged) {
    asm volatile("" : "+v"(tid), "+v"(lane));
    const int r0 = cu * 64;
    const f32x4 b0 = *(const f32x4*)(cb + 8 * lane), b1 = *(const f32x4*)(cb + 8 * lane + 4);
    const f32x4 g0 = *(const f32x4*)(lg + 8 * lane), g1 = *(const f32x4*)(lg + 8 * lane + 4), c0 = *(const f32x4*)(lb + 8 * lane), c1 = *(const f32x4*)(lb + 8 * lane + 4);
    if (!w_staged) {
        f32x4 wv[4][2];
#pragma unroll
        for (int k = 0; k < 4; ++k) { const int i = tid + 512 * k; if (i < KC * 64) { wv[k][0] = *(const f32x4*)(cw + 8 * i); wv[k][1] = *(const f32x4*)(cw + 8 * i + 4); } }
#pragma unroll
        for (int k = 0; k < 4; ++k) { const int i = tid + 512 * k; if (i < KC * 64) { v4u o;
            o.x = __builtin_bit_cast(unsigned, __builtin_amdgcn_cvt_pkrtz(wv[k][0].x, wv[k][0].y)); o.y = __builtin_bit_cast(unsigned, __builtin_amdgcn_cvt_pkrtz(wv[k][0].z, wv[k][0].w));
            o.z = __builtin_bit_cast(unsigned, __builtin_amdgcn_cvt_pkrtz(wv[k][1].x, wv[k][1].y)); o.w = __builtin_bit_cast(unsigned, __builtin_amdgcn_cvt_pkrtz(wv[k][1].z, wv[k][1].w));
            *(LAS v4u*)(lds + CONV_W_LDS + i * 16) = o; } }
        w_staged = true;
    }
    { v4u uv[12];
#pragma unroll
      for (int k = 0; k < 12; ++k) { const int i = tid + 512 * k, rr = i >> 6, pc = i & 63, r = r0 - 15 + rr, rc = r < 0 ? 0 : (r > M - 1 ? M - 1 : r);
          uv[k] = *(const GAS v4u*)(U + (size_t)rc * CW + pc * 8); }
#pragma unroll
      for (int k = 0; k < 12; ++k) { const int i = tid + 512 * k, rr = i >> 6, pc = i & 63, r = r0 - 15 + rr; const bool in = r >= 0 && r < M;
          v4u v = uv[k]; v.x = in ? v.x : 0u; v.y = in ? v.y : 0u; v.z = in ? v.z : 0u; v.w = in ? v.w : 0u;
          if (i < 94 * 64) *(LAS v4u*)(lds + rr * 1024 + pc * 16) = v; } }
    __syncthreads();
    typedef _Float16 h2 __attribute__((ext_vector_type(2)));
    h2 hacc[8][4];
    { const h2 i0 = __builtin_bit_cast(h2, __builtin_amdgcn_cvt_pkrtz(b0.x, b0.y)), i1 = __builtin_bit_cast(h2, __builtin_amdgcn_cvt_pkrtz(b0.z, b0.w)), i2 = __builtin_bit_cast(h2, __builtin_amdgcn_cvt_pkrtz(b1.x, b1.y)), i3 = __builtin_bit_cast(h2, __builtin_amdgcn_cvt_pkrtz(b1.z, b1.w));
#pragma unroll
      for (int j = 0; j < 8; ++j) { hacc[j][0] = i0; hacc[j][1] = i1; hacc[j][2] = i2; hacc[j][3] = i3; } }
    {
        typedef _Float16 h8 __attribute__((ext_vector_type(8)));
        const LAS unsigned char* ub = lds + (wave * 8) * 1024 + lane * 16; const LAS unsigned char* wb = lds + CONV_W_LDS + lane * 16;
        h8 uu[8];
#pragma unroll
        for (int j = 0; j < 7; ++j) uu[j] = *(const LAS h8*)(ub + j * 1024);
        h8 kw = *(const LAS h8*)(wb);
#pragma unroll
        for (int t = 0; t < KC; ++t) {
            uu[(t + 7) & 7] = *(const LAS h8*)(ub + (t + 7) * 1024);
            const h8 kwn = *(const LAS h8*)(wb + (t + 1 < KC ? t + 1 : t) * 1024);
            const h2 k0 = __builtin_shufflevector(kw, kw, 0, 1), k1 = __builtin_shufflevector(kw, kw, 2, 3), k2 = __builtin_shufflevector(kw, kw, 4, 5), k3 = __builtin_shufflevector(kw, kw, 6, 7);
#pragma unroll
            for (int j = 0; j < 8; ++j) { const h8 u = uu[(t + j) & 7];
                hacc[j][0] = __builtin_shufflevector(u, u, 0, 1) * k0 + hacc[j][0]; hacc[j][1] = __builtin_shufflevector(u, u, 2, 3) * k1 + hacc[j][1];
                hacc[j][2] = __builtin_shufflevector(u, u, 4, 5) * k2 + hacc[j][2]; hacc[j][3] = __builtin_shufflevector(u, u, 6, 7) * k3 + hacc[j][3]; }
            kw = kwn;
        }
    }
    float acc[8][8];
#pragma unroll
    for (int j = 0; j < 8; ++j)
#pragma unroll
        for (int k = 0; k < 4; ++k) { acc[j][2 * k] = (float)hacc[j][k][0]; acc[j][2 * k + 1] = (float)hacc[j][k][1]; }
#pragma unroll
    for (int j = 0; j < 8; ++j) {
        float s = ((acc[j][0] + acc[j][1]) + (acc[j][2] + acc[j][3])) + ((acc[j][4] + acc[j][5]) + (acc[j][6] + acc[j][7]));
        const float mu = wave_sum(s) * (1.f / CW); float q = 0.f;
#pragma unroll
        for (int e = 0; e < 8; ++e) { acc[j][e] -= mu; q += acc[j][e] * acc[j][e]; }
        const float r = rsqrtf(wave_sum(q) * (1.f / CW) + EPS);
        float z[8];
        z[0] = acc[j][0] * r * g0.x + c0.x; z[1] = acc[j][1] * r * g0.y + c0.y; z[2] = acc[j][2] * r * g0.z + c0.z; z[3] = acc[j][3] * r * g0.w + c0.w;
        z[4] = acc[j][4] * r * g1.x + c1.x; z[5] = acc[j][5] * r * g1.y + c1.y; z[6] = acc[j][6] * r * g1.z + c1.z; z[7] = acc[j][7] * r * g1.w + c1.w;
#pragma unroll
        for (int e = 0; e < 8; ++e) z[e] = z[e] * fsigmoid(z[e]);
        v4u o; o.x = pk2(z[0], z[1]); o.y = pk2(z[2], z[3]); o.z = pk2(z[4], z[5]); o.w = pk2(z[6], z[7]);
        *(GAS v4u*)(MIX + (size_t)(r0 + wave * 8 + j) * DM + AW + 8 * lane) = o;
    }
    __syncthreads();
}

namespace att {
typedef short bf16x8 __attribute__((ext_vector_type(8)));
typedef short s16x4 __attribute__((ext_vector_type(4)));
typedef float f32x16 __attribute__((ext_vector_type(16)));
typedef float f32x4 __attribute__((ext_vector_type(4)));
typedef unsigned u32x4 __attribute__((ext_vector_type(4)));
constexpr int LDS_HN = 8 * 16384 + 13312;
constexpr int SLOT = 16384, LDS_K = 0, LDS_V = 4 * SLOT, LDS_WS = 8 * SLOT + 4096  , XSTRIDE = 132, SLAB_FLOATS = 8 * 4160;
typedef __attribute__((address_space(3))) const char* lds_cptr;
typedef short v4i16_t __attribute__((ext_vector_type(4)));
__device__ __forceinline__ int crow(int r, int hi) { return (r & 3) + 8 * (r >> 2) + 4 * hi; }
__device__ __forceinline__ void glds2k(const unsigned char* sbase, unsigned voff, unsigned lds_dst) { unsigned keep; const unsigned lds_dst2 = lds_dst + 1024u, voff2 = voff + 1024u;
    asm volatile("s_mov_b32 %0, m0\n\ts_mov_b32 m0, %3\n\ts_nop 0\n\tglobal_load_lds_dwordx4 %1, %2\n\ts_nop 0\n\ts_mov_b32 m0, %4\n\ts_nop 0\n\tglobal_load_lds_dwordx4 %5, %2\n\ts_nop 0\n\ts_mov_b32 m0, %0"
                 : "=&s"(keep) : "v"(voff), "s"(sbase), "s"(lds_dst), "s"(lds_dst2), "v"(voff2) : "memory"); }
#define ATT_WAIT_BAR(N) asm volatile("s_waitcnt vmcnt(" #N ") lgkmcnt(0)\n\ts_barrier" ::: "memory")
__device__ __forceinline__ unsigned cvtpk(float lo, float hi) { unsigned r; asm volatile("v_cvt_pk_bf16_f32 %0, %1, %2" : "=v"(r) : "v"(lo), "v"(hi)); return r; }
__device__ __forceinline__ int v_rd_base(int lane) { return (lane & 31) * 32 + (lane >> 5) * 16; }
__device__ __forceinline__ s16x4 vtr(lds_cptr p) { return __builtin_bit_cast(s16x4, __builtin_amdgcn_ds_read_tr16_b64_v4i16((__attribute__((address_space(3))) v4i16_t*)p)); }
#define SBAR() __builtin_amdgcn_sched_barrier(0)
__device__ __forceinline__ void qkt_acc(f32x16& p0, f32x16& p1, lds_cptr kp, const bf16x8* qr) {
#pragma unroll
    for (int d0 = 0; d0 < 4; ++d0) {
        const bf16x8 b0 = *(const __attribute__((address_space(3))) bf16x8*)(kp + d0 * 2048);
        const bf16x8 b1 = *(const __attribute__((address_space(3))) bf16x8*)(kp + d0 * 2048 + 512);
        p0 = __builtin_amdgcn_mfma_f32_32x32x16_bf16(b0, qr[d0], p0, 0, 0, 0);
        p1 = __builtin_amdgcn_mfma_f32_32x32x16_bf16(b1, qr[d0], p1, 0, 0, 0);
    }
}
__device__ __forceinline__ void bias_general(f32x16& p0, f32x16& p1, float dq, float nslope2, float shift2) {
#pragma unroll
    for (int r = 0; r < 16; ++r) { const float c = (float)((r & 3) + 8 * (r >> 2)); p0[r] = __builtin_fmaf(nslope2, __builtin_fabsf(dq - c), -shift2); p1[r] = __builtin_fmaf(nslope2, __builtin_fabsf(dq - (c + 32.f)), -shift2); }
}
__device__ __forceinline__ void softmax_first(f32x16& p0, f32x16& p1, bf16x8& pa0, bf16x8& pa1, bf16x8& pa2) {
#pragma unroll
    for (int r = 0; r < 16; ++r) { p0[r] = __builtin_amdgcn_exp2f(p0[r]); p1[r] = __builtin_amdgcn_exp2f(p1[r]); }
    { u32x4 w = {cvtpk(p0[0], p0[1]), cvtpk(p0[2], p0[3]), cvtpk(p0[4], p0[5]), cvtpk(p0[6], p0[7])}; pa0 = __builtin_bit_cast(bf16x8, w); }
    { u32x4 w = {cvtpk(p0[8], p0[9]), cvtpk(p0[10], p0[11]), cvtpk(p0[12], p0[13]), cvtpk(p0[14], p0[15])}; pa1 = __builtin_bit_cast(bf16x8, w); }
    { u32x4 w = {cvtpk(p1[0], p1[1]), cvtpk(p1[2], p1[3]), cvtpk(p1[4], p1[5]), cvtpk(p1[6], p1[7])}; pa2 = __builtin_bit_cast(bf16x8, w); }
}
template <int KBITS> __device__ __forceinline__ float fmamk_s(float a, float c) { float r; asm("v_fmamk_f32 %0, %1, %2, %3" : "=v"(r) : "v"(a), "n"(KBITS), "v"(c)); return r; }
#define ATT_ROT3(x) do { (x) = ((x) + SLOT) & (4 * SLOT - 1); } while (0)
#define ATT_DMA2(src, tile, dstoff) do { int t_ = (tile); t_ = t_ < t_hi ? t_ : t_hi; glds2k((src) + (size_t)t_ * SLOT, lane16, (unsigned)(dstoff)); } while (0)
#define ATT_ISSUE_DMA() do { ATT_DMA2(ksrc, tj + 4, kdst + sk_dma); ATT_DMA2(vsrc, tj + 2, vdst + sv_dma); ++tj; } while (0)
#define ATT_STEP(P0, P1, X0, X1, DO_EXP, DO_QK, JJ) do { \
    if (lead_half || (JJ) == 0) { ATT_WAIT_BAR(4); } \
    ATT_ISSUE_DMA(); \
    { const lds_cptr vb_ = vp0 + sv_cur; const lds_cptr kb_ = kp0 + sk_cur; \
      bf16x8 vf0, vf1, vf2; bf16x8 kf0, kf1, kf2; unsigned t0_, t1_, t2_, t3_; \
      const int k02_ = (tj + 1) * 64  ; const bool right_ = k02_ >= qw0 + 31, mixed_ = !right_ && (k02_ + 63 > qw0); \
      const float dq2_ = dq1 - 64.f, ss_ = right_ ? nslope2 : -nslope2, xl0_ = __builtin_fmaf(-ss_, dq2_, -shift2), xl1_ = __builtin_fmaf(ss_, 32.f, xl0_); \
      vf0 = *(const __attribute__((address_space(3))) bf16x8*)(vb_ + 0); vf1 = *(const __attribute__((address_space(3))) bf16x8*)(vb_ + 1024); SBAR(); \
      vf2 = *(const __attribute__((address_space(3))) bf16x8*)(vb_ + 2048); o[0] = __builtin_amdgcn_mfma_f32_32x32x16_bf16(pa0, vf0, o[0], 0, 0, 0); if (DO_EXP) { X0[0] = __builtin_amdgcn_exp2f(X0[0]); } t0_ = cvtpk(P1[8], P1[9]); t1_ = cvtpk(P1[10], P1[11]); SBAR(); \
      vf0 = *(const __attribute__((address_space(3))) bf16x8*)(vb_ + 3072); o[1] = __builtin_amdgcn_mfma_f32_32x32x16_bf16(pa0, vf1, o[1], 0, 0, 0); if (DO_EXP) { X0[1] = __builtin_amdgcn_exp2f(X0[1]); } t2_ = cvtpk(P1[12], P1[13]); t3_ = cvtpk(P1[14], P1[15]); { u32x4 w_ = {t0_, t1_, t2_, t3_}; pa3 = __builtin_bit_cast(bf16x8, w_); } SBAR(); \
      vf1 = *(const __attribute__((address_space(3))) bf16x8*)(vb_ + 4096); o[2] = __builtin_amdgcn_mfma_f32_32x32x16_bf16(pa0, vf2, o[2], 0, 0, 0); if (DO_EXP) { X0[2] = __builtin_amdgcn_exp2f(X0[2]); } if (DO_EXP) { X0[3] = __builtin_amdgcn_exp2f(X0[3]); } SBAR(); \
      vf2 = *(const __attribute__((address_space(3))) bf16x8*)(vb_ + 5120); o[3] = __builtin_amdgcn_mfma_f32_32x32x16_bf16(pa0, vf0, o[3], 0, 0, 0); lacc4 = __builtin_amdgcn_mfma_f32_16x16x32_bf16(lmask, pa0, lacc4, 0, 0, 0); if (DO_EXP) { X0[4] = __builtin_amdgcn_exp2f(X0[4]); } if (DO_QK) { P0[0] = fmamk_s<0>(ss_, xl0_); } if (DO_QK) { P0[1] = fmamk_s<1065353216>(ss_, xl0_); } if (DO_QK) { P0[2] = fmamk_s<1073741824>(ss_, xl0_); } SBAR(); \
      vf0 = *(const __attribute__((address_space(3))) bf16x8*)(vb_ + 6144); o[0] = __builtin_amdgcn_mfma_f32_32x32x16_bf16(pa1, vf1, o[0], 0, 0, 0); if (DO_EXP) { X0[5] = __builtin_amdgcn_exp2f(X0[5]); } if (DO_QK) { P0[3] = fmamk_s<1077936128>(ss_, xl0_); } if (DO_QK) { P0[4] = fmamk_s<1090519040>(ss_, xl0_); } SBAR(); \
      vf1 = *(const __attribute__((address_space(3))) bf16x8*)(vb_ + 7168); o[1] = __builtin_amdgcn_mfma_f32_32x32x16_bf16(pa1, vf2, o[1], 0, 0, 0); if (DO_EXP) { X0[6] = __builtin_amdgcn_exp2f(X0[6]); } if (DO_EXP) { X0[7] = __builtin_amdgcn_exp2f(X0[7]); } if (DO_QK) { P0[5] = fmamk_s<1091567616>(ss_, xl0_); } if (DO_QK) { P0[6] = fmamk_s<1092616192>(ss_, xl0_); } if (DO_QK) { P0[7] = fmamk_s<1093664768>(ss_, xl0_); } SBAR(); \
      vf2 = *(const __attribute__((address_space(3))) bf16x8*)(vb_ + 8192); o[2] = __builtin_amdgcn_mfma_f32_32x32x16_bf16(pa1, vf0, o[2], 0, 0, 0); if (DO_EXP) { X0[8] = __builtin_amdgcn_exp2f(X0[8]); } if (DO_EXP) { t0_ = cvtpk(X0[0], X0[1]); t1_ = cvtpk(X0[2], X0[3]); } if (DO_QK) { P0[8] = fmamk_s<1098907648>(ss_, xl0_); } if (DO_QK) { P0[9] = fmamk_s<1099431936>(ss_, xl0_); } SBAR(); \
      vf0 = *(const __attribute__((address_space(3))) bf16x8*)(vb_ + 9216); o[3] = __builtin_amdgcn_mfma_f32_32x32x16_bf16(pa1, vf1, o[3], 0, 0, 0); lacc4 = __builtin_amdgcn_mfma_f32_16x16x32_bf16(lmask, pa1, lacc4, 0, 0, 0); if (DO_EXP) { X0[9] = __builtin_amdgcn_exp2f(X0[9]); } if (DO_EXP) { t2_ = cvtpk(X0[4], X0[5]); t3_ = cvtpk(X0[6], X0[7]); { u32x4 w_ = {t0_, t1_, t2_, t3_}; pa0 = __builtin_bit_cast(bf16x8, w_); } } if (DO_QK) { P0[10] = fmamk_s<1099956224>(ss_, xl0_); } if (DO_QK) { P0[11] = fmamk_s<1100480512>(ss_, xl0_); } if (DO_QK) { P0[12] = fmamk_s<1103101952>(ss_, xl0_); } SBAR(); \
      vf1 = *(const __attribute__((address_space(3))) bf16x8*)(vb_ + 10240); o[0] = __builtin_amdgcn_mfma_f32_32x32x16_bf16(pa2, vf2, o[0], 0, 0, 0); if (DO_EXP) { X0[10] = __builtin_amdgcn_exp2f(X0[10]); } if (DO_EXP) { X0[11] = __builtin_amdgcn_exp2f(X0[11]); } if (DO_QK) { P0[13] = fmamk_s<1103626240>(ss_, xl0_); } if (DO_QK) { P0[14] = fmamk_s<1104150528>(ss_, xl0_); } SBAR(); \
      vf2 = *(const __attribute__((address_space(3))) bf16x8*)(vb_ + 11264); o[1] = __builtin_amdgcn_mfma_f32_32x32x16_bf16(pa2, vf0, o[1], 0, 0, 0); if (DO_EXP) { X0[12] = __builtin_amdgcn_exp2f(X0[12]); } if (DO_QK) { P0[15] = fmamk_s<1104674816>(ss_, xl0_); } if (DO_QK) { P1[0] = fmamk_s<0>(ss_, xl1_); } if (DO_QK) { P1[1] = fmamk_s<1065353216>(ss_, xl1_); } SBAR(); \
      vf0 = *(const __attribute__((address_space(3))) bf16x8*)(vb_ + 12288); o[2] = __builtin_amdgcn_mfma_f32_32x32x16_bf16(pa2, vf1, o[2], 0, 0, 0); if (DO_EXP) { X0[13] = __builtin_amdgcn_exp2f(X0[13]); } if (DO_QK) { P1[2] = fmamk_s<1073741824>(ss_, xl1_); } if (DO_QK) { P1[3] = fmamk_s<1077936128>(ss_, xl1_); } SBAR(); \
      vf1 = *(const __attribute__((address_space(3))) bf16x8*)(vb_ + 13312); o[3] = __builtin_amdgcn_mfma_f32_32x32x16_bf16(pa2, vf2, o[3], 0, 0, 0); lacc4 = __builtin_amdgcn_mfma_f32_16x16x32_bf16(lmask, pa2, lacc4, 0, 0, 0); if (DO_EXP) { X0[14] = __builtin_amdgcn_exp2f(X0[14]); } if (DO_EXP) { X0[15] = __builtin_amdgcn_exp2f(X0[15]); } if (DO_QK) { P1[4] = fmamk_s<1090519040>(ss_, xl1_); } if (DO_QK) { P1[5] = fmamk_s<1091567616>(ss_, xl1_); } if (DO_QK) { P1[6] = fmamk_s<1092616192>(ss_, xl1_); } SBAR(); \
      if (!lead_half && (JJ) + 1 < NT) { ATT_WAIT_BAR(4); }     \
      vf2 = *(const __attribute__((address_space(3))) bf16x8*)(vb_ + 14336); o[0] = __builtin_amdgcn_mfma_f32_32x32x16_bf16(pa3, vf0, o[0], 0, 0, 0); if (DO_EXP) { X1[0] = __builtin_amdgcn_exp2f(X1[0]); } if (DO_EXP) { t0_ = cvtpk(X0[8], X0[9]); t1_ = cvtpk(X0[10], X0[11]); } if (DO_QK) { P1[7] = fmamk_s<1093664768>(ss_, xl1_); } if (DO_QK) { P1[8] = fmamk_s<1098907648>(ss_, xl1_); } SBAR(); \
      vf0 = *(const __attribute__((address_space(3))) bf16x8*)(vb_ + 15360); o[1] = __builtin_amdgcn_mfma_f32_32x32x16_bf16(pa3, vf1, o[1], 0, 0, 0); if (DO_EXP) { X1[1] = __builtin_amdgcn_exp2f(X1[1]); } if (DO_EXP) { t2_ = cvtpk(X0[12], X0[13]); t3_ = cvtpk(X0[14], X0[15]); { u32x4 w_ = {t0_, t1_, t2_, t3_}; pa1 = __builtin_bit_cast(bf16x8, w_); } } if (DO_QK) { P1[9] = fmamk_s<1099431936>(ss_, xl1_); } if (DO_QK) { P1[10] = fmamk_s<1099956224>(ss_, xl1_); } if (DO_QK) { P1[11] = fmamk_s<1100480512>(ss_, xl1_); } SBAR(); \
      if (DO_QK) kf0 = *(const __attribute__((address_space(3))) bf16x8*)(kb_ + 0); o[2] = __builtin_amdgcn_mfma_f32_32x32x16_bf16(pa3, vf2, o[2], 0, 0, 0); if (DO_EXP) { X1[2] = __builtin_amdgcn_exp2f(X1[2]); } if (DO_EXP) { X1[3] = __builtin_amdgcn_exp2f(X1[3]); } if (DO_QK) { P1[12] = fmamk_s<1103101952>(ss_, xl1_); } if (DO_QK) { P1[13] = fmamk_s<1103626240>(ss_, xl1_); } SBAR(); \
      if (DO_QK) kf1 = *(const __attribute__((address_space(3))) bf16x8*)(kb_ + 512); o[3] = __builtin_amdgcn_mfma_f32_32x32x16_bf16(pa3, vf0, o[3], 0, 0, 0); lacc4 = __builtin_amdgcn_mfma_f32_16x16x32_bf16(lmask, pa3, lacc4, 0, 0, 0); if (DO_EXP) { X1[4] = __builtin_amdgcn_exp2f(X1[4]); } if (DO_QK) { P1[14] = fmamk_s<1104150528>(ss_, xl1_); } if (DO_QK) { P1[15] = fmamk_s<1104674816>(ss_, xl1_); } SBAR(); if (DO_QK && mixed_) { const float c2_ = -2.f * nslope2; P0[0] += c2_ * __builtin_fminf(dq2_ - 0.f, 0.f); P0[1] += c2_ * __builtin_fminf(dq2_ - 1.f, 0.f); P0[2] += c2_ * __builtin_fminf(dq2_ - 2.f, 0.f); P0[3] += c2_ * __builtin_fminf(dq2_ - 3.f, 0.f); P0[4] += c2_ * __builtin_fminf(dq2_ - 8.f, 0.f); P0[5] += c2_ * __builtin_fminf(dq2_ - 9.f, 0.f); P0[6] += c2_ * __builtin_fminf(dq2_ - 10.f, 0.f); P0[7] += c2_ * __builtin_fminf(dq2_ - 11.f, 0.f); P0[8] += c2_ * __builtin_fminf(dq2_ - 16.f, 0.f); P0[9] += c2_ * __builtin_fminf(dq2_ - 17.f, 0.f); P0[10] += c2_ * __builtin_fminf(dq2_ - 18.f, 0.f); P0[11] += c2_ * __builtin_fminf(dq2_ - 19.f, 0.f); P0[12] += c2_ * __builtin_fminf(dq2_ - 24.f, 0.f); P0[13] += c2_ * __builtin_fminf(dq2_ - 25.f, 0.f); P0[14] += c2_ * __builtin_fminf(dq2_ - 26.f, 0.f); P0[15] += c2_ * __builtin_fminf(dq2_ - 27.f, 0.f); P1[0] += c2_ * __builtin_fminf(dq2_ - 32.f, 0.f); P1[1] += c2_ * __builtin_fminf(dq2_ - 33.f, 0.f); P1[2] += c2_ * __builtin_fminf(dq2_ - 34.f, 0.f); P1[3] += c2_ * __builtin_fminf(dq2_ - 35.f, 0.f); P1[4] += c2_ * __builtin_fminf(dq2_ - 40.f, 0.f); P1[5] += c2_ * __builtin_fminf(dq2_ - 41.f, 0.f); P1[6] += c2_ * __builtin_fminf(dq2_ - 42.f, 0.f); P1[7] += c2_ * __builtin_fminf(dq2_ - 43.f, 0.f); P1[8] += c2_ * __builtin_fminf(dq2_ - 48.f, 0.f); P1[9] += c2_ * __builtin_fminf(dq2_ - 49.f, 0.f); P1[10] += c2_ * __builtin_fminf(dq2_ - 50.f, 0.f); P1[11] += c2_ * __builtin_fminf(dq2_ - 51.f, 0.f); P1[12] += c2_ * __builtin_fminf(dq2_ - 56.f, 0.f); P1[13] += c2_ * __builtin_fminf(dq2_ - 57.f, 0.f); P1[14] += c2_ * __builtin_fminf(dq2_ - 58.f, 0.f); P1[15] += c2_ * __builtin_fminf(dq2_ - 59.f, 0.f); } SBAR(); \
      if (DO_QK) kf2 = *(const __attribute__((address_space(3))) bf16x8*)(kb_ + 2048); if (DO_QK) P0 = __builtin_amdgcn_mfma_f32_32x32x16_bf16(kf0, qr[0], P0, 0, 0, 0); if (DO_EXP) { X1[5] = __builtin_amdgcn_exp2f(X1[5]); } SBAR(); \
      if (DO_QK) kf0 = *(const __attribute__((address_space(3))) bf16x8*)(kb_ + 2560); if (DO_QK) P1 = __builtin_amdgcn_mfma_f32_32x32x16_bf16(kf1, qr[0], P1, 0, 0, 0); if (DO_EXP) { X1[6] = __builtin_amdgcn_exp2f(X1[6]); } if (DO_EXP) { X1[7] = __builtin_amdgcn_exp2f(X1[7]); } SBAR(); \
      if (DO_QK) kf1 = *(const __attribute__((address_space(3))) bf16x8*)(kb_ + 4096); if (DO_QK) P0 = __builtin_amdgcn_mfma_f32_32x32x16_bf16(kf2, qr[1], P0, 0, 0, 0); if (DO_EXP) { X1[8] = __builtin_amdgcn_exp2f(X1[8]); } if (DO_EXP) { t0_ = cvtpk(X1[0], X1[1]); t1_ = cvtpk(X1[2], X1[3]); } SBAR(); \
      if (DO_QK) kf2 = *(const __attribute__((address_space(3))) bf16x8*)(kb_ + 4608); if (DO_QK) P1 = __builtin_amdgcn_mfma_f32_32x32x16_bf16(kf0, qr[1], P1, 0, 0, 0); if (DO_EXP) { X1[9] = __builtin_amdgcn_exp2f(X1[9]); } if (DO_EXP) { t2_ = cvtpk(X1[4], X1[5]); t3_ = cvtpk(X1[6], X1[7]); { u32x4 w_ = {t0_, t1_, t2_, t3_}; pa2 = __builtin_bit_cast(bf16x8, w_); } } SBAR(); \
      if (DO_QK) kf0 = *(const __attribute__((address_space(3))) bf16x8*)(kb_ + 6144); if (DO_QK) P0 = __builtin_amdgcn_mfma_f32_32x32x16_bf16(kf1, qr[2], P0, 0, 0, 0); if (DO_EXP) { X1[10] = __builtin_amdgcn_exp2f(X1[10]); } if (DO_EXP) { X1[11] = __builtin_amdgcn_exp2f(X1[11]); } SBAR(); \
      if (DO_QK) kf1 = *(const __attribute__((address_space(3))) bf16x8*)(kb_ + 6656); if (DO_QK) P1 = __builtin_amdgcn_mfma_f32_32x32x16_bf16(kf2, qr[2], P1, 0, 0, 0); if (DO_EXP) { X1[12] = __builtin_amdgcn_exp2f(X1[12]); } SBAR(); \
      if (DO_QK) P0 = __builtin_amdgcn_mfma_f32_32x32x16_bf16(kf0, qr[3], P0, 0, 0, 0); if (DO_EXP) { X1[13] = __builtin_amdgcn_exp2f(X1[13]); } SBAR(); \
      if (DO_QK) P1 = __builtin_amdgcn_mfma_f32_32x32x16_bf16(kf1, qr[3], P1, 0, 0, 0); if (DO_EXP) { X1[14] = __builtin_amdgcn_exp2f(X1[14]); } if (DO_EXP) { X1[15] = __builtin_amdgcn_exp2f(X1[15]); } SBAR(); \
    } \
    dq1 -= 64.f; ATT_ROT3(sk_cur); ATT_ROT3(sv_cur); ATT_ROT3(sk_dma); ATT_ROT3(sv_dma); } while (0)

struct UnitDesc { int u, h, qb, nc, ci, sid, t_lo, t_hi; float slope; };
constexpr int ITEM_FROM_PRE = 8192 - 1024;
__device__ __forceinline__ float att_window(float Bn, float Cn, float slope) {
    const float a1 = 2.f * Bn + 18.2f, a2 = Bn + Cn + 63.f * slope + __logf(1.f / (64.f * slope)) + 18.2f;
    return (ATT_EXACT_ZERO ? 104.f + 2.f * Bn : fminf(a1, a2)) / slope;
}
__device__ __forceinline__ UnitDesc decode_unit(int idx, float Bn, float Cn, const __attribute__((address_space(3))) unsigned short* pre, const __attribute__((address_space(3))) unsigned short* sidx) {
    UnitDesc d;
    const unsigned it_ = (unsigned)__builtin_amdgcn_readfirstlane((int)((const __attribute__((address_space(3))) unsigned*)((const __attribute__((address_space(3))) unsigned char*)pre + ITEM_FROM_PRE))[idx]);
    d.u = (int)(it_ & 511u); d.ci = (int)((it_ >> 10) & 3u); d.nc = (int)((it_ >> 12) & 3u); d.sid = __builtin_amdgcn_readfirstlane((int)sidx[d.u]);
    const int k = d.u & 127; d.h = 3 - (d.u >> 7); d.qb = (k & 1) ? 63 - (k >> 1) : 64 + (k >> 1);
    d.slope = exp2f(-2.f * (float)(d.h + 1));
    const float Rf = att_window(Bn, Cn, d.slope);
    const int R = __builtin_amdgcn_readfirstlane(Rf < 20000.f ? (int)Rf + 1 : 20000);
    const int q0 = d.qb * 128; const int klo = q0 - R < 0 ? 0 : q0 - R, khi = q0 + 127 + R > M - 1 ? M - 1 : q0 + 127 + R;
    const int tlo = klo >> 6, nt = (khi >> 6) - tlo + 1, base = nt / d.nc, rem = nt - base * d.nc;
    d.t_lo = tlo + d.ci * base + (d.ci < rem ? d.ci : rem); d.t_hi = d.t_lo + base + (d.ci < rem ? 1 : 0) - 1;
    return d;
}
__device__ __forceinline__ void attn_unit(int idx, float Bn, float Cn, float lam, const __attribute__((address_space(3))) unsigned short* pre, const __attribute__((address_space(3))) unsigned short* sidx,
                                          const unsigned short* Q, const unsigned char* Kimg, const unsigned char* Vimg, unsigned short* MIX, const float* hn, char* shm,
                                          float* slabs, unsigned* cnts, volatile __attribute__((address_space(3))) unsigned* bcast) {
    const int tid = threadIdx.x, lane = tid & 63, r32 = lane & 31, hi = lane >> 5; const int wid = __builtin_amdgcn_readfirstlane(tid >> 6), rg = wid >> 1, mp = wid & 1;
    const UnitDesc D = decode_unit(idx, Bn, Cn, pre, sidx);
    const int h = D.h, t_lo = D.t_lo, t_hi = D.t_hi; const float slope2 = D.slope * LOG2E;
    const float shift2 = fmaxf(0.f, Bn * LOG2E - 24.f);
    const int q0 = D.qb * 128, NT = t_hi - t_lo + 1;
    const unsigned lds0 = (unsigned)(uintptr_t)shm;
    const unsigned char* ksrc = Kimg + (size_t)h * 256 * SLOT + wid * 2048;
    const unsigned char* vsrc = Vimg + (size_t)h * 256 * SLOT + wid * 2048;
    const unsigned lane16 = (unsigned)lane * 16u;
    const unsigned kdst = lds0 + LDS_K + wid * 2048, vdst = lds0 + LDS_V + wid * 2048;
    const unsigned short* Qw = Q + (size_t)(q0 + rg * 32 + r32) * AW + h * 128 + mp * 64 + hi * 8;
    bf16x8 qr[4];
#pragma unroll
    for (int d0 = 0; d0 < 4; ++d0) qr[d0] = *(const bf16x8*)(Qw + d0 * 16);
    int tj = t_lo;
    ATT_DMA2(ksrc, tj, kdst); ATT_DMA2(ksrc, tj + 1, kdst + SLOT); ATT_DMA2(vsrc, tj, vdst); ATT_DMA2(ksrc, tj + 2, kdst + 2 * SLOT); ATT_DMA2(ksrc, tj + 3, kdst + 3 * SLOT); ATT_DMA2(vsrc, tj + 1, vdst + SLOT);
    const lds_cptr shm3 = (lds_cptr)shm;
    const lds_cptr kp0 = shm3 + LDS_K + (8 * mp + hi) * 1024 + r32 * 16;
    const lds_cptr vp0 = shm3 + LDS_V + v_rd_base(lane);
    const float dq0 = (float)(q0 + rg * 32 + r32 - t_lo * 64 - 4 * hi);
    const int qw0 = q0 + rg * 32;
    const float nslope2 = -slope2;
    f32x16 o[4]; o[0] = f32x16{}; o[1] = f32x16{}; o[2] = f32x16{}; o[3] = f32x16{};
    f32x4 lacc4 = f32x4{0.f, 0.f, 0.f, 0.f};
    bf16x8 lmask; { const int row_ = lane & 15, kg_ = lane >> 4; const bool on_ = (((row_ & 7) == 0) && ((kg_ & 1) == 0)) || (((row_ & 7) == 4) && ((kg_ & 1) == 1));
                    const short one_ = on_ ? (short)0x3F80 : (short)0; lmask = (bf16x8){one_, one_, one_, one_, one_, one_, one_, one_}; }
    f32x16 sA0, sA1, sB0, sB1; bf16x8 pa0, pa1, pa2, pa3 = bf16x8{};
    bias_general(sA0, sA1, dq0, nslope2, shift2);
    bias_general(sB0, sB1, dq0 - 64.f, nslope2, shift2);
    ATT_WAIT_BAR(8);
    qkt_acc(sA0, sA1, kp0, qr);
    qkt_acc(sB0, sB1, kp0 + SLOT, qr);
    softmax_first(sA0, sA1, pa0, pa1, pa2);
    float dq1 = dq0 - 64.f;
    int sk_cur = 2 * SLOT, sv_cur = 0, sk_dma = 0, sv_dma = 2 * SLOT;
    const bool lead_half = wid < 4;
    if (wid >= 4) __builtin_amdgcn_s_setprio(1);
    int j = 0;
    for (; j + 2 < NT; j += 2) { ATT_STEP(sA0, sA1, sB0, sB1, true, true, j); ATT_STEP(sB0, sB1, sA0, sA1, true, true, j + 1); }
    if (NT - j == 2) { ATT_STEP(sA0, sA1, sB0, sB1, true, true, j);
#pragma unroll
        for (int r = 8; r < 16; ++r) sA1[r] = sB1[r];
        ATT_STEP(sA0, sA1, sB0, sB1, false, false, j + 1); }
    else { ATT_STEP(sA0, sA1, sB0, sB1, false, false, j); }
    __builtin_amdgcn_s_setprio(0);
    float l_acc = lacc4[0];
    ATT_WAIT_BAR(0);
    int idx_e = idx; asm volatile("" : "+s"(idx_e));
    int tid_e = threadIdx.x; asm volatile("" : "+v"(tid_e));
    const int lane_e = tid_e & 63, r32_e = lane_e & 31, hi_e = lane_e >> 5, wid_e = __builtin_amdgcn_readfirstlane(tid_e >> 6), rg_e = wid_e >> 1, mp_e = wid_e & 1;
    const UnitDesc E = decode_unit(idx_e, Bn, Cn, pre, sidx);
    const int nc = E.nc, ci = E.ci, h_e = E.h, q0_e = E.qb * 128;
    float* slab_u = slabs + (size_t)E.sid * 3 * SLAB_FLOATS; unsigned* cnt_u = cnts + E.u;
    if (nc > 1) {
        float* sl = slab_u + (size_t)ci * SLAB_FLOATS + wid_e * 4160;
#pragma unroll
        for (int d0 = 0; d0 < 4; ++d0)
#pragma unroll
            for (int i = 0; i < 4; ++i) { const f32x4 v_ = (f32x4){o[d0][4 * i], o[d0][4 * i + 1], o[d0][4 * i + 2], o[d0][4 * i + 3]};
                asm volatile("global_store_dwordx4 %0, %1, off sc1\n\ts_nop 1" :: "v"(sl + ((d0 * 4 + i) * 64 + lane_e) * 4), "v"(v_) : "memory"); }
        asm volatile("global_store_dword %0, %1, off sc1\n\ts_nop 1" :: "v"(sl + 4096 + lane_e), "v"(l_acc) : "memory");
        asm volatile("s_waitcnt vmcnt(0)" ::: "memory");
        __syncthreads();
        if (tid_e == 0) bcast[0] = __hip_atomic_fetch_add(cnt_u, 1u, __ATOMIC_RELAXED, __HIP_MEMORY_SCOPE_AGENT);
        __syncthreads();
        const unsigned old = bcast[0];
        __syncthreads();
        if ((int)old != nc - 1) return;
        if (tid_e == 0) { __builtin_amdgcn_fence(__ATOMIC_ACQUIRE, "agent"); asm volatile("s_waitcnt vmcnt(0)" ::: "memory"); }
        __syncthreads();
        o[0] = f32x16{}; o[1] = f32x16{}; o[2] = f32x16{}; o[3] = f32x16{}; l_acc = 0.f;
        for (int cc = 0; cc < nc; ++cc) { const float* rs = slab_u + (size_t)cc * SLAB_FLOATS + wid_e * 4160;
            f32x4 sv[16];
#pragma unroll
            for (int k = 0; k < 16; ++k) sv[k] = *(const f32x4*)(rs + (k * 64 + lane_e) * 4);
            const float sl_l = rs[4096 + lane_e];
            asm volatile("" :: "v"(sv[0]), "v"(sv[1]), "v"(sv[2]), "v"(sv[3]), "v"(sv[4]), "v"(sv[5]), "v"(sv[6]), "v"(sv[7]), "v"(sv[8]), "v"(sv[9]), "v"(sv[10]), "v"(sv[11]), "v"(sv[12]), "v"(sv[13]), "v"(sv[14]), "v"(sv[15]));
#pragma unroll
            for (int d0 = 0; d0 < 4; ++d0)
#pragma unroll
                for (int i = 0; i < 4; ++i) { const f32x4 v = sv[d0 * 4 + i]; o[d0][4 * i] += v[0]; o[d0][4 * i + 1] += v[1]; o[d0][4 * i + 2] += v[2]; o[d0][4 * i + 3] += v[3]; }
            l_acc += sl_l; }
    }
    float* wsf = (float*)(shm + LDS_WS) + wid_e * 64;
    if (hi_e == 0) wsf[r32_e] = l_acc;
    asm volatile("s_waitcnt lgkmcnt(0)" ::: "memory");
    float rli[16];
#pragma unroll
    for (int r = 0; r < 16; ++r) rli[r] = __builtin_amdgcn_rcpf(wsf[crow(r, hi_e)]);
    float* X = (float*)shm + rg_e * 32 * XSTRIDE;
    if (mp_e == 1) {
#pragma unroll
        for (int r = 0; r < 16; ++r)
#pragma unroll
            for (int d0 = 0; d0 < 4; ++d0) X[crow(r, hi_e) * XSTRIDE + d0 * 32 + r32_e] = lam * o[d0][r] * rli[r];
    }
    ATT_WAIT_BAR(0);
    if (mp_e == 0) {
#pragma unroll
        for (int r = 0; r < 16; ++r)
#pragma unroll
            for (int d0 = 0; d0 < 4; ++d0) { float* xp = X + crow(r, hi_e) * XSTRIDE + d0 * 32 + r32_e; *xp = o[d0][r] * rli[r] - *xp; }
        asm volatile("s_waitcnt lgkmcnt(0)" ::: "memory");
        const float* xr = X + r32_e * XSTRIDE + hi_e * 64;
        f32x4 v[16]; float ss = 0.f;
#pragma unroll
        for (int i = 0; i < 16; ++i) { v[i] = *(const f32x4*)(xr + 4 * i); ss += (v[i][0] * v[i][0] + v[i][1] * v[i][1]) + (v[i][2] * v[i][2] + v[i][3] * v[i][3]); }
        { auto rr = __builtin_amdgcn_permlane32_swap(__float_as_uint(ss), __float_as_uint(ss), false, false); ss = __uint_as_float(rr[0]) + __uint_as_float(rr[1]); }
        const float rn = rsqrtf(ss * (1.f / 128.f) + EPS) * (1.f - LAM_INIT);
        unsigned short* orow = MIX + (size_t)(q0_e + rg_e * 32 + r32_e) * DM + h_e * 128 + hi_e * 64;
        const __attribute__((address_space(3))) f32x4* g = (const __attribute__((address_space(3))) f32x4*)((lds_cptr)shm + LDS_HN + hi_e * 256);
#pragma unroll
        for (int i = 0; i < 8; ++i) { const f32x4 g0 = g[2 * i], g1 = g[2 * i + 1]; const f32x4 a = v[2 * i] * rn * g0, b = v[2 * i + 1] * rn * g1;
            u32x4 w; w.x = cvtpk(a[0], a[1]); w.y = cvtpk(a[2], a[3]); w.z = cvtpk(b[0], b[1]); w.w = cvtpk(b[2], b[3]); *(u32x4*)(orow + 8 * i) = w; }
    }
    ATT_WAIT_BAR(0);
}
}

constexpr int N_LAUNCHES = MK_N_LAUNCHES, PER_PHASE = 7;
constexpr int N_ATT_UNITS = NH * (M / 128), N_CONV_UNITS = M / 64;

__global__ void __launch_bounds__(NWAVES * 64, 2) fwd(Args args) {
    extern __shared__ __attribute__((aligned(16))) unsigned char lds_raw[];
    LAS unsigned char* lds = (LAS unsigned char*)lds_raw;
    volatile LAS unsigned* MISC = (volatile LAS unsigned*)(lds + MISC_OFF);
    const int tid = threadIdx.x, lane = tid & 63, wave = __builtin_amdgcn_readfirstlane(tid >> 6);
    const int G = gridDim.x; const int bx = blockIdx.x; const int vcu = (G % 8 == 0) ? (bx % 8) * (G / 8) + bx / 8 : bx;
    unsigned char* ws = args.ws;
    gu32* ctl = (gu32*)(ws + WS_CTL);
    for (int u = tid; u < (LDS_BYTES - LDSCTL_OFF) / 4; u += NWAVES * 64) ((LAS unsigned*)(lds + LDSCTL_OFF))[u] = 0u;
    __syncthreads();
    XcdBarrier bar; bar.bar = (unsigned*)(ctl + CW_BAR); bar.x = 0; bar.st = nullptr;
    if (N_LAUNCHES != PER_PHASE) bar = xcd_barrier_post((unsigned*)(ctl + CW_BAR), MISC + 8);
#define GRID_BAR() do { if (N_LAUNCHES != PER_PHASE) xcd_barrier(bar); } while (0)
    const int lo = args.ph_lo, hi = args.ph_hi;
#define IN(k) (lo <= (k) && (k) < hi)
#define BOTH(k) (IN(k) && IN((k) + 1))
    bf16* XN = (bf16*)(ws + WS_XN); bf16* Qb = (bf16*)(ws + WS_Q); unsigned char* Kimg = ws + WS_KIMG; unsigned char* Vimg = ws + WS_VIMG; bf16* Ub = (bf16*)(ws + WS_U);
    bf16* MIX = (bf16*)(ws + WS_MIX); bf16* HM = (bf16*)(ws + WS_HM); bf16* PB = (bf16*)(ws + WS_PB); bf16* PR = (bf16*)(ws + WS_PROJ);
    float* SS1 = (float*)(ws + WS_SS1); float* SS2 = (float*)(ws + WS_SS2);

    if (IN(0)) { p0_prologue(args, lds, vcu, G, wave, lane); if (BOTH(0)) GRID_BAR(); }
    int vc = bx; bool xl = false;
    if (N_LAUNCHES == 1 && IN(0)) { xl = __builtin_amdgcn_readfirstlane((int)MISC[11]) != 0; if (xl) vc = (int)bar.x + 8 * __builtin_amdgcn_readfirstlane((int)MISC[10]); }
#define XCD_BAR() do { if (N_LAUNCHES != PER_PHASE) { if (xl) xcd_local_barrier(bar); else xcd_barrier(bar); } } while (0)

    constexpr int NT1 = (M / 256) * (NIN / 256);
    const int first_idle = NT1 - ((NT1 + G - 1) / G - 1) * G, w_p1 = (N_LAUNCHES == 1) ? ((G - first_idle) < N_W_UNITS ? (G - first_idle) : N_W_UNITS) : 0, w_p2 = N_W_UNITS - w_p1;
    if (IN(1)) {
        { pg8::Gemm g{XN, (const bf16*)(ws + WS_WIN), M, NIN, DM}; pg8::StaticOrder S; S.init(M, NIN, G, bx);
          LAS float* rtab = (LAS float*)(lds + LDSCTL_OFF + 12288); int rpm = -1;
          LAS float* gtab = (LAS float*)(lds + LDSCTL_OFF + 13824);
          if (tid >= 256 && tid < 384) gtab[tid - 256] = tid < 320 ? args.in[4][tid - 256] : args.in[5][tid - 320];
          { pg8::Unit u0; if (S.next(0, u0)) { rpm = u0.pm; if (tid < 256) rtab[tid] = rsqrtf(((const float*)(ws + WS_SS0))[rpm * 256 + tid] * (1.f / DM) + EPS); } __syncthreads(); }
          pg8::EpiIn E{Qb, Kimg, Vimg, Ub, args.in[4], args.in[5], (unsigned*)(ctl + CW_QMAX), (const float*)(ws + WS_SS0), rtab, rpm, gtab, (LAS unsigned*)(lds + LDSCTL_OFF + 14400)};
          pg8::gemm_phase<pg8::EpiIn, pg8::StaticOrder, PG8_ALIGN, PG8_SP2>(lds + RING_OFF, g, S, E);
          __syncthreads();
          if (tid < 3) { const unsigned v = ((LAS unsigned*)(lds + LDSCTL_OFF + 14400))[tid]; if (v) atomicMax((unsigned*)(ctl + CW_QMAX) + tid, v); } }
        if (w_p1 > 0 && bx >= first_idle && bx - first_idle < w_p1) weight_unit(bx - first_idle, args, lds, wave, lane);
        if (BOTH(1)) GRID_BAR();
    }

    if (IN(2)) {
        const unsigned mx3 = __hip_atomic_load((unsigned*)(ctl + CW_QMAX) + (lane < 3 ? lane : 0), __ATOMIC_RELAXED, __HIP_MEMORY_SCOPE_AGENT);
        const float qmax = __uint_as_float(__builtin_amdgcn_readlane(mx3, 0)), kmax = __uint_as_float(__builtin_amdgcn_readlane(mx3, 1)), kbar = __uint_as_float(__builtin_amdgcn_readlane(mx3, 2));
        const float Bn = qmax * kmax * (1.02f / LOG2E);
        const float Cn = qmax * kbar * (1.02f / LOG2E) + 0.05f;
        const float d1 = wave_sum(args.in[6][lane] * args.in[7][lane]), d2 = wave_sum(args.in[8][lane] * args.in[9][lane]);
        const float lam = __expf(d1) - __expf(d2) + LAM_INIT;
        LAS unsigned short* pre = (LAS unsigned short*)(lds + LDSCTL_OFF + 1024);
        LAS unsigned short* sidx = (LAS unsigned short*)(lds + LDSCTL_OFF + 2112);
        LAS unsigned* wtot = (LAS unsigned*)(lds + LDSCTL_OFF + 3200);
        if (tid < 128) ((LAS float*)(lds + att::LDS_HN))[tid] = args.in[10][tid];
        { const int u = tid, h = 3 - (u >> 7), k = u & 127, qb = (k & 1) ? 63 - (k >> 1) : 64 + (k >> 1);
          const float slope = exp2f(-2.f * (float)(h + 1));
          const float Rf = att::att_window(Bn, Cn, slope);
          const int R = Rf < 20000.f ? (int)Rf + 1 : 20000;
          const int q0 = qb * 128; const int klo = q0 - R < 0 ? 0 : q0 - R, khi = q0 + 127 + R > M - 1 ? M - 1 : q0 + 127 + R;
          const int my_nt = (khi >> 6) - (klo >> 6) + 1, want = my_nt > 100 ? 1 : 0;
          int v = want;
#pragma unroll
          for (int o = 1; o < 64; o <<= 1) { const int t = __shfl_up(v, o); if (lane >= o) v += t; }
          if (lane == 63) wtot[wave] = (unsigned)v;
          __syncthreads();
          int off = 0;
          for (int w = 0; w < wave; ++w) off += (int)wtot[w];
          const int sid = off + v - want;
          const int my_nc = (want && sid < MAX_SPLIT_UNITS) ? ((my_nt + 63) / 64 < 3 ? (my_nt + 63) / 64 : 3) : 1;
          sidx[u] = (unsigned short)sid;
          v = my_nc;
#pragma unroll
          for (int o = 1; o < 64; o <<= 1) { const int t = __shfl_up(v, o); if (lane >= o) v += t; }
          if (lane == 63) wtot[8 + wave] = (unsigned)v;
          __syncthreads();
          off = 0;
          for (int w = 0; w < wave; ++w) off += (int)wtot[8 + w];
          pre[u] = (unsigned short)(off + v - my_nc);
          if (u == 511) pre[512] = (unsigned short)(off + v);
          { LAS unsigned* item = (LAS unsigned*)(lds + LDSCTL_OFF + 8192);
            for (int ci = 0; ci < my_nc; ++ci) item[off + v - my_nc + ci] = (unsigned)u | ((unsigned)ci << 10) | ((unsigned)my_nc << 12); }
          __syncthreads(); }
        const int n_att = (int)pre[512];
        unsigned* slabs_cnt = (unsigned*)(ctl + CW_UCNT);
        bool conv_w_staged = false;
        unsigned nx = 0;
        if (tid == 0) nx = __hip_atomic_fetch_add(ctl + CW_QUEUE, 1u, __ATOMIC_RELAXED, __HIP_MEMORY_SCOPE_AGENT);
        for (;;) {
            if (tid == 0) MISC[16] = nx;
            __syncthreads();
            const int idx = __builtin_amdgcn_readfirstlane((int)MISC[16]);
            __syncthreads();
            if (idx >= n_att + w_p2 + N_CONV_UNITS) break;
            if (tid == 0) nx = __hip_atomic_fetch_add(ctl + CW_QUEUE, 1u, __ATOMIC_RELAXED, __HIP_MEMORY_SCOPE_AGENT);
            if (idx < n_att) {
                att::attn_unit(idx, Bn, Cn, lam, pre, sidx, Qb, Kimg, Vimg, MIX, args.in[10], (char*)lds_raw, (float*)(ws + WS_SLAB), slabs_cnt, MISC + 17);
            } else if (idx < n_att + w_p2) {
                weight_unit(w_p1 + idx - n_att, args, lds, wave, lane);
            } else {
                conv_unit(idx - n_att - w_p2, Ub, args.in[11], args.in[12], args.in[13], args.in[14], MIX, lds, tid, wave, lane, conv_w_staged);
            }
        }
        if (BOTH(2)) GRID_BAR();
    }

    if (IN(3)) {
        pg8::Gemm g{MIX, (const bf16*)(ws + WS_WOUT), M, DM, DM}; pg8::StaticOrder S; S.init(M, DM, G, vc);
        pg8::EpiRes<false> E{nullptr, XN, SS1};
        pg8::gemm_phase<pg8::EpiRes<false>, pg8::StaticOrder, PG8_ALIGN, PG8_SP2>(lds + RING_OFF, g, S, E);
        if (BOTH(3)) XCD_BAR();
    }
    if (IN(4)) {
        { pg8::Gemm g{XN, (const bf16*)(ws + WS_WGU), M, 2 * FF, DM}; pg8::StaticOrder S; S.init(M, 2 * FF, G, vc);
          LAS float* rtab = (LAS float*)(lds + LDSCTL_OFF + 12288); int rpm = -1;
          { pg8::Unit u0; if (S.next(0, u0)) { rpm = u0.pm; if (tid < 256) { const f32x4* sp = (const f32x4*)(SS1 + (size_t)(rpm * 256 + tid) * 16); const f32x4 a = sp[0], b = sp[1], c = sp[2], d = sp[3];
                rtab[tid] = rsqrtf((((a[0] + a[1]) + (a[2] + a[3])) + ((b[0] + b[1]) + (b[2] + b[3])) + ((c[0] + c[1]) + (c[2] + c[3])) + ((d[0] + d[1]) + (d[2] + d[3]))) * (1.f / DM) + EPS); } } __syncthreads(); }
          pg8::EpiGU E{HM, SS1, rtab, rpm};
          pg8::gemm_phase<pg8::EpiGU, pg8::StaticOrder, PG8_ALIGN, PG8_SP2>(lds + RING_OFF, g, S, E); }
        { int kproj = PD; asm volatile("" : "+s"(kproj));
          pg8::Gemm g{PB, (const bf16*)(ws + WS_WPP), M, DM, kproj}; pg8::HelperOrder S{G, vc};
          pg8::EpiBf16 E{PR, DM};
          pg8::gemm_phase<pg8::EpiBf16, pg8::HelperOrder, PG8_ALIGN, PG8_SP2>(lds + RING_OFF, g, S, E); }
        if (BOTH(4)) XCD_BAR();
    }
    if (IN(5)) {
        pg8::Gemm g{HM, (const bf16*)(ws + WS_WDN), M, DM, FF}; pg8::StaticOrder S; S.init(M, DM, G, vc);
        pg8::EpiRes<false> E{nullptr, XN, SS2};
        pg8::gemm_phase<pg8::EpiRes<false>, pg8::StaticOrder, PG8_ALIGN, PG8_SP2>(lds + RING_OFF, g, S, E);
        if (BOTH(5)) XCD_BAR();
    }
    if (IN(6)) {
        pg8::Gemm g{XN, (const bf16*)(ws + WS_WPG), M, DM, DM}; pg8::StaticOrder S; S.init(M, DM, G, vc);
        LAS float* rtab = (LAS float*)(lds + LDSCTL_OFF + 12288); int rpm = -1;
        { pg8::Unit u0; if (S.next(0, u0)) { rpm = u0.pm; if (tid < 256) { const f32x4* sp = (const f32x4*)(SS2 + (size_t)(rpm * 256 + tid) * 16); const f32x4 a = sp[0], b = sp[1], c = sp[2], d = sp[3];
              rtab[tid] = rsqrtf((((a[0] + a[1]) + (a[2] + a[3])) + ((b[0] + b[1]) + (b[2] + b[3])) + ((c[0] + c[1]) + (c[2] + c[3])) + ((d[0] + d[1]) + (d[2] + d[3]))) * (1.f / DM) + EPS); } } __syncthreads(); }
        pg8::EpiPG E{args.out, XN, PR, SS2, rtab, rpm};
        pg8::gemm_phase<pg8::EpiPG, pg8::StaticOrder, PG8_ALIGN, PG8_SP2>(lds + RING_OFF, g, S, E);
    }
#undef IN
#undef BOTH
#undef GRID_BAR
#undef XCD_BAR
}

extern "C" void kernel_launch(void* const* d_in, const int* in_sizes, int n_in, void* d_out, int out_size, void* d_ws, size_t ws_size, hipStream_t stream) {
    static int grid = 0;
    if (grid == 0) {
        if (n_in != 23 || in_sizes[0] != M * DM || out_size != M * DM || ws_size < WS_END) { fprintf(stderr, "kernel_launch: unexpected shapes (n_in %d, out %d, ws %zu); nothing launched\n", n_in, out_size, ws_size); grid = -1; return; }
        int dev = 0, cus = 0, per_cu = 0;
        if (hipGetDevice(&dev) != hipSuccess || hipDeviceGetAttribute(&cus, hipDeviceAttributeMultiprocessorCount, dev) != hipSuccess) { grid = -1; return; }
        if (hipFuncSetAttribute((const void*)fwd, hipFuncAttributeMaxDynamicSharedMemorySize, LDS_BYTES) != hipSuccess) { fprintf(stderr, "kernel_launch: hipFuncSetAttribute failed\n"); grid = -1; return; }
        const hipError_t oe = hipOccupancyMaxActiveBlocksPerMultiprocessor(&per_cu, (const void*)fwd, NWAVES * 64, LDS_BYTES);
        (void)hipGetLastError();
        if (oe == hipSuccess && per_cu < 1) { fprintf(stderr, "kernel_launch: the occupancy query admits no workgroup of this kernel per CU; nothing launched\n"); grid = -1; return; }
        grid = cus;
    }
    if (grid < 0) return;
    if (hipMemsetAsync((char*)d_ws + WS_CTL, 0, CTL_ZERO_BYTES, stream) != hipSuccess) { fprintf(stderr, "kernel_launch: memset failed\n"); return; }
    Args a{};
    for (int i = 0; i < 23; ++i) a.in[i] = (const float*)d_in[i];
    a.out = (float*)d_out; a.ws = (unsigned char*)d_ws;
    for (int li = 0; li < N_LAUNCHES; ++li) {
        a.ph_lo = (N_LAUNCHES == PER_PHASE) ? li : 0; a.ph_hi = (N_LAUNCHES == PER_PHASE) ? li + 1 : PER_PHASE; a.li = li;
        hipLaunchKernelGGL(fwd, dim3(grid), dim3(NWAVES * 64), LDS_BYTES, stream, a);
        const hipError_t le = hipPeekAtLastError();
        if (le != hipSuccess) { fprintf(stderr, "kernel_launch: launch %d failed: %s\n", li, hipGetErrorName(le)); break; }
    }
}
```

```cpp
#include <hip/hip_runtime.h>
#include <cstdio>
#include <cstdint>

#ifndef ATT_EXACT_ZERO
#define ATT_EXACT_ZERO 0
#endif
#ifndef MK_N_LAUNCHES
#define MK_N_LAUNCHES 1
#endif

constexpr int M = 16384, DM = 1024, NIN = 2560, AW = 512, CW = 512, NH = 4, DH = 64, VH = 128, KC = 31, FF = 2816, PD = 256;
constexpr float EPS = 1e-6f;
constexpr float LOG2E = 1.4426950408889634f;
constexpr float QSCALE = 0.125f * LOG2E;
constexpr float LAM_INIT = 0.2f;

__host__ __device__ __forceinline__ int v_st(int k, int c) { return ((c >> 5) * 4 + (k >> 4)) * 1024 + (k & 15) * 64 + (c & 31) * 2; }
__host__ __device__ __forceinline__ int k_st(int k, int c) { return (c >> 3) * 1024 + k * 16 + (c & 7) * 2; }
__device__ __forceinline__ float fsigmoid(float x) { return __builtin_amdgcn_rcpf(1.f + __builtin_amdgcn_exp2f(-LOG2E * x)); }

namespace pg8 {
#define PG8_LAS __attribute__((address_space(3)))
typedef unsigned short bf16_t;
typedef short bf16x8 __attribute__((ext_vector_type(8)));
typedef float f32x4 __attribute__((ext_vector_type(4)));
typedef unsigned u32x4 __attribute__((ext_vector_type(4)));
constexpr int BM = 256, BK = 64, HALF = 128, HTB = HALF * BK * 2  , STAGE_BYTES = 8 * HTB, NXCD = 8, WGM = 8;

__host__ __device__ __forceinline__ int lds_byte(int r, int c) { const int st = (r >> 4) * 2 + (c >> 5), rr = r & 15, cc = c & 31, ob = rr * 64 + cc * 2; return st * 1024 + (ob ^ (((ob >> 9) & 1) << 5)); }
__host__ __device__ __forceinline__ void stage_rc(int b, int& R, int& C) { const int st = b / 1024, sb = b % 1024, swz = sb ^ (((sb >> 9) & 1) << 5); R = (st >> 1) * 16 + swz / 64; C = (st & 1) * 32 + (swz % 64) / 2; }
__host__ __device__ __forceinline__ int perm32(int rho) { const int n = rho >> 4, i = rho & 15; return 8 * (i >> 2) + 4 * n + (i & 3); }

struct Unit { int pm, pn; };
struct Gemm { const bf16_t* A; const bf16_t* Bt; int M, N, K; };

struct StaticOrder {
    int nM, nN, nwg, G, c;
    __host__ __device__ void init(int M, int N, int G_, int c_) { nM = M / BM; nN = N / BM; nwg = nM * nN; G = G_; c = c_; }
    __host__ __device__ bool next(int i, Unit& u) const {
        const long L = (long)i * G + c; if (L >= nwg) return false;
        int wgid = (int)L; { const int q = nwg / NXCD, r = nwg % NXCD, xcd = wgid % NXCD, off = wgid / NXCD; wgid = (xcd < r ? xcd * (q + 1) : r * (q + 1) + (xcd - r) * q) + off; }
        const int nig = WGM * nN, gid = wgid / nig, fm = gid * WGM, gsz = (nM - fm) < WGM ? (nM - fm) : WGM;
        u.pm = fm + ((wgid % nig) % gsz); u.pn = (wgid % nig) / gsz; return true;
    }
    __device__ __forceinline__ void a_ready(const Unit&) const {}
    __device__ __forceinline__ void done(const Unit&) const {}
};


__device__ __forceinline__ float sum_fq(float v) {
    { auto r = __builtin_amdgcn_permlane32_swap(__float_as_uint(v), __float_as_uint(v), false, false); v = __uint_as_float(r[0]) + __uint_as_float(r[1]); }
    { auto r = __builtin_amdgcn_permlane16_swap(__float_as_uint(v), __float_as_uint(v), false, false); v = __uint_as_float(r[0]) + __uint_as_float(r[1]); }
    return v;
}
__device__ __forceinline__ unsigned cvt_pk_bf16(float lo, float hi) { unsigned r; asm volatile("v_cvt_pk_bf16_f32 %0, %1, %2" : "=v"(r) : "v"(lo), "v"(hi)); return r; }
typedef _Float16 half2_t __attribute__((ext_vector_type(2)));
__device__ __forceinline__ unsigned pkh(float lo, float hi) { return __builtin_bit_cast(unsigned, __builtin_amdgcn_cvt_pkrtz(lo, hi)); }
__device__ __forceinline__ u32x4 pack8_f16(const f32x4 a, const f32x4 b) { u32x4 w; w.x = pkh(a[0], a[1]); w.y = pkh(a[2], a[3]); w.z = pkh(b[0], b[1]); w.w = pkh(b[2], b[3]); return w; }
__device__ __forceinline__ u32x4 pack8(const f32x4 a, const f32x4 b) { u32x4 w; w.x = cvt_pk_bf16(a[0], a[1]); w.y = cvt_pk_bf16(a[2], a[3]); w.z = cvt_pk_bf16(b[0], b[1]); w.w = cvt_pk_bf16(b[2], b[3]); return w; }

struct EpiBf16 {
    static constexpr bool PERM = true, AFTER_DRAIN = false;
    bf16_t* O; int ldc;
    __device__ __forceinline__ void operator()(const f32x4 (&acc)[2][2][4][2], const Unit& u, int wr, int wc, int fr, int fq) const {
        const int row0 = u.pm * BM + wr * 64 + fr, col0 = u.pn * BM + wc * 32 + 8 * fq;
#pragma unroll
        for (int ai = 0; ai < 2; ++ai)
#pragma unroll
            for (int m = 0; m < 4; ++m) { bf16_t* rowp = O + (size_t)(row0 + ai * HALF + m * 16) * ldc + col0;
#pragma unroll
                for (int bj = 0; bj < 2; ++bj) *(u32x4*)(rowp + bj * HALF) = pack8(acc[ai][bj][m][0], acc[ai][bj][m][1]); }
    }
};

struct EpiIn {
    static constexpr bool PERM = true, AFTER_DRAIN = false;
    bf16_t* Q; unsigned char* Kimg; unsigned char* Vimg; bf16_t* U; const float* qn; const float* kn; unsigned* nmax; const float* SS0; const PG8_LAS float* rtab; int rtab_pm; const PG8_LAS float* gtab; PG8_LAS unsigned* nmax_lds;
    __device__ __forceinline__ void operator()(const f32x4 (&acc)[2][2][4][2], const Unit& u, int wr, int wc, int fr, int fq) const {
        const int row0 = u.pm * BM + wr * 64 + fr;
        float r0s[2][4];
        if (u.pm == rtab_pm) {
#pragma unroll
            for (int ai = 0; ai < 2; ++ai)
#pragma unroll
                for (int m = 0; m < 4; ++m) r0s[ai][m] = rtab[wr * 64 + fr + ai * HALF + m * 16];
        } else {
#pragma unroll
            for (int ai = 0; ai < 2; ++ai)
#pragma unroll
                for (int m = 0; m < 4; ++m) r0s[ai][m] = SS0[row0 + ai * HALF + m * 16];
#pragma unroll
            for (int ai = 0; ai < 2; ++ai)
#pragma unroll
                for (int m = 0; m < 4; ++m) r0s[ai][m] = rsqrtf(r0s[ai][m] * (1.f / DM) + EPS);
        }
        if (u.pn < 4) {
            float nn_max = 0.f;
            const bool isq = u.pn < 2; const PG8_LAS float* gn = gtab + (isq ? 0 : 64); const float sc = isq ? QSCALE : 1.f;
            const int gidx = (u.pn & 1) * 4 + wc;
            f32x4 g[2][2];
#pragma unroll
            for (int bj = 0; bj < 2; ++bj)
#pragma unroll
                for (int n = 0; n < 2; ++n) g[bj][n] = *(const PG8_LAS f32x4*)(gn + 32 * bj + 8 * fq + 4 * n);
            float kbar2_max = 0.f;
#pragma unroll
            for (int ai = 0; ai < 2; ++ai) {
                f32x4 cs[2][2];
#pragma unroll
                for (int bj = 0; bj < 2; ++bj) { cs[bj][0] = (f32x4){0.f, 0.f, 0.f, 0.f}; cs[bj][1] = (f32x4){0.f, 0.f, 0.f, 0.f}; }
#pragma unroll
                for (int m = 0; m < 4; ++m) {
                    float ss = 0.f;
#pragma unroll
                    for (int bj = 0; bj < 2; ++bj)
#pragma unroll
                        for (int n = 0; n < 2; ++n) { const f32x4 x = acc[ai][bj][m][n]; ss += (x[0] * x[0] + x[1] * x[1]) + (x[2] * x[2] + x[3] * x[3]); }
                    ss = sum_fq(ss);
                    const int row = row0 + ai * HALF + m * 16; float nn = 0.f;
                    const float r0 = r0s[ai][m];
                    const float r = rsqrtf(ss * (r0 * r0) * (1.f / 64.f) + EPS) * (r0 * sc);
#pragma unroll
                    for (int bj = 0; bj < 2; ++bj) {
                        const f32x4 v0 = acc[ai][bj][m][0] * r * g[bj][0], v1 = acc[ai][bj][m][1] * r * g[bj][1];
                        nn += (v0[0] * v0[0] + v0[1] * v0[1]) + (v0[2] * v0[2] + v0[3] * v0[3]) + (v1[0] * v1[0] + v1[1] * v1[1]) + (v1[2] * v1[2] + v1[3] * v1[3]);
                        if (!isq) { cs[bj][0] += v0; cs[bj][1] += v1; }
                        const u32x4 w = pack8(v0, v1);
                        if (isq) *(u32x4*)(Q + (size_t)row * AW + gidx * 64 + 32 * bj + 8 * fq) = w;
                        else *(u32x4*)(Kimg + (size_t)((gidx >> 1) * 256 + (row >> 6)) * 16384 + k_st(row & 63, (gidx & 1) * 64 + 32 * bj + 8 * fq)) = w;
                    }
                    nn = sum_fq(nn); nn_max = fmaxf(nn_max, nn);
                }
                if (!isq) {
                    float kb = 0.f;
#pragma unroll
                    for (int bj = 0; bj < 2; ++bj)
#pragma unroll
                        for (int n = 0; n < 2; ++n)
#pragma unroll
                            for (int e = 0; e < 4; ++e) { float c = cs[bj][n][e];
#pragma unroll
                                for (int o = 1; o < 16; o <<= 1) c += __shfl_xor(c, o);
                                kb += c * c; }
                    kb = sum_fq(kb);
                    kbar2_max = fmaxf(kbar2_max, kb * (1.f / 4096.f));
                }
            }
#pragma unroll
            for (int o = 1; o < 16; o <<= 1) nn_max = fmaxf(nn_max, __shfl_xor(nn_max, o));
            if ((threadIdx.x & 63) == 0) (void)__hip_atomic_fetch_max(nmax_lds + (isq ? 0 : 1), __float_as_uint(sqrtf(nn_max)), __ATOMIC_RELAXED, __HIP_MEMORY_SCOPE_WORKGROUP);
            if (!isq && (threadIdx.x & 63) == 0) (void)__hip_atomic_fetch_max(nmax_lds + 2, __float_as_uint(sqrtf(kbar2_max)), __ATOMIC_RELAXED, __HIP_MEMORY_SCOPE_WORKGROUP);
        } else if (u.pn < 6) {
#pragma unroll
            for (int ai = 0; ai < 2; ++ai)
#pragma unroll
                for (int m = 0; m < 4; ++m) { const int row = row0 + ai * HALF + m * 16; const float r0 = r0s[ai][m];
#pragma unroll
                    for (int bj = 0; bj < 2; ++bj) { const int h = (u.pn - 4) * 2 + bj;
                        *(u32x4*)(Vimg + (size_t)(h * 256 + (row >> 6)) * 16384 + v_st(row & 63, wc * 32 + 8 * fq)) = pack8(acc[ai][bj][m][0] * r0, acc[ai][bj][m][1] * r0); } }
        } else {
            const int ch0 = (u.pn - 6) * 128 + wc * 32 + 8 * fq;
#pragma unroll
            for (int ai = 0; ai < 2; ++ai)
#pragma unroll
                for (int m = 0; m < 4; ++m) { const int row = row0 + ai * HALF + m * 16; f32x4 v[2]; const float r0 = r0s[ai][m];
                    const float r2 = -LOG2E * r0, ir0 = __builtin_amdgcn_rcpf(r0);
#pragma unroll
                    for (int n = 0; n < 2; ++n) { const f32x4 a = acc[ai][0][m][n], gt = acc[ai][1][m][n];
                        const f32x4 t = gt * r2; const f32x4 ex = (f32x4){__builtin_amdgcn_exp2f(t[0]), __builtin_amdgcn_exp2f(t[1]), __builtin_amdgcn_exp2f(t[2]), __builtin_amdgcn_exp2f(t[3])};
                        const f32x4 den = ex * ir0 + ir0; v[n] = a * (f32x4){__builtin_amdgcn_rcpf(den[0]), __builtin_amdgcn_rcpf(den[1]), __builtin_amdgcn_rcpf(den[2]), __builtin_amdgcn_rcpf(den[3])}; }
                    *(u32x4*)(U + (size_t)row * CW + ch0) = pack8_f16(v[0], v[1]); }
        }
    }
};

template <bool F32BASE> struct EpiRes {
    static constexpr bool PERM = true, AFTER_DRAIN = false;
    const float* base; bf16_t* Xb; float* SS;
    __device__ __forceinline__ void operator()(const f32x4 (&acc)[2][2][4][2], const Unit& u, int wr, int wc, int fr, int fq) const {
        static_assert(!F32BASE, "the residual base is the bf16 stream");
        const int row0 = u.pm * BM + wr * 64 + fr, col0 = u.pn * BM + wc * 32 + 8 * fq;
        u32x4 bva[2][4][2];
#pragma unroll
        for (int ai = 0; ai < 2; ++ai)
#pragma unroll
            for (int m = 0; m < 4; ++m)
#pragma unroll
                for (int bj = 0; bj < 2; ++bj) bva[ai][m][bj] = *(const u32x4*)(Xb + (size_t)(row0 + ai * HALF + m * 16) * DM + col0 + bj * HALF);
        asm volatile("" :: "v"(bva[0][0][0]), "v"(bva[0][1][0]), "v"(bva[0][2][0]), "v"(bva[0][3][0]), "v"(bva[1][0][0]), "v"(bva[1][1][0]), "v"(bva[1][2][0]), "v"(bva[1][3][0]), "v"(bva[0][0][1]), "v"(bva[0][1][1]), "v"(bva[0][2][1]), "v"(bva[0][3][1]), "v"(bva[1][0][1]), "v"(bva[1][1][1]), "v"(bva[1][2][1]), "v"(bva[1][3][1]));
#pragma unroll
        for (int ai = 0; ai < 2; ++ai) {
#pragma unroll
            for (int m = 0; m < 4; ++m) { const int row = row0 + ai * HALF + m * 16; float ss = 0.f;
#pragma unroll
                for (int bj = 0; bj < 2; ++bj) { const size_t off = (size_t)row * DM + col0 + bj * HALF; const u32x4 b = bva[ai][m][bj];
                    f32x4 x0 = (f32x4){__builtin_bit_cast(float, b.x << 16), __builtin_bit_cast(float, b.x & 0xffff0000u), __builtin_bit_cast(float, b.y << 16), __builtin_bit_cast(float, b.y & 0xffff0000u)};
                    f32x4 x1 = (f32x4){__builtin_bit_cast(float, b.z << 16), __builtin_bit_cast(float, b.z & 0xffff0000u), __builtin_bit_cast(float, b.w << 16), __builtin_bit_cast(float, b.w & 0xffff0000u)};
                    x0 += acc[ai][bj][m][0]; x1 += acc[ai][bj][m][1];
                    ss += (x0[0] * x0[0] + x0[1] * x0[1]) + (x0[2] * x0[2] + x0[3] * x0[3]) + (x1[0] * x1[0] + x1[1] * x1[1]) + (x1[2] * x1[2] + x1[3] * x1[3]);
                    *(u32x4*)(Xb + off) = pack8(x0, x1); }
                ss = sum_fq(ss);
                if (fq == 0) SS[(size_t)row * 16 + u.pn * 4 + wc] = ss; }
        }
    }
};
__device__ __forceinline__ void row_rstd8(const float* SS, int row0, int fq, float (&rs)[2][4]) {
#pragma unroll
    for (int ai = 0; ai < 2; ++ai)
#pragma unroll
        for (int m = 0; m < 4; ++m) { const f32x4 t = *(const f32x4*)(SS + (size_t)(row0 + ai * HALF + m * 16) * 16 + 4 * fq); rs[ai][m] = (t[0] + t[1]) + (t[2] + t[3]); }
#pragma unroll
    for (int ai = 0; ai < 2; ++ai)
#pragma unroll
        for (int m = 0; m < 4; ++m) { float v = sum_fq(rs[ai][m]); rs[ai][m] = rsqrtf(v * (1.f / DM) + EPS); }
}
struct EpiGU {
    static constexpr bool PERM = true, AFTER_DRAIN = false;
    bf16_t* HM; const float* SS; const PG8_LAS float* rtab; int rtab_pm;
    __device__ __forceinline__ void operator()(const f32x4 (&acc)[2][2][4][2], const Unit& u, int wr, int wc, int fr, int fq) const {
        const int row0 = u.pm * BM + wr * 64 + fr, col0 = u.pn * HALF + wc * 32 + 8 * fq;
        float rs[2][4];
        if (u.pm == rtab_pm) {
#pragma unroll
            for (int ai = 0; ai < 2; ++ai)
#pragma unroll
                for (int m = 0; m < 4; ++m) rs[ai][m] = rtab[wr * 64 + fr + ai * HALF + m * 16];
        } else row_rstd8(SS, row0, fq, rs);
#pragma unroll
        for (int ai = 0; ai < 2; ++ai)
#pragma unroll
            for (int m = 0; m < 4; ++m) { const int row = row0 + ai * HALF + m * 16; const float r = rs[ai][m]; f32x4 v[2];
                const float r2 = -LOG2E * r, ir2 = __builtin_amdgcn_rcpf(r * r);
#pragma unroll
                for (int n = 0; n < 2; ++n) { const f32x4 gt = acc[ai][0][m][n], up = acc[ai][1][m][n];
                    const f32x4 t = gt * r2, gu = gt * up; f32x4 ex = (f32x4){__builtin_amdgcn_exp2f(t[0]), __builtin_amdgcn_exp2f(t[1]), __builtin_amdgcn_exp2f(t[2]), __builtin_amdgcn_exp2f(t[3])};
                    const f32x4 den = ex * ir2 + ir2; const f32x4 rc = (f32x4){__builtin_amdgcn_rcpf(den[0]), __builtin_amdgcn_rcpf(den[1]), __builtin_amdgcn_rcpf(den[2]), __builtin_amdgcn_rcpf(den[3])};
                    v[n] = gu * rc; }
                *(u32x4*)(HM + (size_t)row * FF + col0) = pack8(v[0], v[1]); }
    }
};
struct EpiPG {
    static constexpr bool PERM = true, AFTER_DRAIN = false;
    float* out; const bf16_t* Xb; const bf16_t* PR; const float* SS; const PG8_LAS float* rtab; int rtab_pm;
    __device__ __forceinline__ void operator()(const f32x4 (&acc)[2][2][4][2], const Unit& u, int wr, int wc, int fr, int fq) const {
        const int row0 = u.pm * BM + wr * 64 + fr, col0 = u.pn * BM + wc * 32 + 8 * fq;
        float rs[2][4];
        if (u.pm == rtab_pm) {
#pragma unroll
            for (int ai = 0; ai < 2; ++ai)
#pragma unroll
                for (int m = 0; m < 4; ++m) rs[ai][m] = rtab[wr * 64 + fr + ai * HALF + m * 16];
        } else row_rstd8(SS, row0, fq, rs);
#pragma unroll
        for (int ai = 0; ai < 2; ++ai) {
            u32x4 prv[4][2], xbv[4][2];
#pragma unroll
            for (int m = 0; m < 4; ++m)
#pragma unroll
                for (int bj = 0; bj < 2; ++bj) { const size_t off = (size_t)(row0 + ai * HALF + m * 16) * DM + col0 + bj * HALF; prv[m][bj] = *(const u32x4*)(PR + off); xbv[m][bj] = *(const u32x4*)(Xb + off); }
#pragma unroll
            for (int m = 0; m < 4; ++m) { const int row = row0 + ai * HALF + m * 16; const float r = rs[ai][m];
#pragma unroll
                for (int bj = 0; bj < 2; ++bj) { const size_t off = (size_t)row * DM + col0 + bj * HALF;
                    const u32x4 pr = prv[m][bj], xb = xbv[m][bj];
                    const float rl = -LOG2E * r;
                    const f32x4 t0 = acc[ai][bj][m][0] * rl, t1 = acc[ai][bj][m][1] * rl;
                    const f32x4 d0 = (f32x4){__builtin_amdgcn_exp2f(t0[0]), __builtin_amdgcn_exp2f(t0[1]), __builtin_amdgcn_exp2f(t0[2]), __builtin_amdgcn_exp2f(t0[3])} + 1.f;
                    const f32x4 d1 = (f32x4){__builtin_amdgcn_exp2f(t1[0]), __builtin_amdgcn_exp2f(t1[1]), __builtin_amdgcn_exp2f(t1[2]), __builtin_amdgcn_exp2f(t1[3])} + 1.f;
                    const f32x4 s0 = (f32x4){__builtin_amdgcn_rcpf(d0[0]), __builtin_amdgcn_rcpf(d0[1]), __builtin_amdgcn_rcpf(d0[2]), __builtin_amdgcn_rcpf(d0[3])}, s1 = (f32x4){__builtin_amdgcn_rcpf(d1[0]), __builtin_amdgcn_rcpf(d1[1]), __builtin_amdgcn_rcpf(d1[2]), __builtin_amdgcn_rcpf(d1[3])};
                    const f32x4 x0 = (f32x4){__builtin_bit_cast(float, xb.x << 16), __builtin_bit_cast(float, xb.x & 0xffff0000u), __builtin_bit_cast(float, xb.y << 16), __builtin_bit_cast(float, xb.y & 0xffff0000u)};
                    const f32x4 x1 = (f32x4){__builtin_bit_cast(float, xb.z << 16), __builtin_bit_cast(float, xb.z & 0xffff0000u), __builtin_bit_cast(float, xb.w << 16), __builtin_bit_cast(float, xb.w & 0xffff0000u)};
                    const f32x4 p0 = (f32x4){__builtin_bit_cast(float, pr.x << 16), __builtin_bit_cast(float, pr.x & 0xffff0000u), __builtin_bit_cast(float, pr.y << 16), __builtin_bit_cast(float, pr.y & 0xffff0000u)};
                    const f32x4 p1 = (f32x4){__builtin_bit_cast(float, pr.z << 16), __builtin_bit_cast(float, pr.z & 0xffff0000u), __builtin_bit_cast(float, pr.w << 16), __builtin_bit_cast(float, pr.w & 0xffff0000u)};
                    const f32x4 o0 = s0 * p0 + x0, o1 = s1 * p1 + x1;
                    __builtin_nontemporal_store(o0, (f32x4*)(out + off)); __builtin_nontemporal_store(o1, (f32x4*)(out + off + 4)); } }
        }
    }
};
struct HelperOrder {
    int G, c;
    __device__ __forceinline__ bool next(int i, Unit& u) const {
        const int h0 = G >> 1; if (c < h0) return false;
        if ((G & 15) == 0) {
            const int x = c & 7, rank = c >> 3, nr = G >> 3, r0 = nr >> 1, lu = (rank - r0) + (nr - r0) * i; if (lu >= 32) return false; u.pm = 8 * x + (lu >> 2); u.pn = lu & 3; return true; }
        const int L = (c - h0) + (G - h0) * i; if (L >= 256) return false; u.pm = L >> 2; u.pn = L & 3; return true; }
    __device__ __forceinline__ void a_ready(const Unit&) const {}
    __device__ __forceinline__ void done(const Unit&) const {}
};

template <class Epi, class Sched, bool ALIGN_EPI = false, bool SP2 = false>
__device__ __forceinline__ void gemm_phase(PG8_LAS unsigned char* lds, const Gemm g, const Sched& S, const Epi& E) {
    const int tid = threadIdx.x, wid = __builtin_amdgcn_readfirstlane(tid >> 6), lane = tid & 63, wr = wid >> 2, wc = wid & 3, fr = lane & 15, fq = lane >> 4;
    const int K = g.K, nt = K / BK;
    unsigned voffA[2], voffB[2];
#pragma unroll
    for (int i = 0; i < 2; ++i) { int R, C; stage_rc(tid * 16 + i * 8192, R, C); const int Rb = Epi::PERM ? ((R & ~31) + perm32(R & 31)) : R;
        voffA[i] = (unsigned)(R * K + C) * 2u; voffB[i] = (unsigned)(Rb * K + C) * 2u; }
    const size_t kstep = (size_t)(BK * 2);
    const size_t hstep = (size_t)HALF * K * 2;
    const size_t tstep = 2 * hstep;
    const unsigned ldsw = (unsigned)wid * 1024u;
    const int aoff = lds_byte(wr * 64 + fr, fq * 8), boff = lds_byte(wc * 32 + fr, fq * 8);
#define PG8_SA(b, h) (((b) * 2 + (h)) * HTB)
#define PG8_SB(b, h) ((4 + (b) * 2 + (h)) * HTB)
#define PG8_STAGE(bufoff, gbase, voff) do { _Pragma("unroll") for (int _i = 0; _i < 2; ++_i) \
        __builtin_amdgcn_global_load_lds((const unsigned*)((const char*)(gbase) + (voff)[_i]), (PG8_LAS unsigned*)(lds + (bufoff) + ldsw + _i * 8192), 16, 0, 0); } while (0)
#define PG8_LDA(dst, b, h) do { _Pragma("unroll") for (int m = 0; m < 4; ++m) _Pragma("unroll") for (int k = 0; k < 2; ++k) dst[m][k] = *(const PG8_LAS bf16x8*)(lds + PG8_SA(b, h) + aoff + m * 2048 + k * 1024); } while (0)
#define PG8_LDB(dst, b, h) do { _Pragma("unroll") for (int n = 0; n < 2; ++n) _Pragma("unroll") for (int k = 0; k < 2; ++k) dst[n][k] = *(const PG8_LAS bf16x8*)(lds + PG8_SB(b, h) + boff + n * 2048 + k * 1024); } while (0)
#define PG8_MMA(ai, bj, At, Bt) do { __builtin_amdgcn_s_setprio(1); _Pragma("unroll") for (int m = 0; m < 4; ++m) _Pragma("unroll") for (int n = 0; n < 2; ++n) _Pragma("unroll") for (int k = 0; k < 2; ++k) \
        acc[ai][bj][m][n] = __builtin_amdgcn_mfma_f32_16x16x32_bf16(Bt[n][k], At[m][k], acc[ai][bj][m][n], 0, 0, 0); __builtin_amdgcn_s_setprio(0); } while (0)
#define PG8_WAIT_V(n) asm volatile("s_waitcnt vmcnt(" #n ")" ::: "memory")
#define PG8_WAIT_L(n) asm volatile("s_waitcnt lgkmcnt(" #n ")" ::: "memory")
#define PG8_BAR __builtin_amdgcn_s_barrier()
#define PG8_SCHED __builtin_amdgcn_sched_barrier(0)
    Unit cur, nxt; int ui = 0;
    if (!S.next(0, cur)) return;
    f32x4 acc[2][2][4][2];
#pragma unroll
    for (int a = 0; a < 2; ++a)
#pragma unroll
        for (int b = 0; b < 2; ++b)
#pragma unroll
            for (int m = 0; m < 4; ++m)
#pragma unroll
                for (int n = 0; n < 2; ++n) acc[a][b][m][n] = (f32x4){0.f, 0.f, 0.f, 0.f};
    bf16x8 At[4][2], B0[2][2], B1[2][2];
    const char* cA = (const char*)g.A + (size_t)cur.pm * tstep; const char* cB = (const char*)g.Bt + (size_t)cur.pn * tstep;
    S.a_ready(cur);
    if constexpr (SP2) {
        PG8_STAGE(PG8_SB(0, 0), cB, voffB); PG8_STAGE(PG8_SB(0, 1), cB + hstep, voffB); PG8_STAGE(PG8_SA(0, 0), cA, voffA); PG8_STAGE(PG8_SA(0, 1), cA + hstep, voffA);
        if (wr == 1) PG8_BAR;
        PG8_WAIT_V(2); PG8_BAR;
        PG8_STAGE(PG8_SB(1, 0), cB + kstep, voffB); PG8_STAGE(PG8_SA(1, 0), cA + kstep, voffA); PG8_STAGE(PG8_SB(1, 1), cB + hstep + kstep, voffB);
        PG8_WAIT_V(6); PG8_BAR;
    } else {
        PG8_STAGE(PG8_SB(0, 0), cB, voffB); PG8_STAGE(PG8_SA(0, 0), cA, voffA); PG8_STAGE(PG8_SB(0, 1), cB + hstep, voffB); PG8_STAGE(PG8_SA(0, 1), cA + hstep, voffA);
        if (wr == 1) PG8_BAR;
        PG8_WAIT_V(4); PG8_BAR;
        PG8_STAGE(PG8_SB(1, 0), cB + kstep, voffB); PG8_STAGE(PG8_SA(1, 0), cA + kstep, voffA); PG8_STAGE(PG8_SB(1, 1), cB + hstep + kstep, voffB);
        PG8_WAIT_V(6); PG8_BAR;
    }
    for (;;) {
        const bool has_next = S.next(ui + 1, nxt);
        const char* nA = has_next ? (const char*)g.A + (size_t)nxt.pm * tstep : cA; const char* nB = has_next ? (const char*)g.Bt + (size_t)nxt.pn * tstep : cB;
        for (int t = 0; t < nt; t += 2) {
            const bool last = (t == nt - 2);
            const char* a1 = cA + (size_t)(t + 1) * kstep;
            const char* a2 = last ? nA : cA + (size_t)(t + 2) * kstep; const char* b2 = last ? nB : cB + (size_t)(t + 2) * kstep;
            const char* a3 = a2 + kstep; const char* b3 = b2 + kstep;
            if (last && has_next) S.a_ready(nxt);
            if constexpr (SP2) {
            PG8_LDB(B0, 0, 0); PG8_LDB(B1, 0, 1); PG8_SCHED; PG8_LDA(At, 0, 0); PG8_STAGE(PG8_SA(1, 1), a1 + hstep, voffA);
            PG8_WAIT_V(8); PG8_WAIT_L(0); PG8_BAR; PG8_MMA(0, 0, At, B0); PG8_MMA(0, 1, At, B1); PG8_BAR; PG8_SCHED;
            PG8_LDA(At, 0, 1); PG8_STAGE(PG8_SB(0, 0), b2, voffB); PG8_STAGE(PG8_SB(0, 1), b2 + hstep, voffB); PG8_STAGE(PG8_SA(0, 0), a2, voffA);
            PG8_WAIT_V(8); PG8_WAIT_L(0); PG8_BAR; PG8_MMA(1, 0, At, B0); PG8_MMA(1, 1, At, B1); PG8_BAR; PG8_SCHED;
            PG8_LDB(B0, 1, 0); PG8_LDB(B1, 1, 1); PG8_SCHED; PG8_LDA(At, 1, 0); PG8_STAGE(PG8_SA(0, 1), a2 + hstep, voffA);
            PG8_WAIT_V(8); PG8_WAIT_L(0); PG8_BAR; PG8_MMA(0, 0, At, B0); PG8_MMA(0, 1, At, B1); PG8_BAR; PG8_SCHED;
            PG8_LDA(At, 1, 1); PG8_STAGE(PG8_SB(1, 0), b3, voffB); PG8_STAGE(PG8_SB(1, 1), b3 + hstep, voffB); PG8_STAGE(PG8_SA(1, 0), a3, voffA);
            PG8_WAIT_V(8); PG8_WAIT_L(0); PG8_BAR; PG8_MMA(1, 0, At, B0); PG8_MMA(1, 1, At, B1); PG8_BAR; PG8_SCHED;
            } else {
            PG8_LDB(B0, 0, 0); PG8_SCHED; PG8_LDA(At, 0, 0); PG8_STAGE(PG8_SA(1, 1), a1 + hstep, voffA);
            PG8_WAIT_L(8); PG8_BAR; PG8_WAIT_L(0); PG8_MMA(0, 0, At, B0); PG8_BAR; PG8_SCHED;
            PG8_LDB(B1, 0, 1); PG8_STAGE(PG8_SB(0, 0), b2, voffB);
            PG8_BAR; PG8_WAIT_L(0); PG8_MMA(0, 1, At, B1); PG8_BAR;
            PG8_LDA(At, 0, 1); PG8_STAGE(PG8_SA(0, 0), a2, voffA);
            PG8_BAR; PG8_WAIT_L(0); PG8_MMA(1, 0, At, B0); PG8_BAR; PG8_SCHED;
            PG8_STAGE(PG8_SB(0, 1), b2 + hstep, voffB);
            PG8_WAIT_V(6); PG8_BAR; PG8_MMA(1, 1, At, B1); PG8_BAR;
            PG8_LDB(B0, 1, 0); PG8_SCHED; PG8_LDA(At, 1, 0); PG8_STAGE(PG8_SA(0, 1), a2 + hstep, voffA);
            PG8_WAIT_L(8); PG8_BAR; PG8_WAIT_L(0); PG8_MMA(0, 0, At, B0); PG8_BAR; PG8_SCHED;
            PG8_LDB(B1, 1, 1); PG8_STAGE(PG8_SB(1, 0), b3, voffB);
            PG8_BAR; PG8_WAIT_L(0); PG8_MMA(0, 1, At, B1); PG8_BAR;
            PG8_LDA(At, 1, 1); PG8_STAGE(PG8_SA(1, 0), a3, voffA);
            PG8_BAR; PG8_WAIT_L(0); PG8_MMA(1, 0, At, B0); PG8_BAR; PG8_SCHED;
            PG8_STAGE(PG8_SB(1, 1), b3 + hstep, voffB);
            PG8_WAIT_V(6); PG8_BAR; PG8_MMA(1, 1, At, B1); PG8_BAR;
            }
        }
        if constexpr (ALIGN_EPI) { if (wr == 0) PG8_BAR; }
        if constexpr (!Epi::AFTER_DRAIN) { E(acc, cur, wr, wc, fr, fq); S.done(cur); }
        if (!has_next) break;
#pragma unroll
        for (int a = 0; a < 2; ++a)
#pragma unroll
            for (int b = 0; b < 2; ++b)
#pragma unroll
                for (int m = 0; m < 4; ++m)
#pragma unroll
                    for (int n = 0; n < 2; ++n) acc[a][b][m][n] = (f32x4){0.f, 0.f, 0.f, 0.f};
        cur = nxt; cA = nA; cB = nB; ++ui;
        if constexpr (ALIGN_EPI) { if (wr == 1) PG8_BAR; }
    }
    PG8_WAIT_V(0);
    if constexpr (!ALIGN_EPI) { if (wr == 0) PG8_BAR; }
    PG8_BAR;
    if constexpr (Epi::AFTER_DRAIN) { E.fused(acc, cur, wr, wc, fr, fq, lds, wid, lane); S.done(cur); }
#undef PG8_SA
#undef PG8_SB
#undef PG8_STAGE
#undef PG8_LDA
#undef PG8_LDB
#undef PG8_MMA
#undef PG8_WAIT_V
#undef PG8_WAIT_L
#undef PG8_BAR
#undef PG8_SCHED
}
}

#ifndef PG8_SP2
#define PG8_SP2 true
#endif
#ifndef PG8_ALIGN
#define PG8_ALIGN true
#endif
#define GAS __attribute__((address_space(1)))
#define LAS __attribute__((address_space(3)))
typedef unsigned short bf16;
typedef unsigned v4u __attribute__((ext_vector_type(4)));
typedef float f32x4 __attribute__((ext_vector_type(4)));
typedef short bf16x8 __attribute__((ext_vector_type(8)));
typedef GAS unsigned gu32;
typedef GAS unsigned long long gu64;
#define RLX_AGENT __ATOMIC_RELAXED, __HIP_MEMORY_SCOPE_AGENT
#define LDS_WAIT() asm volatile("s_waitcnt lgkmcnt(0)" ::: "memory")
#define VM_WAIT() asm volatile("s_waitcnt vmcnt(0)" ::: "memory")
__device__ __forceinline__ unsigned long long rt() { return __builtin_amdgcn_s_memrealtime(); }
__device__ __forceinline__ unsigned f2bf(float f) { unsigned u = __builtin_bit_cast(unsigned, f); return (u + 0x7fffu + ((u >> 16) & 1u)) >> 16; }
__device__ __forceinline__ unsigned pk2(float lo, float hi) { return f2bf(lo) | (f2bf(hi) << 16); }

#define XB_TMO      128
#define XB_XCNT(j)  (256  + 64 * (j))
#define XB_XSUB(j)  (1280 + 64 * (j))
#define XB_XGEN(j)  (2304 + 64 * (j))
#define XB_TOP      3328
#define XB_TOPGEN   3392
#define XB_LSUB(j)  (3456 + 64 * (j))
#define XB_LGEN(j)  (4480 + 64 * (j))
#define XCD_BAR_WORDS 5504
#define XB_SPIN_CAP (1u << 18)

__device__ __forceinline__ unsigned xb_ld(unsigned* p)              { return __hip_atomic_load(p, __ATOMIC_RELAXED, __HIP_MEMORY_SCOPE_AGENT); }
__device__ __forceinline__ unsigned xb_add(unsigned* p, unsigned v) { return __hip_atomic_fetch_add(p, v, __ATOMIC_RELAXED, __HIP_MEMORY_SCOPE_AGENT); }
__device__ __forceinline__ unsigned xb_xcc_id() { return (unsigned)__builtin_amdgcn_s_getreg((3 << 11) | 20) & 0xFu; }
#define XB_SPIN(cond, bar) do { unsigned _sp = 0; while (cond) { __builtin_amdgcn_s_sleep(1); \
    if ((++_sp & 255u) == 0u) { if (xb_ld(&(bar)[XB_TMO])) break; if (_sp > XB_SPIN_CAP) { atomicAdd(&(bar)[XB_TMO], 1u); break; } } } } while (0)

struct XcdBarrier {
    unsigned* bar; unsigned x;
    volatile LAS unsigned* st;
};

__device__ __forceinline__ XcdBarrier xcd_barrier_post(unsigned* bar, volatile LAS unsigned* st) {
    XcdBarrier b; b.bar = bar; b.x = xb_xcc_id(); b.st = st;
    if (threadIdx.x == 0) st[2] = xb_add(&bar[XB_XCNT(b.x)], 1u);
    return b;
}
__device__ __forceinline__ void xcd_barrier_complete(unsigned* bar, unsigned x, unsigned& nloc, unsigned& nx, unsigned& uniform) {
    const unsigned G = gridDim.x * gridDim.y * gridDim.z;
    unsigned sum, cnt, mine, odd, sp = 0u;
    for (;;) {
        sum = 0u; cnt = 0u; mine = 0u; odd = 0u;
#pragma unroll
        for (unsigned j = 0; j < 16; ++j) { const unsigned c = xb_ld(&bar[XB_XCNT(j)]); sum += c; cnt += (c > 0u) ? 1u : 0u; mine = (j == x) ? c : mine; odd |= (j < 8u) ? (c * 8u != G ? 1u : 0u) : (c != 0u ? 1u : 0u); }
        if (sum == G) { uniform = odd ? 0u : 1u; break; }
        __builtin_amdgcn_s_sleep(1);
        if ((++sp & 255u) == 0u) { if (xb_ld(&bar[XB_TMO])) { uniform = 0u; break; } if (sp > XB_SPIN_CAP) { atomicAdd(&bar[XB_TMO], 1u); uniform = 0u; break; } }
    }
    nloc = mine > 0u ? mine : 1u; nx = cnt > 0u ? cnt : 1u;
}

__device__ __forceinline__ void xcd_barrier(const XcdBarrier& b) {
    asm volatile("s_waitcnt vmcnt(0)" ::: "memory");
    __syncthreads();
    if (threadIdx.x == 0) {
        unsigned* bar = b.bar;
        __builtin_amdgcn_s_waitcnt(0);
        unsigned nloc = b.st[0], nx = b.st[1];
        if (nloc == 0u) { unsigned uni = 0u; xcd_barrier_complete(bar, b.x, nloc, nx, uni); b.st[0] = nloc; b.st[1] = nx; b.st[3] = uni; }
        const unsigned old = xb_add(&bar[XB_XSUB(b.x)], 1u);
        const unsigned gen = old / nloc;
        if (old + 1u == (gen + 1u) * nloc) {
            __builtin_amdgcn_fence(__ATOMIC_RELEASE, "agent");
            asm volatile("s_waitcnt vmcnt(0)" ::: "memory");
            const unsigned og = xb_add(&bar[XB_TOP], 1u);
            const unsigned tg = og / nx;
            if (og + 1u == (tg + 1u) * nx) xb_add(&bar[XB_TOPGEN], 1u);
            else XB_SPIN(xb_ld(&bar[XB_TOPGEN]) == tg, bar);
            __builtin_amdgcn_fence(__ATOMIC_ACQUIRE, "agent");
            xb_add(&bar[XB_XGEN(b.x)], 1u);
            asm volatile("s_waitcnt vmcnt(0)" ::: "memory");
        } else {
            XB_SPIN(xb_ld(&bar[XB_XGEN(b.x)]) == gen, bar);
            __builtin_amdgcn_fence(__ATOMIC_ACQUIRE, "agent");
            asm volatile("s_waitcnt vmcnt(0)" ::: "memory");
        }
    }
    __syncthreads();
}

__device__ __forceinline__ void xcd_local_barrier(const XcdBarrier& b) {
    asm volatile("s_waitcnt vmcnt(0)" ::: "memory");
    __syncthreads();
    if (threadIdx.x == 0) {
        unsigned* bar = b.bar;
        __builtin_amdgcn_s_waitcnt(0);
        const unsigned nloc = b.st[0];
        const unsigned old = xb_add(&bar[XB_LSUB(b.x)], 1u);
        const unsigned gen = old / nloc;
        if (old + 1u == (gen + 1u) * nloc) (void)xb_add(&bar[XB_LGEN(b.x)], 1u);
        else XB_SPIN(xb_ld(&bar[XB_LGEN(b.x)]) == gen, bar);
        __builtin_amdgcn_fence(__ATOMIC_ACQUIRE, "agent");
        asm volatile("s_waitcnt vmcnt(0)" ::: "memory");
    }
    __syncthreads();
}


constexpr size_t MiB = 1u << 20;
constexpr size_t WS_CTL = 0, CTL_ZERO_BYTES = 1 * MiB;
constexpr size_t WS_WIN = 2 * MiB, WS_WOUT = 7 * MiB, WS_WGU = 9 * MiB, WS_WDN = 20 * MiB, WS_WPG = 26 * MiB, WS_WPP = 28 * MiB;
constexpr size_t WS_SS0 = 28 * MiB + 512 * 1024  , WS_SS1 = 29 * MiB, WS_SS2 = 30 * MiB;
constexpr size_t WS_XN = 32 * MiB;
constexpr size_t WS_Q = 64 * MiB, WS_KIMG = 80 * MiB, WS_VIMG = 96 * MiB, WS_U = 112 * MiB, WS_SLAB = 128 * MiB;
constexpr size_t WS_HM = 64 * MiB;
constexpr size_t WS_PB = 184 * MiB, WS_PROJ = 192 * MiB, WS_MIX = 224 * MiB, WS_END = 256 * MiB;
static_assert(WS_HM + (size_t)M * FF * 2 <= WS_PB && WS_SLAB + 56 * MiB <= WS_PB, "HM overlay");
constexpr int CW_TMO = 0, CW_CODE = 1, CW_QMAX = 32, CW_KMAX = 33, CW_KBAR = 34  , CW_QUEUE = 64, CW_UCNT = 1024  , CW_BAR = 4096;
constexpr int MAX_SPLIT_UNITS = 144;

constexpr int RING_OFF = 0, RING_BYTES = 131072;
constexpr int LDSCTL_OFF = RING_BYTES, MISC_OFF = LDSCTL_OFF + 320;
constexpr int LDS_BYTES = 147456;
constexpr int NWAVES = 8;

__device__ __forceinline__ float wave_sum(float v) {
#pragma unroll
    for (int o = 1; o < 64; o <<= 1) v += __shfl_xor(v, o);
    return v;
}
__device__ __forceinline__ float wave_max(float v) {
#pragma unroll
    for (int o = 1; o < 64; o <<= 1) v = fmaxf(v, __shfl_xor(v, o));
    return v;
}
__device__ __forceinline__ float bflo(unsigned w) { return __builtin_bit_cast(float, w << 16); }
__device__ __forceinline__ float bfhi(unsigned w) { return __builtin_bit_cast(float, w & 0xffff0000u); }

__device__ __forceinline__ void transpose_item(const float* W, int ldw, int K, bf16* WT, int k0, int n0, int dst0, LAS float* scr, int lane, const float* rowgain = nullptr) {
    float v[32];
#pragma unroll
    for (int i = 0; i < 32; ++i) { const int kk = 2 * i + (lane >> 5); v[i] = __builtin_nontemporal_load(&W[(size_t)(k0 + kk) * ldw + n0 + (lane & 31)]); }
    if (rowgain) {
#pragma unroll
        for (int i = 0; i < 32; ++i) v[i] *= rowgain[k0 + 2 * i + (lane >> 5)]; }
#pragma unroll
    for (int i = 0; i < 32; ++i) scr[(2 * i + (lane >> 5)) * 33 + (lane & 31)] = v[i];
    LDS_WAIT(); asm volatile("" ::: "memory");
    const int c = lane & 7;
#pragma unroll
    for (int j = 0; j < 4; ++j) { const int n = (lane >> 3) + 8 * j; const LAS float* s = scr + (8 * c) * 33 + n;
        v4u o; o.x = pk2(s[0 * 33], s[1 * 33]); o.y = pk2(s[2 * 33], s[3 * 33]); o.z = pk2(s[4 * 33], s[5 * 33]); o.w = pk2(s[6 * 33], s[7 * 33]);
        *(GAS v4u*)(WT + (size_t)(dst0 + n) * K + k0 + 8 * c) = o; }
    LDS_WAIT(); asm volatile("" ::: "memory");
}
__device__ __forceinline__ int in_dst_row(int s) {
    if (s < 1024) { const int part = s >> 9, sp = s & 511, tp = sp >> 8, sl = sp & 255, wc = sl >> 6, bj = (sl >> 5) & 1; return (part * 2 + tp) * 256 + 128 * bj + 32 * wc; }
    if (s < 1536) return s;
    if (s < 2048) { const int ch = s - 1536; return 1536 + 256 * (ch >> 7) + (ch & 127); }
    const int ch = s - 2048; return 1536 + 256 * (ch >> 7) + 128 + (ch & 127);
}
struct Args { const float* in[23]; float* out; unsigned char* ws; int ph_lo, ph_hi, li, pad; };

__device__ __forceinline__ void p0_prologue(const Args& a, LAS unsigned char* lds, int vcu, int G, int wave, int lane) {
    LAS float* scr = (LAS float*)(lds + RING_OFF + wave * 16384);
    const int gw = vcu * NWAVES + wave, NGW = G * NWAVES;
    unsigned char* ws = a.ws;
    constexpr int I_IN = 16 * 80;
    for (int it = gw; it < I_IN; it += NGW) { const int kb = it / 80, nb = it % 80; transpose_item(a.in[3], NIN, DM, (bf16*)(ws + WS_WIN), 64 * kb, 32 * nb, in_dst_row(32 * nb), scr, lane, a.in[2]); }
    const float* x = a.in[0];
    bf16* XN = (bf16*)(ws + WS_XN); float* SS0 = (float*)(ws + WS_SS0);
    for (int m = gw; m < M; m += NGW) {
        const GAS f32x4* xr = (const GAS f32x4*)(x + (size_t)m * DM) + lane;
        f32x4 v[4]; float s = 0.f;
#pragma unroll
        for (int j = 0; j < 4; ++j) { v[j] = __builtin_nontemporal_load(&xr[64 * j]); s += (v[j].x * v[j].x + v[j].y * v[j].y) + (v[j].z * v[j].z + v[j].w * v[j].w); }
        GAS unsigned long long* o8 = (GAS unsigned long long*)(XN + (size_t)m * DM) + lane;
#pragma unroll
        for (int j = 0; j < 4; ++j) o8[64 * j] = (unsigned long long)pk2(v[j].x, v[j].y) | ((unsigned long long)pk2(v[j].z, v[j].w) << 32);
        s = wave_sum(s);
        if (lane == 0) SS0[m] = s;
    }
}
constexpr int WI_OUT = 16 * 32, WI_G = 16 * 88, WI_DN = 44 * 32, WI_PG = 16 * 32, WI_PP = 4 * 32, W_ITEMS = WI_OUT + 2 * WI_G + WI_DN + WI_PG + WI_PP, N_W_UNITS = (W_ITEMS + 31) / 32;
constexpr int N_PB_UNITS = M / 256;
__device__ __forceinline__ void weight_unit(int wu, const Args& a, LAS unsigned char* lds, int wave, int lane) {
    asm volatile("" : "+v"(lane));
    LAS float* scr = (LAS float*)(lds + RING_OFF + wave * 16384);
    unsigned char* ws = a.ws;
    for (int q = 0; q < 4; ++q) {
        asm volatile("" : "+v"(lane));
        int r = wu * 32 + wave * 4 + q; if (r >= W_ITEMS) break;
        if (r < WI_OUT) { const int kb = r / 32, nb = r % 32; transpose_item(a.in[15], DM, DM, (bf16*)(ws + WS_WOUT), 64 * kb, 32 * nb, 32 * nb, scr, lane); continue; } r -= WI_OUT;
        if (r < WI_G) { const int kb = r / 88, nb = r % 88, n0 = 32 * nb; transpose_item(a.in[17], FF, DM, (bf16*)(ws + WS_WGU), 64 * kb, n0, 256 * (n0 >> 7) + (n0 & 127), scr, lane, a.in[16]); continue; } r -= WI_G;
        if (r < WI_G) { const int kb = r / 88, nb = r % 88, n0 = 32 * nb; transpose_item(a.in[18], FF, DM, (bf16*)(ws + WS_WGU), 64 * kb, n0, 256 * (n0 >> 7) + 128 + (n0 & 127), scr, lane, a.in[16]); continue; } r -= WI_G;
        if (r < WI_DN) { const int kb = r / 32, nb = r % 32; transpose_item(a.in[19], DM, FF, (bf16*)(ws + WS_WDN), 64 * kb, 32 * nb, 32 * nb, scr, lane); continue; } r -= WI_DN;
        if (r < WI_PG) { const int kb = r / 32, nb = r % 32; transpose_item(a.in[21], DM, DM, (bf16*)(ws + WS_WPG), 64 * kb, 32 * nb, 32 * nb, scr, lane, a.in[20]); continue; } r -= WI_PG;
        { const int kb = r / 32, nb = r % 32; transpose_item(a.in[22], DM, PD, (bf16*)(ws + WS_WPP), 64 * kb, 32 * nb, 32 * nb, scr, lane); }
    }
    __syncthreads();
}

__device__ __forceinline__ void pb_unit(int pu, const float* p, bf16* PB, int wave, int lane) {
    asm volatile("" : "+v"(lane));
#pragma unroll
    for (int half = 0; half < 2; ++half) { const int m0 = pu * 256 + wave * 32 + half * 16; f32x4 pv[16];
#pragma unroll
        for (int j = 0; j < 16; ++j) pv[j] = __builtin_nontemporal_load(&((const GAS f32x4*)(p + (size_t)(m0 + j) * PD))[lane]);
#pragma unroll
        for (int j = 0; j < 16; ++j) ((GAS unsigned long long*)(PB + (size_t)(m0 + j) * PD))[lane] = (unsigned long long)pk2(pv[j].x, pv[j].y) | ((unsigned long long)pk2(pv[j].z, pv[j].w) << 32); }
    __syncthreads();
}
constexpr int CONV_W_LDS = 96 * 1024;
__device__ __forceinline__ void conv_unit(int cu, const bf16* U, const float* cw, const float* cb, const float* lg, const float* lb, bf16* MIX, LAS unsigned char* lds, int tid, int wave, int lane, bool& w_staged) {
    asm volatile("" : "+v"(tid), "+v"(lane));
    const int r0 = cu * 64;
    const f32x4 b0 = *(const f32x4*)(cb + 8 * lane), b1 = *(const f32x4*)(cb + 8 * lane + 4);
    const f32x4 g0 = *(const f32x4*)(lg + 8 * lane), g1 = *(const f32x4*)(lg + 8 * lane + 4), c0 = *(const f32x4*)(lb + 8 * lane), c1 = *(const f32x4*)(lb + 8 * lane + 4);
    if (!w_staged) {
        f32x4 wv[4][2];
#pragma unroll
        for (int k = 0; k < 4; ++k) { const int i = tid + 512 * k; if (i < KC * 64) { wv[k][0] = *(const f32x4*)(cw + 8 * i); wv[k][1] = *(const f32x4*)(cw + 8 * i + 4); } }
#pragma unroll
        for (int k = 0; k < 4; ++k) { const int i = tid + 512 * k; if (i < KC * 64) { v4u o;
            o.x = __builtin_bit_cast(unsigned, __builtin_amdgcn_cvt_pkrtz(wv[k][0].x, wv[k][0].y)); o.y = __builtin_bit_cast(unsigned, __builtin_amdgcn_cvt_pkrtz(wv[k][0].z, wv[k][0].w));
            o.z = __builtin_bit_cast(unsigned, __builtin_amdgcn_cvt_pkrtz(wv[k][1].x, wv[k][1].y)); o.w = __builtin_bit_cast(unsigned, __builtin_amdgcn_cvt_pkrtz(wv[k][1].z, wv[k][1].w));
            *(LAS v4u*)(lds + CONV_W_LDS + i * 16) = o; } }
        w_staged = true;
    }
    { v4u uv[12];
#pragma unroll
      for (int k = 0; k < 12; ++k) { const int i = tid + 512 * k, rr = i >> 6, pc = i & 63, r = r0 - 15 + rr, rc = r < 0 ? 0 : (r > M - 1 ? M - 1 : r);
          uv[k] = *(const GAS v4u*)(U + (size_t)rc * CW + pc * 8); }
#pragma unroll
      for (int k = 0; k < 12; ++k) { const int i = tid + 512 * k, rr = i >> 6, pc = i & 63, r = r0 - 15 + rr; const bool in = r >= 0 && r < M;
          v4u v = uv[k]; v.x = in ? v.x : 0u; v.y = in ? v.y : 0u; v.z = in ? v.z : 0u; v.w = in ? v.w : 0u;
          if (i < 94 * 64) *(LAS v4u*)(lds + rr * 1024 + pc * 16) = v; } }
    __syncthreads();
    typedef _Float16 h2 __attribute__((ext_vector_type(2)));
    h2 hacc[8][4];
    { const h2 i0 = __builtin_bit_cast(h2, __builtin_amdgcn_cvt_pkrtz(b0.x, b0.y)), i1 = __builtin_bit_cast(h2, __builtin_amdgcn_cvt_pkrtz(b0.z, b0.w)), i2 = __builtin_bit_cast(h2, __builtin_amdgcn_cvt_pkrtz(b1.x, b1.y)), i3 = __builtin_bit_cast(h2, __builtin_amdgcn_cvt_pkrtz(b1.z, b1.w));
#pragma unroll
      for (int j = 0; j < 8; ++j) { hacc[j][0] = i0; hacc[j][1] = i1; hacc[j][2] = i2; hacc[j][3] = i3; } }
    {
        typedef _Float16 h8 __attribute__((ext_vector_type(8)));
        const LAS unsigned char* ub = lds + (wave * 8) * 1024 + lane * 16; const LAS unsigned char* wb = lds + CONV_W_LDS + lane * 16;
        h8 uu[8];
#pragma unroll
        for (int j = 0; j < 7; ++j) uu[j] = *(const LAS h8*)(ub + j * 1024);
        h8 kw = *(const LAS h8*)(wb);
#pragma unroll
        for (int t = 0; t < KC; ++t) {
            uu[(t + 7) & 7] = *(const LAS h8*)(ub + (t + 7) * 1024);
            const h8 kwn = *(const LAS h8*)(wb + (t + 1 < KC ? t + 1 : t) * 1024);
            const h2 k0 = __builtin_shufflevector(kw, kw, 0, 1), k1 = __builtin_shufflevector(kw, kw, 2, 3), k2 = __builtin_shufflevector(kw, kw, 4, 5), k3 = __builtin_shufflevector(kw, kw, 6, 7);
#pragma unroll
            for (int j = 0; j < 8; ++j) { const h8 u = uu[(t + j) & 7];
                hacc[j][0] = __builtin_shufflevector(u, u, 0, 1) * k0 + hacc[j][0]; hacc[j][1] = __builtin_shufflevector(u, u, 2, 3) * k1 + hacc[j][1];
                hacc[j][2] = __builtin_shufflevector(u, u, 4, 5) * k2 + hacc[j][2]; hacc[j][3] = __builtin_shufflevector(u, u, 6, 7) * k3 + hacc[j][3]; }
            kw = kwn;
        }
    }
    float acc[8][8];
#pragma unroll
    for (int j = 0; j < 8; ++j)
#pragma unroll
        for (int k = 0; k < 4; ++k) { acc[j][2 * k] = (float)hacc[j][k][0]; acc[j][2 * k + 1] = (float)hacc[j][k][1]; }
#pragma unroll
    for (int j = 0; j < 8; ++j) {
        float s = ((acc[j][0] + acc[j][1]) + (acc[j][2] + acc[j][3])) + ((acc[j][4] + acc[j][5]) + (acc[j][6] + acc[j][7]));
        const float mu = wave_sum(s) * (1.f / CW); float q = 0.f;
#pragma unroll
        for (int e = 0; e < 8; ++e) { acc[j][e] -= mu; q += acc[j][e] * acc[j][e]; }
        const float r = rsqrtf(wave_sum(q) * (1.f / CW) + EPS);
        float z[8];
        z[0] = acc[j][0] * r * g0.x + c0.x; z[1] = acc[j][1] * r * g0.y + c0.y; z[2] = acc[j][2] * r * g0.z + c0.z; z[3] = acc[j][3] * r * g0.w + c0.w;
        z[4] = acc[j][4] * r * g1.x + c1.x; z[5] = acc[j][5] * r * g1.y + c1.y; z[6] = acc[j][6] * r * g1.z + c1.z; z[7] = acc[j][7] * r * g1.w + c1.w;
#pragma unroll
        for (int e = 0; e < 8; ++e) z[e] = z[e] * fsigmoid(z[e]);
        v4u o; o.x = pk2(z[0], z[1]); o.y = pk2(z[2], z[3]); o.z = pk2(z[4], z[5]); o.w = pk2(z[6], z[7]);
        *(GAS v4u*)(MIX + (size_t)(r0 + wave * 8 + j) * DM + AW + 8 * lane) = o;
    }
    __syncthreads();
}

namespace att {
typedef short bf16x8 __attribute__((ext_vector_type(8)));
typedef short s16x4 __attribute__((ext_vector_type(4)));
typedef float f32x16 __attribute__((ext_vector_type(16)));
typedef float f32x4 __attribute__((ext_vector_type(4)));
typedef unsigned u32x4 __attribute__((ext_vector_type(4)));
constexpr int LDS_HN = 8 * 16384 + 13312;
constexpr int SLOT = 16384, LDS_K = 0, LDS_V = 4 * SLOT, LDS_WS = 8 * SLOT + 4096  , XSTRIDE = 132, SLAB_FLOATS = 8 * 4160;
typedef __attribute__((address_space(3))) const char* lds_cptr;
typedef short v4i16_t __attribute__((ext_vector_type(4)));
__device__ __forceinline__ int crow(int r, int hi) { return (r & 3) + 8 * (r >> 2) + 4 * hi; }
__device__ __forceinline__ void glds2k(const unsigned char* sbase, unsigned voff, unsigned lds_dst) { unsigned keep; const unsigned lds_dst2 = lds_dst + 1024u, voff2 = voff + 1024u;
    asm volatile("s_mov_b32 %0, m0\n\ts_mov_b32 m0, %3\n\ts_nop 0\n\tglobal_load_lds_dwordx4 %1, %2\n\ts_nop 0\n\ts_mov_b32 m0, %4\n\ts_nop 0\n\tglobal_load_lds_dwordx4 %5, %2\n\ts_nop 0\n\ts_mov_b32 m0, %0"
                 : "=&s"(keep) : "v"(voff), "s"(sbase), "s"(lds_dst), "s"(lds_dst2), "v"(voff2) : "memory"); }
#define ATT_WAIT_BAR(N) asm volatile("s_waitcnt vmcnt(" #N ") lgkmcnt(0)\n\ts_barrier" ::: "memory")
__device__ __forceinline__ unsigned cvtpk(float lo, float hi) { unsigned r; asm volatile("v_cvt_pk_bf16_f32 %0, %1, %2" : "=v"(r) : "v"(lo), "v"(hi)); return r; }
__device__ __forceinline__ int v_rd_base(int lane) { return ((lane >> 4) & 1) * 32 + (lane & 3) * 8 + (4 * (lane >> 5) + ((lane & 15) >> 2)) * 64; }
__device__ __forceinline__ s16x4 vtr(lds_cptr p) { return __builtin_bit_cast(s16x4, __builtin_amdgcn_ds_read_tr16_b64_v4i16((__attribute__((address_space(3))) v4i16_t*)p)); }
#define SBAR() __builtin_amdgcn_sched_barrier(0)
__device__ __forceinline__ void qkt_acc(f32x16& p0, f32x16& p1, lds_cptr kp, const bf16x8* qr) {
#pragma unroll
    for (int d0 = 0; d0 < 4; ++d0) {
        const bf16x8 b0 = *(const __attribute__((address_space(3))) bf16x8*)(kp + d0 * 2048);
        const bf16x8 b1 = *(const __attribute__((address_space(3))) bf16x8*)(kp + d0 * 2048 + 512);
        p0 = __builtin_amdgcn_mfma_f32_32x32x16_bf16(b0, qr[d0], p0, 0, 0, 0);
        p1 = __builtin_amdgcn_mfma_f32_32x32x16_bf16(b1, qr[d0], p1, 0, 0, 0);
    }
}
__device__ __forceinline__ void bias_general(f32x16& p0, f32x16& p1, float dq, float nslope2, float shift2) {
#pragma unroll
    for (int r = 0; r < 16; ++r) { const float c = (float)((r & 3) + 8 * (r >> 2)); p0[r] = __builtin_fmaf(nslope2, __builtin_fabsf(dq - c), -shift2); p1[r] = __builtin_fmaf(nslope2, __builtin_fabsf(dq - (c + 32.f)), -shift2); }
}
__device__ __forceinline__ void softmax_first(f32x16& p0, f32x16& p1, bf16x8& pa0, bf16x8& pa1, bf16x8& pa2) {
#pragma unroll
    for (int r = 0; r < 16; ++r) { p0[r] = __builtin_amdgcn_exp2f(p0[r]); p1[r] = __builtin_amdgcn_exp2f(p1[r]); }
    { u32x4 w = {cvtpk(p0[0], p0[1]), cvtpk(p0[2], p0[3]), cvtpk(p0[4], p0[5]), cvtpk(p0[6], p0[7])}; pa0 = __builtin_bit_cast(bf16x8, w); }
    { u32x4 w = {cvtpk(p0[8], p0[9]), cvtpk(p0[10], p0[11]), cvtpk(p0[12], p0[13]), cvtpk(p0[14], p0[15])}; pa1 = __builtin_bit_cast(bf16x8, w); }
    { u32x4 w = {cvtpk(p1[0], p1[1]), cvtpk(p1[2], p1[3]), cvtpk(p1[4], p1[5]), cvtpk(p1[6], p1[7])}; pa2 = __builtin_bit_cast(bf16x8, w); }
}
template <int KBITS> __device__ __forceinline__ float fmamk_s(float a, float c) { float r; asm("v_fmamk_f32 %0, %1, %2, %3" : "=v"(r) : "v"(a), "n"(KBITS), "v"(c)); return r; }
#define ATT_ROT3(x) do { (x) = ((x) + SLOT) & (4 * SLOT - 1); } while (0)
#define ATT_DMA2(src, tile, dstoff) do { int t_ = (tile); t_ = t_ < t_hi ? t_ : t_hi; glds2k((src) + (size_t)t_ * SLOT, lane16, (unsigned)(dstoff)); } while (0)
#define ATT_ISSUE_DMA() do { ATT_DMA2(ksrc, tj + 4, kdst + sk_dma); ATT_DMA2(vsrc, tj + 2, vdst + sv_dma); ++tj; } while (0)
#define ATT_STEP(P0, P1, X0, X1, DO_EXP, DO_QK, JJ) do { \
    if (lead_half || (JJ) == 0) { ATT_WAIT_BAR(4); } \
    ATT_ISSUE_DMA(); \
    { const lds_cptr vb_ = vp0 + sv_cur; const lds_cptr kb_ = kp0 + sk_cur; \
      s16x4 vl0, vh0, vl1, vh1, vl2, vh2; bf16x8 kf0, kf1, kf2; unsigned t0_, t1_, t2_, t3_; \
      const int k02_ = (tj + 1) * 64  ; const bool right_ = k02_ >= qw0 + 31, mixed_ = !right_ && (k02_ + 63 > qw0); \
      const float dq2_ = dq1 - 64.f, ss_ = right_ ? nslope2 : -nslope2, xl0_ = __builtin_fmaf(-ss_, dq2_, -shift2), xl1_ = __builtin_fmaf(ss_, 32.f, xl0_); \
      vl0 = vtr(vb_ + 0); vh0 = vtr(vb_ + 512); vl1 = vtr(vb_ + 4096); vh1 = vtr(vb_ + 4608); SBAR(); \
      vl2 = vtr(vb_ + 8192); vh2 = vtr(vb_ + 8704); o[0] = __builtin_amdgcn_mfma_f32_32x32x16_bf16(pa0, (bf16x8){vl0[0], vl0[1], vl0[2], vl0[3], vh0[0], vh0[1], vh0[2], vh0[3]}, o[0], 0, 0, 0); if (DO_EXP) { X0[0] = __builtin_amdgcn_exp2f(X0[0]); } t0_ = cvtpk(P1[8], P1[9]); t1_ = cvtpk(P1[10], P1[11]); SBAR(); \
      vl0 = vtr(vb_ + 12288); vh0 = vtr(vb_ + 12800); o[1] = __builtin_amdgcn_mfma_f32_32x32x16_bf16(pa0, (bf16x8){vl1[0], vl1[1], vl1[2], vl1[3], vh1[0], vh1[1], vh1[2], vh1[3]}, o[1], 0, 0, 0); if (DO_EXP) { X0[1] = __builtin_amdgcn_exp2f(X0[1]); } t2_ = cvtpk(P1[12], P1[13]); t3_ = cvtpk(P1[14], P1[15]); { u32x4 w_ = {t0_, t1_, t2_, t3_}; pa3 = __builtin_bit_cast(bf16x8, w_); } SBAR(); \
      vl1 = vtr(vb_ + 1024); vh1 = vtr(vb_ + 1536); o[2] = __builtin_amdgcn_mfma_f32_32x32x16_bf16(pa0, (bf16x8){vl2[0], vl2[1], vl2[2], vl2[3], vh2[0], vh2[1], vh2[2], vh2[3]}, o[2], 0, 0, 0); if (DO_EXP) { X0[2] = __builtin_amdgcn_exp2f(X0[2]); } if (DO_EXP) { X0[3] = __builtin_amdgcn_exp2f(X0[3]); } SBAR(); \
      vl2 = vtr(vb_ + 5120); vh2 = vtr(vb_ + 5632); o[3] = __builtin_amdgcn_mfma_f32_32x32x16_bf16(pa0, (bf16x8){vl0[0], vl0[1], vl0[2], vl0[3], vh0[0], vh0[1], vh0[2], vh0[3]}, o[3], 0, 0, 0); lacc4 = __builtin_amdgcn_mfma_f32_16x16x32_bf16(lmask, pa0, lacc4, 0, 0, 0); if (DO_EXP) { X0[4] = __builtin_amdgcn_exp2f(X0[4]); } if (DO_QK) { P0[0] = fmamk_s<0>(ss_, xl0_); } if (DO_QK) { P0[1] = fmamk_s<1065353216>(ss_, xl0_); } if (DO_QK) { P0[2] = fmamk_s<1073741824>(ss_, xl0_); } SBAR(); \
      vl0 = vtr(vb_ + 9216); vh0 = vtr(vb_ + 9728); o[0] = __builtin_amdgcn_mfma_f32_32x32x16_bf16(pa1, (bf16x8){vl1[0], vl1[1], vl1[2], vl1[3], vh1[0], vh1[1], vh1[2], vh1[3]}, o[0], 0, 0, 0); if (DO_EXP) { X0[5] = __builtin_amdgcn_exp2f(X0[5]); } if (DO_QK) { P0[3] = fmamk_s<1077936128>(ss_, xl0_); } if (DO_QK) { P0[4] = fmamk_s<1090519040>(ss_, xl0_); } SBAR(); \
      vl1 = vtr(vb_ + 13312); vh1 = vtr(vb_ + 13824); o[1] = __builtin_amdgcn_mfma_f32_32x32x16_bf16(pa1, (bf16x8){vl2[0], vl2[1], vl2[2], vl2[3], vh2[0], vh2[1], vh2[2], vh2[3]}, o[1], 0, 0, 0); if (DO_EXP) { X0[6] = __builtin_amdgcn_exp2f(X0[6]); } if (DO_EXP) { X0[7] = __builtin_amdgcn_exp2f(X0[7]); } if (DO_QK) { P0[5] = fmamk_s<1091567616>(ss_, xl0_); } if (DO_QK) { P0[6] = fmamk_s<1092616192>(ss_, xl0_); } if (DO_QK) { P0[7] = fmamk_s<1093664768>(ss_, xl0_); } SBAR(); \
      vl2 = vtr(vb_ + 2048); vh2 = vtr(vb_ + 2560); o[2] = __builtin_amdgcn_mfma_f32_32x32x16_bf16(pa1, (bf16x8){vl0[0], vl0[1], vl0[2], vl0[3], vh0[0], vh0[1], vh0[2], vh0[3]}, o[2], 0, 0, 0); if (DO_EXP) { X0[8] = __builtin_amdgcn_exp2f(X0[8]); } if (DO_EXP) { t0_ = cvtpk(X0[0], X0[1]); t1_ = cvtpk(X0[2], X0[3]); } if (DO_QK) { P0[8] = fmamk_s<1098907648>(ss_, xl0_); } if (DO_QK) { P0[9] = fmamk_s<1099431936>(ss_, xl0_); } SBAR(); \
      vl0 = vtr(vb_ + 6144); vh0 = vtr(vb_ + 6656); o[3] = __builtin_amdgcn_mfma_f32_32x32x16_bf16(pa1, (bf16x8){vl1[0], vl1[1], vl1[2], vl1[3], vh1[0], vh1[1], vh1[2], vh1[3]}, o[3], 0, 0, 0); lacc4 = __builtin_amdgcn_mfma_f32_16x16x32_bf16(lmask, pa1, lacc4, 0, 0, 0); if (DO_EXP) { X0[9] = __builtin_amdgcn_exp2f(X0[9]); } if (DO_EXP) { t2_ = cvtpk(X0[4], X0[5]); t3_ = cvtpk(X0[6], X0[7]); { u32x4 w_ = {t0_, t1_, t2_, t3_}; pa0 = __builtin_bit_cast(bf16x8, w_); } } if (DO_QK) { P0[10] = fmamk_s<1099956224>(ss_, xl0_); } if (DO_QK) { P0[11] = fmamk_s<1100480512>(ss_, xl0_); } if (DO_QK) { P0[12] = fmamk_s<1103101952>(ss_, xl0_); } SBAR(); \
      vl1 = vtr(vb_ + 10240); vh1 = vtr(vb_ + 10752); o[0] = __builtin_amdgcn_mfma_f32_32x32x16_bf16(pa2, (bf16x8){vl2[0], vl2[1], vl2[2], vl2[3], vh2[0], vh2[1], vh2[2], vh2[3]}, o[0], 0, 0, 0); if (DO_EXP) { X0[10] = __builtin_amdgcn_exp2f(X0[10]); } if (DO_EXP) { X0[11] = __builtin_amdgcn_exp2f(X0[11]); } if (DO_QK) { P0[13] = fmamk_s<1103626240>(ss_, xl0_); } if (DO_QK) { P0[14] = fmamk_s<1104150528>(ss_, xl0_); } SBAR(); \
      vl2 = vtr(vb_ + 14336); vh2 = vtr(vb_ + 14848); o[1] = __builtin_amdgcn_mfma_f32_32x32x16_bf16(pa2, (bf16x8){vl0[0], vl0[1], vl0[2], vl0[3], vh0[0], vh0[1], vh0[2], vh0[3]}, o[1], 0, 0, 0); if (DO_EXP) { X0[12] = __builtin_amdgcn_exp2f(X0[12]); } if (DO_QK) { P0[15] = fmamk_s<1104674816>(ss_, xl0_); } if (DO_QK) { P1[0] = fmamk_s<0>(ss_, xl1_); } if (DO_QK) { P1[1] = fmamk_s<1065353216>(ss_, xl1_); } SBAR(); \
      vl0 = vtr(vb_ + 3072); vh0 = vtr(vb_ + 3584); o[2] = __builtin_amdgcn_mfma_f32_32x32x16_bf16(pa2, (bf16x8){vl1[0], vl1[1], vl1[2], vl1[3], vh1[0], vh1[1], vh1[2], vh1[3]}, o[2], 0, 0, 0); if (DO_EXP) { X0[13] = __builtin_amdgcn_exp2f(X0[13]); } if (DO_QK) { P1[2] = fmamk_s<1073741824>(ss_, xl1_); } if (DO_QK) { P1[3] = fmamk_s<1077936128>(ss_, xl1_); } SBAR(); \
      vl1 = vtr(vb_ + 7168); vh1 = vtr(vb_ + 7680); o[3] = __builtin_amdgcn_mfma_f32_32x32x16_bf16(pa2, (bf16x8){vl2[0], vl2[1], vl2[2], vl2[3], vh2[0], vh2[1], vh2[2], vh2[3]}, o[3], 0, 0, 0); lacc4 = __builtin_amdgcn_mfma_f32_16x16x32_bf16(lmask, pa2, lacc4, 0, 0, 0); if (DO_EXP) { X0[14] = __builtin_amdgcn_exp2f(X0[14]); } if (DO_EXP) { X0[15] = __builtin_amdgcn_exp2f(X0[15]); } if (DO_QK) { P1[4] = fmamk_s<1090519040>(ss_, xl1_); } if (DO_QK) { P1[5] = fmamk_s<1091567616>(ss_, xl1_); } if (DO_QK) { P1[6] = fmamk_s<1092616192>(ss_, xl1_); } SBAR(); \
      if (!lead_half && (JJ) + 1 < NT) { ATT_WAIT_BAR(4); }     \
      vl2 = vtr(vb_ + 11264); vh2 = vtr(vb_ + 11776); o[0] = __builtin_amdgcn_mfma_f32_32x32x16_bf16(pa3, (bf16x8){vl0[0], vl0[1], vl0[2], vl0[3], vh0[0], vh0[1], vh0[2], vh0[3]}, o[0], 0, 0, 0); if (DO_EXP) { X1[0] = __builtin_amdgcn_exp2f(X1[0]); } if (DO_EXP) { t0_ = cvtpk(X0[8], X0[9]); t1_ = cvtpk(X0[10], X0[11]); } if (DO_QK) { P1[7] = fmamk_s<1093664768>(ss_, xl1_); } if (DO_QK) { P1[8] = fmamk_s<1098907648>(ss_, xl1_); } SBAR(); \
      vl0 = vtr(vb_ + 15360); vh0 = vtr(vb_ + 15872); o[1] = __builtin_amdgcn_mfma_f32_32x32x16_bf16(pa3, (bf16x8){vl1[0], vl1[1], vl1[2], vl1[3], vh1[0], vh1[1], vh1[2], vh1[3]}, o[1], 0, 0, 0); if (DO_EXP) { X1[1] = __builtin_amdgcn_exp2f(X1[1]); } if (DO_EXP) { t2_ = cvtpk(X0[12], X0[13]); t3_ = cvtpk(X0[14], X0[15]); { u32x4 w_ = {t0_, t1_, t2_, t3_}; pa1 = __builtin_bit_cast(bf16x8, w_); } } if (DO_QK) { P1[9] = fmamk_s<1099431936>(ss_, xl1_); } if (DO_QK) { P1[10] = fmamk_s<1099956224>(ss_, xl1_); } if (DO_QK) { P1[11] = fmamk_s<1100480512>(ss_, xl1_); } SBAR(); \
      if (DO_QK) kf0 = *(const __attribute__((address_space(3))) bf16x8*)(kb_ + 0); o[2] = __builtin_amdgcn_mfma_f32_32x32x16_bf16(pa3, (bf16x8){vl2[0], vl2[1], vl2[2], vl2[3], vh2[0], vh2[1], vh2[2], vh2[3]}, o[2], 0, 0, 0); if (DO_EXP) { X1[2] = __builtin_amdgcn_exp2f(X1[2]); } if (DO_EXP) { X1[3] = __builtin_amdgcn_exp2f(X1[3]); } if (DO_QK) { P1[12] = fmamk_s<1103101952>(ss_, xl1_); } if (DO_QK) { P1[13] = fmamk_s<1103626240>(ss_, xl1_); } SBAR(); \
      if (DO_QK) kf1 = *(const __attribute__((address_space(3))) bf16x8*)(kb_ + 512); o[3] = __builtin_amdgcn_mfma_f32_32x32x16_bf16(pa3, (bf16x8){vl0[0], vl0[1], vl0[2], vl0[3], vh0[0], vh0[1], vh0[2], vh0[3]}, o[3], 0, 0, 0); lacc4 = __builtin_amdgcn_mfma_f32_16x16x32_bf16(lmask, pa3, lacc4, 0, 0, 0); if (DO_EXP) { X1[4] = __builtin_amdgcn_exp2f(X1[4]); } if (DO_QK) { P1[14] = fmamk_s<1104150528>(ss_, xl1_); } if (DO_QK) { P1[15] = fmamk_s<1104674816>(ss_, xl1_); } SBAR(); if (DO_QK && mixed_) { const float c2_ = -2.f * nslope2; P0[0] += c2_ * __builtin_fminf(dq2_ - 0.f, 0.f); P0[1] += c2_ * __builtin_fminf(dq2_ - 1.f, 0.f); P0[2] += c2_ * __builtin_fminf(dq2_ - 2.f, 0.f); P0[3] += c2_ * __builtin_fminf(dq2_ - 3.f, 0.f); P0[4] += c2_ * __builtin_fminf(dq2_ - 8.f, 0.f); P0[5] += c2_ * __builtin_fminf(dq2_ - 9.f, 0.f); P0[6] += c2_ * __builtin_fminf(dq2_ - 10.f, 0.f); P0[7] += c2_ * __builtin_fminf(dq2_ - 11.f, 0.f); P0[8] += c2_ * __builtin_fminf(dq2_ - 16.f, 0.f); P0[9] += c2_ * __builtin_fminf(dq2_ - 17.f, 0.f); P0[10] += c2_ * __builtin_fminf(dq2_ - 18.f, 0.f); P0[11] += c2_ * __builtin_fminf(dq2_ - 19.f, 0.f); P0[12] += c2_ * __builtin_fminf(dq2_ - 24.f, 0.f); P0[13] += c2_ * __builtin_fminf(dq2_ - 25.f, 0.f); P0[14] += c2_ * __builtin_fminf(dq2_ - 26.f, 0.f); P0[15] += c2_ * __builtin_fminf(dq2_ - 27.f, 0.f); P1[0] += c2_ * __builtin_fminf(dq2_ - 32.f, 0.f); P1[1] += c2_ * __builtin_fminf(dq2_ - 33.f, 0.f); P1[2] += c2_ * __builtin_fminf(dq2_ - 34.f, 0.f); P1[3] += c2_ * __builtin_fminf(dq2_ - 35.f, 0.f); P1[4] += c2_ * __builtin_fminf(dq2_ - 40.f, 0.f); P1[5] += c2_ * __builtin_fminf(dq2_ - 41.f, 0.f); P1[6] += c2_ * __builtin_fminf(dq2_ - 42.f, 0.f); P1[7] += c2_ * __builtin_fminf(dq2_ - 43.f, 0.f); P1[8] += c2_ * __builtin_fminf(dq2_ - 48.f, 0.f); P1[9] += c2_ * __builtin_fminf(dq2_ - 49.f, 0.f); P1[10] += c2_ * __builtin_fminf(dq2_ - 50.f, 0.f); P1[11] += c2_ * __builtin_fminf(dq2_ - 51.f, 0.f); P1[12] += c2_ * __builtin_fminf(dq2_ - 56.f, 0.f); P1[13] += c2_ * __builtin_fminf(dq2_ - 57.f, 0.f); P1[14] += c2_ * __builtin_fminf(dq2_ - 58.f, 0.f); P1[15] += c2_ * __builtin_fminf(dq2_ - 59.f, 0.f); } SBAR(); \
      if (DO_QK) kf2 = *(const __attribute__((address_space(3))) bf16x8*)(kb_ + 2048); if (DO_QK) P0 = __builtin_amdgcn_mfma_f32_32x32x16_bf16(kf0, qr[0], P0, 0, 0, 0); if (DO_EXP) { X1[5] = __builtin_amdgcn_exp2f(X1[5]); } SBAR(); \
      if (DO_QK) kf0 = *(const __attribute__((address_space(3))) bf16x8*)(kb_ + 2560); if (DO_QK) P1 = __builtin_amdgcn_mfma_f32_32x32x16_bf16(kf1, qr[0], P1, 0, 0, 0); if (DO_EXP) { X1[6] = __builtin_amdgcn_exp2f(X1[6]); } if (DO_EXP) { X1[7] = __builtin_amdgcn_exp2f(X1[7]); } SBAR(); \
      if (DO_QK) kf1 = *(const __attribute__((address_space(3))) bf16x8*)(kb_ + 4096); if (DO_QK) P0 = __builtin_amdgcn_mfma_f32_32x32x16_bf16(kf2, qr[1], P0, 0, 0, 0); if (DO_EXP) { X1[8] = __builtin_amdgcn_exp2f(X1[8]); } if (DO_EXP) { t0_ = cvtpk(X1[0], X1[1]); t1_ = cvtpk(X1[2], X1[3]); } SBAR(); \
      if (DO_QK) kf2 = *(const __attribute__((address_space(3))) bf16x8*)(kb_ + 4608); if (DO_QK) P1 = __builtin_amdgcn_mfma_f32_32x32x16_bf16(kf0, qr[1], P1, 0, 0, 0); if (DO_EXP) { X1[9] = __builtin_amdgcn_exp2f(X1[9]); } if (DO_EXP) { t2_ = cvtpk(X1[4], X1[5]); t3_ = cvtpk(X1[6], X1[7]); { u32x4 w_ = {t0_, t1_, t2_, t3_}; pa2 = __builtin_bit_cast(bf16x8, w_); } } SBAR(); \
      if (DO_QK) kf0 = *(const __attribute__((address_space(3))) bf16x8*)(kb_ + 6144); if (DO_QK) P0 = __builtin_amdgcn_mfma_f32_32x32x16_bf16(kf1, qr[2], P0, 0, 0, 0); if (DO_EXP) { X1[10] = __builtin_amdgcn_exp2f(X1[10]); } if (DO_EXP) { X1[11] = __builtin_amdgcn_exp2f(X1[11]); } SBAR(); \
      if (DO_QK) kf1 = *(const __attribute__((address_space(3))) bf16x8*)(kb_ + 6656); if (DO_QK) P1 = __builtin_amdgcn_mfma_f32_32x32x16_bf16(kf2, qr[2], P1, 0, 0, 0); if (DO_EXP) { X1[12] = __builtin_amdgcn_exp2f(X1[12]); } SBAR(); \
      if (DO_QK) P0 = __builtin_amdgcn_mfma_f32_32x32x16_bf16(kf0, qr[3], P0, 0, 0, 0); if (DO_EXP) { X1[13] = __builtin_amdgcn_exp2f(X1[13]); } SBAR(); \
      if (DO_QK) P1 = __builtin_amdgcn_mfma_f32_32x32x16_bf16(kf1, qr[3], P1, 0, 0, 0); if (DO_EXP) { X1[14] = __builtin_amdgcn_exp2f(X1[14]); } if (DO_EXP) { X1[15] = __builtin_amdgcn_exp2f(X1[15]); } SBAR(); \
    } \
    dq1 -= 64.f; ATT_ROT3(sk_cur); ATT_ROT3(sv_cur); ATT_ROT3(sk_dma); ATT_ROT3(sv_dma); } while (0)

struct UnitDesc { int u, h, qb, nc, ci, sid, t_lo, t_hi; float slope; };
constexpr int ITEM_FROM_PRE = 8192 - 1024;
__device__ __forceinline__ float att_window(float Bn, float Cn, float slope) {
    const float a1 = 2.f * Bn + 18.2f, a2 = Bn + Cn + 63.f * slope + __logf(1.f / (64.f * slope)) + 18.2f;
    return (ATT_EXACT_ZERO ? 104.f + 2.f * Bn : fminf(a1, a2)) / slope;
}
__device__ __forceinline__ UnitDesc decode_unit(int idx, float Bn, float Cn, const __attribute__((address_space(3))) unsigned short* pre, const __attribute__((address_space(3))) unsigned short* sidx) {
    UnitDesc d;
    const unsigned it_ = (unsigned)__builtin_amdgcn_readfirstlane((int)((const __attribute__((address_space(3))) unsigned*)((const __attribute__((address_space(3))) unsigned char*)pre + ITEM_FROM_PRE))[idx]);
    d.u = (int)(it_ & 511u); d.ci = (int)((it_ >> 10) & 3u); d.nc = (int)((it_ >> 12) & 3u); d.sid = __builtin_amdgcn_readfirstlane((int)sidx[d.u]);
    const int k = d.u & 127; d.h = 3 - (d.u >> 7); d.qb = (k & 1) ? 63 - (k >> 1) : 64 + (k >> 1);
    d.slope = exp2f(-2.f * (float)(d.h + 1));
    const float Rf = att_window(Bn, Cn, d.slope);
    const int R = __builtin_amdgcn_readfirstlane(Rf < 20000.f ? (int)Rf + 1 : 20000);
    const int q0 = d.qb * 128; const int klo = q0 - R < 0 ? 0 : q0 - R, khi = q0 + 127 + R > M - 1 ? M - 1 : q0 + 127 + R;
    const int tlo = klo >> 6, nt = (khi >> 6) - tlo + 1, base = nt / d.nc, rem = nt - base * d.nc;
    d.t_lo = tlo + d.ci * base + (d.ci < rem ? d.ci : rem); d.t_hi = d.t_lo + base + (d.ci < rem ? 1 : 0) - 1;
    return d;
}
__device__ __forceinline__ void attn_unit(int idx, float Bn, float Cn, float lam, const __attribute__((address_space(3))) unsigned short* pre, const __attribute__((address_space(3))) unsigned short* sidx,
                                          const unsigned short* Q, const unsigned char* Kimg, const unsigned char* Vimg, unsigned short* MIX, const float* hn, char* shm,
                                          float* slabs, unsigned* cnts, volatile __attribute__((address_space(3))) unsigned* bcast) {
    const int tid = threadIdx.x, lane = tid & 63, r32 = lane & 31, hi = lane >> 5; const int wid = __builtin_amdgcn_readfirstlane(tid >> 6), rg = wid >> 1, mp = wid & 1;
    const UnitDesc D = decode_unit(idx, Bn, Cn, pre, sidx);
    const int h = D.h, t_lo = D.t_lo, t_hi = D.t_hi; const float slope2 = D.slope * LOG2E;
    const float shift2 = fmaxf(0.f, Bn * LOG2E - 24.f);
    const int q0 = D.qb * 128, NT = t_hi - t_lo + 1;
    const unsigned lds0 = (unsigned)(uintptr_t)shm;
    const unsigned char* ksrc = Kimg + (size_t)h * 256 * SLOT + wid * 2048;
    const unsigned char* vsrc = Vimg + (size_t)h * 256 * SLOT + wid * 2048;
    const unsigned lane16 = (unsigned)lane * 16u;
    const unsigned kdst = lds0 + LDS_K + wid * 2048, vdst = lds0 + LDS_V + wid * 2048;
    const unsigned short* Qw = Q + (size_t)(q0 + rg * 32 + r32) * AW + h * 128 + mp * 64 + hi * 8;
    bf16x8 qr[4];
#pragma unroll
    for (int d0 = 0; d0 < 4; ++d0) qr[d0] = *(const bf16x8*)(Qw + d0 * 16);
    int tj = t_lo;
    ATT_DMA2(ksrc, tj, kdst); ATT_DMA2(ksrc, tj + 1, kdst + SLOT); ATT_DMA2(vsrc, tj, vdst); ATT_DMA2(ksrc, tj + 2, kdst + 2 * SLOT); ATT_DMA2(ksrc, tj + 3, kdst + 3 * SLOT); ATT_DMA2(vsrc, tj + 1, vdst + SLOT);
    const lds_cptr shm3 = (lds_cptr)shm;
    const lds_cptr kp0 = shm3 + LDS_K + (8 * mp + hi) * 1024 + r32 * 16;
    const lds_cptr vp0 = shm3 + LDS_V + v_rd_base(lane);
    const float dq0 = (float)(q0 + rg * 32 + r32 - t_lo * 64 - 4 * hi);
    const int qw0 = q0 + rg * 32;
    const float nslope2 = -slope2;
    f32x16 o[4]; o[0] = f32x16{}; o[1] = f32x16{}; o[2] = f32x16{}; o[3] = f32x16{};
    f32x4 lacc4 = f32x4{0.f, 0.f, 0.f, 0.f};
    bf16x8 lmask; { const int row_ = lane & 15, kg_ = lane >> 4; const bool on_ = (((row_ & 7) == 0) && ((kg_ & 1) == 0)) || (((row_ & 7) == 4) && ((kg_ & 1) == 1));
                    const short one_ = on_ ? (short)0x3F80 : (short)0; lmask = (bf16x8){one_, one_, one_, one_, one_, one_, one_, one_}; }
    f32x16 sA0, sA1, sB0, sB1; bf16x8 pa0, pa1, pa2, pa3 = bf16x8{};
    bias_general(sA0, sA1, dq0, nslope2, shift2);
    bias_general(sB0, sB1, dq0 - 64.f, nslope2, shift2);
    ATT_WAIT_BAR(8);
    qkt_acc(sA0, sA1, kp0, qr);
    qkt_acc(sB0, sB1, kp0 + SLOT, qr);
    softmax_first(sA0, sA1, pa0, pa1, pa2);
    float dq1 = dq0 - 64.f;
    int sk_cur = 2 * SLOT, sv_cur = 0, sk_dma = 0, sv_dma = 2 * SLOT;
    const bool lead_half = wid < 4;
    if (wid >= 4) __builtin_amdgcn_s_setprio(1);
    int j = 0;
    for (; j + 2 < NT; j += 2) { ATT_STEP(sA0, sA1, sB0, sB1, true, true, j); ATT_STEP(sB0, sB1, sA0, sA1, true, true, j + 1); }
    if (NT - j == 2) { ATT_STEP(sA0, sA1, sB0, sB1, true, true, j);
#pragma unroll
        for (int r = 8; r < 16; ++r) sA1[r] = sB1[r];
        ATT_STEP(sA0, sA1, sB0, sB1, false, false, j + 1); }
    else { ATT_STEP(sA0, sA1, sB0, sB1, false, false, j); }
    __builtin_amdgcn_s_setprio(0);
    float l_acc = lacc4[0];
    ATT_WAIT_BAR(0);
    int idx_e = idx; asm volatile("" : "+s"(idx_e));
    int tid_e = threadIdx.x; asm volatile("" : "+v"(tid_e));
    const int lane_e = tid_e & 63, r32_e = lane_e & 31, hi_e = lane_e >> 5, wid_e = __builtin_amdgcn_readfirstlane(tid_e >> 6), rg_e = wid_e >> 1, mp_e = wid_e & 1;
    const UnitDesc E = decode_unit(idx_e, Bn, Cn, pre, sidx);
    const int nc = E.nc, ci = E.ci, h_e = E.h, q0_e = E.qb * 128;
    float* slab_u = slabs + (size_t)E.sid * 3 * SLAB_FLOATS; unsigned* cnt_u = cnts + E.u;
    if (nc > 1) {
        float* sl = slab_u + (size_t)ci * SLAB_FLOATS + wid_e * 4160;
#pragma unroll
        for (int d0 = 0; d0 < 4; ++d0)
#pragma unroll
            for (int i = 0; i < 4; ++i) { const f32x4 v_ = (f32x4){o[d0][4 * i], o[d0][4 * i + 1], o[d0][4 * i + 2], o[d0][4 * i + 3]};
                asm volatile("global_store_dwordx4 %0, %1, off sc1\n\ts_nop 1" :: "v"(sl + ((d0 * 4 + i) * 64 + lane_e) * 4), "v"(v_) : "memory"); }
        asm volatile("global_store_dword %0, %1, off sc1\n\ts_nop 1" :: "v"(sl + 4096 + lane_e), "v"(l_acc) : "memory");
        asm volatile("s_waitcnt vmcnt(0)" ::: "memory");
        __syncthreads();
        if (tid_e == 0) bcast[0] = __hip_atomic_fetch_add(cnt_u, 1u, __ATOMIC_RELAXED, __HIP_MEMORY_SCOPE_AGENT);
        __syncthreads();
        const unsigned old = bcast[0];
        __syncthreads();
        if ((int)old != nc - 1) return;
        if (tid_e == 0) { __builtin_amdgcn_fence(__ATOMIC_ACQUIRE, "agent"); asm volatile("s_waitcnt vmcnt(0)" ::: "memory"); }
        __syncthreads();
        o[0] = f32x16{}; o[1] = f32x16{}; o[2] = f32x16{}; o[3] = f32x16{}; l_acc = 0.f;
        for (int cc = 0; cc < nc; ++cc) { const float* rs = slab_u + (size_t)cc * SLAB_FLOATS + wid_e * 4160;
            f32x4 sv[16];
#pragma unroll
            for (int k = 0; k < 16; ++k) sv[k] = *(const f32x4*)(rs + (k * 64 + lane_e) * 4);
            const float sl_l = rs[4096 + lane_e];
            asm volatile("" :: "v"(sv[0]), "v"(sv[1]), "v"(sv[2]), "v"(sv[3]), "v"(sv[4]), "v"(sv[5]), "v"(sv[6]), "v"(sv[7]), "v"(sv[8]), "v"(sv[9]), "v"(sv[10]), "v"(sv[11]), "v"(sv[12]), "v"(sv[13]), "v"(sv[14]), "v"(sv[15]));
#pragma unroll
            for (int d0 = 0; d0 < 4; ++d0)
#pragma unroll
                for (int i = 0; i < 4; ++i) { const f32x4 v = sv[d0 * 4 + i]; o[d0][4 * i] += v[0]; o[d0][4 * i + 1] += v[1]; o[d0][4 * i + 2] += v[2]; o[d0][4 * i + 3] += v[3]; }
            l_acc += sl_l; }
    }
    float* wsf = (float*)(shm + LDS_WS) + wid_e * 64;
    if (hi_e == 0) wsf[r32_e] = l_acc;
    asm volatile("s_waitcnt lgkmcnt(0)" ::: "memory");
    float rli[16];
#pragma unroll
    for (int r = 0; r < 16; ++r) rli[r] = __builtin_amdgcn_rcpf(wsf[crow(r, hi_e)]);
    float* X = (float*)shm + rg_e * 32 * XSTRIDE;
    if (mp_e == 1) {
#pragma unroll
        for (int r = 0; r < 16; ++r)
#pragma unroll
            for (int d0 = 0; d0 < 4; ++d0) X[crow(r, hi_e) * XSTRIDE + d0 * 32 + r32_e] = lam * o[d0][r] * rli[r];
    }
    ATT_WAIT_BAR(0);
    if (mp_e == 0) {
#pragma unroll
        for (int r = 0; r < 16; ++r)
#pragma unroll
            for (int d0 = 0; d0 < 4; ++d0) { float* xp = X + crow(r, hi_e) * XSTRIDE + d0 * 32 + r32_e; *xp = o[d0][r] * rli[r] - *xp; }
        asm volatile("s_waitcnt lgkmcnt(0)" ::: "memory");
        const float* xr = X + r32_e * XSTRIDE + hi_e * 64;
        f32x4 v[16]; float ss = 0.f;
#pragma unroll
        for (int i = 0; i < 16; ++i) { v[i] = *(const f32x4*)(xr + 4 * i); ss += (v[i][0] * v[i][0] + v[i][1] * v[i][1]) + (v[i][2] * v[i][2] + v[i][3] * v[i][3]); }
        { auto rr = __builtin_amdgcn_permlane32_swap(__float_as_uint(ss), __float_as_uint(ss), false, false); ss = __uint_as_float(rr[0]) + __uint_as_float(rr[1]); }
        const float rn = rsqrtf(ss * (1.f / 128.f) + EPS) * (1.f - LAM_INIT);
        unsigned short* orow = MIX + (size_t)(q0_e + rg_e * 32 + r32_e) * DM + h_e * 128 + hi_e * 64;
        const __attribute__((address_space(3))) f32x4* g = (const __attribute__((address_space(3))) f32x4*)((lds_cptr)shm + LDS_HN + hi_e * 256);
#pragma unroll
        for (int i = 0; i < 8; ++i) { const f32x4 g0 = g[2 * i], g1 = g[2 * i + 1]; const f32x4 a = v[2 * i] * rn * g0, b = v[2 * i + 1] * rn * g1;
            u32x4 w; w.x = cvtpk(a[0], a[1]); w.y = cvtpk(a[2], a[3]); w.z = cvtpk(b[0], b[1]); w.w = cvtpk(b[2], b[3]); *(u32x4*)(orow + 8 * i) = w; }
    }
    ATT_WAIT_BAR(0);
}
}

constexpr int N_LAUNCHES = MK_N_LAUNCHES, PER_PHASE = 7;
constexpr int N_ATT_UNITS = NH * (M / 128), N_CONV_UNITS = M / 64;

__global__ void __launch_bounds__(NWAVES * 64, 2) fwd(Args args) {
    extern __shared__ __attribute__((aligned(16))) unsigned char lds_raw[];
    LAS unsigned char* lds = (LAS unsigned char*)lds_raw;
    volatile LAS unsigned* MISC = (volatile LAS unsigned*)(lds + MISC_OFF);
    const int tid = threadIdx.x, lane = tid & 63, wave = __builtin_amdgcn_readfirstlane(tid >> 6);
    const int G = gridDim.x; const int bx = blockIdx.x; const int vcu = (G % 8 == 0) ? (bx % 8) * (G / 8) + bx / 8 : bx;
    unsigned char* ws = args.ws;
    gu32* ctl = (gu32*)(ws + WS_CTL);
    for (int u = tid; u < (LDS_BYTES - LDSCTL_OFF) / 4; u += NWAVES * 64) ((LAS unsigned*)(lds + LDSCTL_OFF))[u] = 0u;
    __syncthreads();
    XcdBarrier bar; bar.bar = (unsigned*)(ctl + CW_BAR); bar.x = 0; bar.st = nullptr;
    if (N_LAUNCHES != PER_PHASE) bar = xcd_barrier_post((unsigned*)(ctl + CW_BAR), MISC + 8);
#define GRID_BAR() do { if (N_LAUNCHES != PER_PHASE) xcd_barrier(bar); } while (0)
    const int lo = args.ph_lo, hi = args.ph_hi;
#define IN(k) (lo <= (k) && (k) < hi)
#define BOTH(k) (IN(k) && IN((k) + 1))
    bf16* XN = (bf16*)(ws + WS_XN); bf16* Qb = (bf16*)(ws + WS_Q); unsigned char* Kimg = ws + WS_KIMG; unsigned char* Vimg = ws + WS_VIMG; bf16* Ub = (bf16*)(ws + WS_U);
    bf16* MIX = (bf16*)(ws + WS_MIX); bf16* HM = (bf16*)(ws + WS_HM); bf16* PB = (bf16*)(ws + WS_PB); bf16* PR = (bf16*)(ws + WS_PROJ);
    float* SS1 = (float*)(ws + WS_SS1); float* SS2 = (float*)(ws + WS_SS2);

    if (IN(0)) { p0_prologue(args, lds, vcu, G, wave, lane); if (BOTH(0)) GRID_BAR(); }
    int vc = bx; bool xl = false;
    if (N_LAUNCHES == 1 && IN(0)) { xl = __builtin_amdgcn_readfirstlane((int)MISC[11]) != 0; if (xl) vc = (int)bar.x + 8 * __builtin_amdgcn_readfirstlane((int)MISC[10]); }
#define XCD_BAR() do { if (N_LAUNCHES != PER_PHASE) { if (xl) xcd_local_barrier(bar); else xcd_barrier(bar); } } while (0)

    constexpr int NT1 = (M / 256) * (NIN / 256);
    const int first_idle = NT1 - ((NT1 + G - 1) / G - 1) * G, w_p1 = (N_LAUNCHES == 1) ? ((G - first_idle) < N_W_UNITS ? (G - first_idle) : N_W_UNITS) : 0, w_p2 = N_W_UNITS - w_p1;
    if (IN(1)) {
        { pg8::Gemm g{XN, (const bf16*)(ws + WS_WIN), M, NIN, DM}; pg8::StaticOrder S; S.init(M, NIN, G, bx);
          LAS float* rtab = (LAS float*)(lds + LDSCTL_OFF + 12288); int rpm = -1;
          LAS float* gtab = (LAS float*)(lds + LDSCTL_OFF + 13824);
          if (tid >= 256 && tid < 384) gtab[tid - 256] = tid < 320 ? args.in[4][tid - 256] : args.in[5][tid - 320];
          { pg8::Unit u0; if (S.next(0, u0)) { rpm = u0.pm; if (tid < 256) rtab[tid] = rsqrtf(((const float*)(ws + WS_SS0))[rpm * 256 + tid] * (1.f / DM) + EPS); } __syncthreads(); }
          pg8::EpiIn E{Qb, Kimg, Vimg, Ub, args.in[4], args.in[5], (unsigned*)(ctl + CW_QMAX), (const float*)(ws + WS_SS0), rtab, rpm, gtab, (LAS unsigned*)(lds + LDSCTL_OFF + 14400)};
          pg8::gemm_phase<pg8::EpiIn, pg8::StaticOrder, PG8_ALIGN, PG8_SP2>(lds + RING_OFF, g, S, E);
          __syncthreads();
          if (tid < 3) { const unsigned v = ((LAS unsigned*)(lds + LDSCTL_OFF + 14400))[tid]; if (v) atomicMax((unsigned*)(ctl + CW_QMAX) + tid, v); } }
        if (w_p1 > 0 && bx >= first_idle && bx - first_idle < w_p1) weight_unit(bx - first_idle, args, lds, wave, lane);
        if (BOTH(1)) GRID_BAR();
    }

    if (IN(2)) {
        const unsigned mx3 = __hip_atomic_load((unsigned*)(ctl + CW_QMAX) + (lane < 3 ? lane : 0), __ATOMIC_RELAXED, __HIP_MEMORY_SCOPE_AGENT);
        const float qmax = __uint_as_float(__builtin_amdgcn_readlane(mx3, 0)), kmax = __uint_as_float(__builtin_amdgcn_readlane(mx3, 1)), kbar = __uint_as_float(__builtin_amdgcn_readlane(mx3, 2));
        const float Bn = qmax * kmax * (1.02f / LOG2E);
        const float Cn = qmax * kbar * (1.02f / LOG2E) + 0.05f;
        const float d1 = wave_sum(args.in[6][lane] * args.in[7][lane]), d2 = wave_sum(args.in[8][lane] * args.in[9][lane]);
        const float lam = __expf(d1) - __expf(d2) + LAM_INIT;
        LAS unsigned short* pre = (LAS unsigned short*)(lds + LDSCTL_OFF + 1024);
        LAS unsigned short* sidx = (LAS unsigned short*)(lds + LDSCTL_OFF + 2112);
        LAS unsigned* wtot = (LAS unsigned*)(lds + LDSCTL_OFF + 3200);
        if (tid < 128) ((LAS float*)(lds + att::LDS_HN))[tid] = args.in[10][tid];
        { const int u = tid, h = 3 - (u >> 7), k = u & 127, qb = (k & 1) ? 63 - (k >> 1) : 64 + (k >> 1);
          const float slope = exp2f(-2.f * (float)(h + 1));
          const float Rf = att::att_window(Bn, Cn, slope);
          const int R = Rf < 20000.f ? (int)Rf + 1 : 20000;
          const int q0 = qb * 128; const int klo = q0 - R < 0 ? 0 : q0 - R, khi = q0 + 127 + R > M - 1 ? M - 1 : q0 + 127 + R;
          const int my_nt = (khi >> 6) - (klo >> 6) + 1, want = my_nt > 100 ? 1 : 0;
          int v = want;
#pragma unroll
          for (int o = 1; o < 64; o <<= 1) { const int t = __shfl_up(v, o); if (lane >= o) v += t; }
          if (lane == 63) wtot[wave] = (unsigned)v;
          __syncthreads();
          int off = 0;
          for (int w = 0; w < wave; ++w) off += (int)wtot[w];
          const int sid = off + v - want;
          const int my_nc = (want && sid < MAX_SPLIT_UNITS) ? ((my_nt + 63) / 64 < 3 ? (my_nt + 63) / 64 : 3) : 1;
          sidx[u] = (unsigned short)sid;
          v = my_nc;
#pragma unroll
          for (int o = 1; o < 64; o <<= 1) { const int t = __shfl_up(v, o); if (lane >= o) v += t; }
          if (lane == 63) wtot[8 + wave] = (unsigned)v;
          __syncthreads();
          off = 0;
          for (int w = 0; w < wave; ++w) off += (int)wtot[8 + w];
          pre[u] = (unsigned short)(off + v - my_nc);
          if (u == 511) pre[512] = (unsigned short)(off + v);
          { LAS unsigned* item = (LAS unsigned*)(lds + LDSCTL_OFF + 8192);
            for (int ci = 0; ci < my_nc; ++ci) item[off + v - my_nc + ci] = (unsigned)u | ((unsigned)ci << 10) | ((unsigned)my_nc << 12); }
          __syncthreads(); }
        const int n_att = (int)pre[512];
        unsigned* slabs_cnt = (unsigned*)(ctl + CW_UCNT);
        bool conv_w_staged = false;
        unsigned nx = 0;
        if (tid == 0) nx = __hip_atomic_fetch_add(ctl + CW_QUEUE, 1u, __ATOMIC_RELAXED, __HIP_MEMORY_SCOPE_AGENT);
        for (;;) {
            if (tid == 0) MISC[16] = nx;
            __syncthreads();
            const int idx = __builtin_amdgcn_readfirstlane((int)MISC[16]);
            __syncthreads();
            if (idx >= n_att + w_p2 + N_PB_UNITS + N_CONV_UNITS) break;
            if (tid == 0) nx = __hip_atomic_fetch_add(ctl + CW_QUEUE, 1u, __ATOMIC_RELAXED, __HIP_MEMORY_SCOPE_AGENT);
            if (idx < n_att) {
                att::attn_unit(idx, Bn, Cn, lam, pre, sidx, Qb, Kimg, Vimg, MIX, args.in[10], (char*)lds_raw, (float*)(ws + WS_SLAB), slabs_cnt, MISC + 17);
            } else if (idx < n_att + w_p2) {
                weight_unit(w_p1 + idx - n_att, args, lds, wave, lane);
            } else if (idx < n_att + w_p2 + N_PB_UNITS) {
                pb_unit(idx - n_att - w_p2, args.in[1], PB, wave, lane);
            } else {
                conv_unit(idx - n_att - w_p2 - N_PB_UNITS, Ub, args.in[11], args.in[12], args.in[13], args.in[14], MIX, lds, tid, wave, lane, conv_w_staged);
            }
        }
        if (BOTH(2)) GRID_BAR();
    }

    if (IN(3)) {
        pg8::Gemm g{MIX, (const bf16*)(ws + WS_WOUT), M, DM, DM}; pg8::StaticOrder S; S.init(M, DM, G, vc);
        pg8::EpiRes<false> E{nullptr, XN, SS1};
        pg8::gemm_phase<pg8::EpiRes<false>, pg8::StaticOrder, PG8_ALIGN, PG8_SP2>(lds + RING_OFF, g, S, E);
        if (BOTH(3)) XCD_BAR();
    }
    if (IN(4)) {
        { pg8::Gemm g{XN, (const bf16*)(ws + WS_WGU), M, 2 * FF, DM}; pg8::StaticOrder S; S.init(M, 2 * FF, G, vc);
          LAS float* rtab = (LAS float*)(lds + LDSCTL_OFF + 12288); int rpm = -1;
          { pg8::Unit u0; if (S.next(0, u0)) { rpm = u0.pm; if (tid < 256) { const f32x4* sp = (const f32x4*)(SS1 + (size_t)(rpm * 256 + tid) * 16); const f32x4 a = sp[0], b = sp[1], c = sp[2], d = sp[3];
                rtab[tid] = rsqrtf((((a[0] + a[1]) + (a[2] + a[3])) + ((b[0] + b[1]) + (b[2] + b[3])) + ((c[0] + c[1]) + (c[2] + c[3])) + ((d[0] + d[1]) + (d[2] + d[3]))) * (1.f / DM) + EPS); } } __syncthreads(); }
          pg8::EpiGU E{HM, SS1, rtab, rpm};
          pg8::gemm_phase<pg8::EpiGU, pg8::StaticOrder, PG8_ALIGN, PG8_SP2>(lds + RING_OFF, g, S, E); }
        { int kproj = PD; asm volatile("" : "+s"(kproj));
          pg8::Gemm g{PB, (const bf16*)(ws + WS_WPP), M, DM, kproj}; pg8::HelperOrder S{G, vc};
          pg8::EpiBf16 E{PR, DM};
          pg8::gemm_phase<pg8::EpiBf16, pg8::HelperOrder, PG8_ALIGN, PG8_SP2>(lds + RING_OFF, g, S, E); }
        if (BOTH(4)) XCD_BAR();
    }
    if (IN(5)) {
        pg8::Gemm g{HM, (const bf16*)(ws + WS_WDN), M, DM, FF}; pg8::StaticOrder S; S.init(M, DM, G, vc);
        pg8::EpiRes<false> E{nullptr, XN, SS2};
        pg8::gemm_phase<pg8::EpiRes<false>, pg8::StaticOrder, PG8_ALIGN, PG8_SP2>(lds + RING_OFF, g, S, E);
        if (BOTH(5)) XCD_BAR();
    }
    if (IN(6)) {
        pg8::Gemm g{XN, (const bf16*)(ws + WS_WPG), M, DM, DM}; pg8::StaticOrder S; S.init(M, DM, G, vc);
        LAS float* rtab = (LAS float*)(lds + LDSCTL_OFF + 12288); int rpm = -1;
        { pg8::Unit u0; if (S.next(0, u0)) { rpm = u0.pm; if (tid < 256) { const f32x4* sp = (const f32x4*)(SS2 + (size_t)(rpm * 256 + tid) * 16); const f32x4 a = sp[0], b = sp[1], c = sp[2], d = sp[3];
              rtab[tid] = rsqrtf((((a[0] + a[1]) + (a[2] + a[3])) + ((b[0] + b[1]) + (b[2] + b[3])) + ((c[0] + c[1]) + (c[2] + c[3])) + ((d[0] + d[1]) + (d[2] + d[3]))) * (1.f / DM) + EPS); } } __syncthreads(); }
        pg8::EpiPG E{args.out, XN, PR, SS2, rtab, rpm};
        pg8::gemm_phase<pg8::EpiPG, pg8::StaticOrder, PG8_ALIGN, PG8_SP2>(lds + RING_OFF, g, S, E);
    }
#undef IN
#undef BOTH
#undef GRID_BAR
#undef XCD_BAR
}

extern "C" void kernel_launch(void* const* d_in, const int* in_sizes, int n_in, void* d_out, int out_size, void* d_ws, size_t ws_size, hipStream_t stream) {
    static int grid = 0;
    if (grid == 0) {
        if (n_in != 23 || in_sizes[0] != M * DM || out_size != M * DM || ws_size < WS_END) { fprintf(stderr, "kernel_launch: unexpected shapes (n_in %d, out %d, ws %zu); nothing launched\n", n_in, out_size, ws_size); grid = -1; return; }
        int dev = 0, cus = 0, per_cu = 0;
        if (hipGetDevice(&dev) != hipSuccess || hipDeviceGetAttribute(&cus, hipDeviceAttributeMultiprocessorCount, dev) != hipSuccess) { grid = -1; return; }
        if (hipFuncSetAttribute((const void*)fwd, hipFuncAttributeMaxDynamicSharedMemorySize, LDS_BYTES) != hipSuccess) { fprintf(stderr, "kernel_launch: hipFuncSetAttribute failed\n"); grid = -1; return; }
        const hipError_t oe = hipOccupancyMaxActiveBlocksPerMultiprocessor(&per_cu, (const void*)fwd, NWAVES * 64, LDS_BYTES);
        (void)hipGetLastError();
        if (oe == hipSuccess && per_cu < 1) { fprintf(stderr, "kernel_launch: the occupancy query admits no workgroup of this kernel per CU; nothing launched\n"); grid = -1; return; }
        grid = cus;
    }
    if (grid < 0) return;
    if (hipMemsetAsync((char*)d_ws + WS_CTL, 0, CTL_ZERO_BYTES, stream) != hipSuccess) { fprintf(stderr, "kernel_launch: memset failed\n"); return; }
    Args a{};
    for (int i = 0; i < 23; ++i) a.in[i] = (const float*)d_in[i];
    a.out = (float*)d_out; a.ws = (unsigned char*)d_ws;
    for (int li = 0; li < N_LAUNCHES; ++li) {
        a.ph_lo = (N_LAUNCHES == PER_PHASE) ? li : 0; a.ph_hi = (N_LAUNCHES == PER_PHASE) ? li + 1 : PER_PHASE; a.li = li;
        hipLaunchKernelGGL(fwd, dim3(grid), dim3(NWAVES * 64), LDS_BYTES, stream, a);
        const hipError_t le = hipPeekAtLastError();
        if (le != hipSuccess) { fprintf(stderr, "kernel_launch: launch %d failed: %s\n", li, hipGetErrorName(le)); break; }
    }
}
```

```cpp
#include <hip/hip_runtime.h>
#include <cstdio>
#include <cstdint>

#ifndef ATT_EXACT_ZERO
#define ATT_EXACT_ZERO 0
#endif
#ifndef MK_N_LAUNCHES
#define MK_N_LAUNCHES 1
#endif

constexpr int M = 16384, DM = 1024, NIN = 2560, AW = 512, CW = 512, NH = 4, DH = 64, VH = 128, KC = 31, FF = 2816, PD = 256;
constexpr float EPS = 1e-6f;
constexpr float LOG2E = 1.4426950408889634f;
constexpr float QSCALE = 0.125f * LOG2E;
constexpr float LAM_INIT = 0.2f;

__host__ __device__ __forceinline__ int v_st(int k, int c) { return ((c >> 5) * 4 + (k >> 4)) * 1024 + (k & 15) * 64 + (c & 31) * 2; }
__host__ __device__ __forceinline__ int k_st(int k, int c) { return (c >> 3) * 1024 + k * 16 + (c & 7) * 2; }
__device__ __forceinline__ float fsigmoid(float x) { return __builtin_amdgcn_rcpf(1.f + __builtin_amdgcn_exp2f(-LOG2E * x)); }

namespace pg8 {
#define PG8_LAS __attribute__((address_space(3)))
typedef unsigned short bf16_t;
typedef short bf16x8 __attribute__((ext_vector_type(8)));
typedef float f32x4 __attribute__((ext_vector_type(4)));
typedef unsigned u32x4 __attribute__((ext_vector_type(4)));
constexpr int BM = 256, BK = 64, HALF = 128, HTB = HALF * BK * 2  , STAGE_BYTES = 8 * HTB, NXCD = 8, WGM = 8;

__host__ __device__ __forceinline__ int lds_byte(int r, int c) { const int st = (r >> 4) * 2 + (c >> 5), rr = r & 15, cc = c & 31, ob = rr * 64 + cc * 2; return st * 1024 + (ob ^ (((ob >> 9) & 1) << 5)); }
__host__ __device__ __forceinline__ void stage_rc(int b, int& R, int& C) { const int st = b / 1024, sb = b % 1024, swz = sb ^ (((sb >> 9) & 1) << 5); R = (st >> 1) * 16 + swz / 64; C = (st & 1) * 32 + (swz % 64) / 2; }
__host__ __device__ __forceinline__ int perm32(int rho) { const int n = rho >> 4, i = rho & 15; return 8 * (i >> 2) + 4 * n + (i & 3); }

struct Unit { int pm, pn; };
struct Gemm { const bf16_t* A; const bf16_t* Bt; int M, N, K; };

struct StaticOrder {
    int nM, nN, nwg, G, c;
    __host__ __device__ void init(int M, int N, int G_, int c_) { nM = M / BM; nN = N / BM; nwg = nM * nN; G = G_; c = c_; }
    __host__ __device__ bool next(int i, Unit& u) const {
        const long L = (long)i * G + c; if (L >= nwg) return false;
        int wgid = (int)L; { const int q = nwg / NXCD, r = nwg % NXCD, xcd = wgid % NXCD, off = wgid / NXCD; wgid = (xcd < r ? xcd * (q + 1) : r * (q + 1) + (xcd - r) * q) + off; }
        const int nig = WGM * nN, gid = wgid / nig, fm = gid * WGM, gsz = (nM - fm) < WGM ? (nM - fm) : WGM;
        u.pm = fm + ((wgid % nig) % gsz); u.pn = (wgid % nig) / gsz; return true;
    }
    __device__ __forceinline__ void a_ready(const Unit&) const {}
    __device__ __forceinline__ void done(const Unit&) const {}
};


__device__ __forceinline__ float sum_fq(float v) {
    { auto r = __builtin_amdgcn_permlane32_swap(__float_as_uint(v), __float_as_uint(v), false, false); v = __uint_as_float(r[0]) + __uint_as_float(r[1]); }
    { auto r = __builtin_amdgcn_permlane16_swap(__float_as_uint(v), __float_as_uint(v), false, false); v = __uint_as_float(r[0]) + __uint_as_float(r[1]); }
    return v;
}
__device__ __forceinline__ unsigned cvt_pk_bf16(float lo, float hi) { unsigned r; asm volatile("v_cvt_pk_bf16_f32 %0, %1, %2" : "=v"(r) : "v"(lo), "v"(hi)); return r; }
typedef _Float16 half2_t __attribute__((ext_vector_type(2)));
__device__ __forceinline__ unsigned pkh(float lo, float hi) { return __builtin_bit_cast(unsigned, __builtin_amdgcn_cvt_pkrtz(lo, hi)); }
__device__ __forceinline__ u32x4 pack8_f16(const f32x4 a, const f32x4 b) { u32x4 w; w.x = pkh(a[0], a[1]); w.y = pkh(a[2], a[3]); w.z = pkh(b[0], b[1]); w.w = pkh(b[2], b[3]); return w; }
__device__ __forceinline__ u32x4 pack8(const f32x4 a, const f32x4 b) { u32x4 w; w.x = cvt_pk_bf16(a[0], a[1]); w.y = cvt_pk_bf16(a[2], a[3]); w.z = cvt_pk_bf16(b[0], b[1]); w.w = cvt_pk_bf16(b[2], b[3]); return w; }

struct EpiBf16 {
    static constexpr bool PERM = true, AFTER_DRAIN = false;
    bf16_t* O; int ldc;
    __device__ __forceinline__ void operator()(const f32x4 (&acc)[2][2][4][2], const Unit& u, int wr, int wc, int fr, int fq) const {
        const int row0 = u.pm * BM + wr * 64 + fr, col0 = u.pn * BM + wc * 32 + 8 * fq;
#pragma unroll
        for (int ai = 0; ai < 2; ++ai)
#pragma unroll
            for (int m = 0; m < 4; ++m) { bf16_t* rowp = O + (size_t)(row0 + ai * HALF + m * 16) * ldc + col0;
#pragma unroll
                for (int bj = 0; bj < 2; ++bj) *(u32x4*)(rowp + bj * HALF) = pack8(acc[ai][bj][m][0], acc[ai][bj][m][1]); }
    }
};

struct EpiIn {
    static constexpr bool PERM = true, AFTER_DRAIN = false;
    bf16_t* Q; unsigned char* Kimg; unsigned char* Vimg; bf16_t* U; const float* qn; const float* kn; unsigned* nmax; const float* SS0; const PG8_LAS float* rtab; int rtab_pm; const PG8_LAS float* gtab; PG8_LAS unsigned* nmax_lds;
    __device__ __forceinline__ void operator()(const f32x4 (&acc)[2][2][4][2], const Unit& u, int wr, int wc, int fr, int fq) const {
        const int row0 = u.pm * BM + wr * 64 + fr;
        float r0s[2][4];
        if (u.pm == rtab_pm) {
#pragma unroll
            for (int ai = 0; ai < 2; ++ai)
#pragma unroll
                for (int m = 0; m < 4; ++m) r0s[ai][m] = rtab[wr * 64 + fr + ai * HALF + m * 16];
        } else {
#pragma unroll
            for (int ai = 0; ai < 2; ++ai)
#pragma unroll
                for (int m = 0; m < 4; ++m) r0s[ai][m] = SS0[row0 + ai * HALF + m * 16];
#pragma unroll
            for (int ai = 0; ai < 2; ++ai)
#pragma unroll
                for (int m = 0; m < 4; ++m) r0s[ai][m] = rsqrtf(r0s[ai][m] * (1.f / DM) + EPS);
        }
        if (u.pn < 4) {
            float nn_max = 0.f;
            const bool isq = u.pn < 2; const PG8_LAS float* gn = gtab + (isq ? 0 : 64); const float sc = isq ? QSCALE : 1.f;
            const int gidx = (u.pn & 1) * 4 + wc;
            f32x4 g[2][2];
#pragma unroll
            for (int bj = 0; bj < 2; ++bj)
#pragma unroll
                for (int n = 0; n < 2; ++n) g[bj][n] = *(const PG8_LAS f32x4*)(gn + 32 * bj + 8 * fq + 4 * n);
            float kbar2_max = 0.f;
#pragma unroll
            for (int ai = 0; ai < 2; ++ai) {
                f32x4 cs[2][2];
#pragma unroll
                for (int bj = 0; bj < 2; ++bj) { cs[bj][0] = (f32x4){0.f, 0.f, 0.f, 0.f}; cs[bj][1] = (f32x4){0.f, 0.f, 0.f, 0.f}; }
#pragma unroll
                for (int m = 0; m < 4; ++m) {
                    float ss = 0.f;
#pragma unroll
                    for (int bj = 0; bj < 2; ++bj)
#pragma unroll
                        for (int n = 0; n < 2; ++n) { const f32x4 x = acc[ai][bj][m][n]; ss += (x[0] * x[0] + x[1] * x[1]) + (x[2] * x[2] + x[3] * x[3]); }
                    ss = sum_fq(ss);
                    const int row = row0 + ai * HALF + m * 16; float nn = 0.f;
                    const float r0 = r0s[ai][m];
                    const float r = rsqrtf(ss * (r0 * r0) * (1.f / 64.f) + EPS) * (r0 * sc);
#pragma unroll
                    for (int bj = 0; bj < 2; ++bj) {
                        const f32x4 v0 = acc[ai][bj][m][0] * r * g[bj][0], v1 = acc[ai][bj][m][1] * r * g[bj][1];
                        nn += (v0[0] * v0[0] + v0[1] * v0[1]) + (v0[2] * v0[2] + v0[3] * v0[3]) + (v1[0] * v1[0] + v1[1] * v1[1]) + (v1[2] * v1[2] + v1[3] * v1[3]);
                        if (!isq) { cs[bj][0] += v0; cs[bj][1] += v1; }
                        const u32x4 w = pack8(v0, v1);
                        if (isq) *(u32x4*)(Q + (size_t)row * AW + gidx * 64 + 32 * bj + 8 * fq) = w;
                        else *(u32x4*)(Kimg + (size_t)((gidx >> 1) * 256 + (row >> 6)) * 16384 + k_st(row & 63, (gidx & 1) * 64 + 32 * bj + 8 * fq)) = w;
                    }
                    nn = sum_fq(nn); nn_max = fmaxf(nn_max, nn);
                }
                if (!isq) {
                    float kb = 0.f;
#pragma unroll
                    for (int bj = 0; bj < 2; ++bj)
#pragma unroll
                        for (int n = 0; n < 2; ++n)
#pragma unroll
                            for (int e = 0; e < 4; ++e) { float c = cs[bj][n][e];
#pragma unroll
                                for (int o = 1; o < 16; o <<= 1) c += __shfl_xor(c, o);
                                kb += c * c; }
                    kb = sum_fq(kb);
                    kbar2_max = fmaxf(kbar2_max, kb * (1.f / 4096.f));
                }
            }
#pragma unroll
            for (int o = 1; o < 16; o <<= 1) nn_max = fmaxf(nn_max, __shfl_xor(nn_max, o));
            if ((threadIdx.x & 63) == 0) (void)__hip_atomic_fetch_max(nmax_lds + (isq ? 0 : 1), __float_as_uint(sqrtf(nn_max)), __ATOMIC_RELAXED, __HIP_MEMORY_SCOPE_WORKGROUP);
            if (!isq && (threadIdx.x & 63) == 0) (void)__hip_atomic_fetch_max(nmax_lds + 2, __float_as_uint(sqrtf(kbar2_max)), __ATOMIC_RELAXED, __HIP_MEMORY_SCOPE_WORKGROUP);
        } else if (u.pn < 6) {
#pragma unroll
            for (int ai = 0; ai < 2; ++ai)
#pragma unroll
                for (int m = 0; m < 4; ++m) { const int row = row0 + ai * HALF + m * 16; const float r0 = r0s[ai][m];
#pragma unroll
                    for (int bj = 0; bj < 2; ++bj) { const int h = (u.pn - 4) * 2 + bj;
                        *(u32x4*)(Vimg + (size_t)(h * 256 + (row >> 6)) * 16384 + v_st(row & 63, wc * 32 + 8 * fq)) = pack8(acc[ai][bj][m][0] * r0, acc[ai][bj][m][1] * r0); } }
        } else {
            const int ch0 = (u.pn - 6) * 128 + wc * 32 + 8 * fq;
#pragma unroll
            for (int ai = 0; ai < 2; ++ai)
#pragma unroll
                for (int m = 0; m < 4; ++m) { const int row = row0 + ai * HALF + m * 16; f32x4 v[2]; const float r0 = r0s[ai][m];
                    const float r2 = -LOG2E * r0, ir0 = __builtin_amdgcn_rcpf(r0);
#pragma unroll
                    for (int n = 0; n < 2; ++n) { const f32x4 a = acc[ai][0][m][n], gt = acc[ai][1][m][n];
                        const f32x4 t = gt * r2; const f32x4 ex = (f32x4){__builtin_amdgcn_exp2f(t[0]), __builtin_amdgcn_exp2f(t[1]), __builtin_amdgcn_exp2f(t[2]), __builtin_amdgcn_exp2f(t[3])};
                        const f32x4 den = ex * ir0 + ir0; v[n] = a * (f32x4){__builtin_amdgcn_rcpf(den[0]), __builtin_amdgcn_rcpf(den[1]), __builtin_amdgcn_rcpf(den[2]), __builtin_amdgcn_rcpf(den[3])}; }
                    *(u32x4*)(U + (size_t)row * CW + ch0) = pack8_f16(v[0], v[1]); }
        }
    }
};

template <bool F32BASE> struct EpiRes {
    static constexpr bool PERM = true, AFTER_DRAIN = false;
    const float* base; bf16_t* Xb; float* SS;
    __device__ __forceinline__ void operator()(const f32x4 (&acc)[2][2][4][2], const Unit& u, int wr, int wc, int fr, int fq) const {
        static_assert(!F32BASE, "the residual base is the bf16 stream");
        const int row0 = u.pm * BM + wr * 64 + fr, col0 = u.pn * BM + wc * 32 + 8 * fq;
        u32x4 bva[2][4][2];
#pragma unroll
        for (int ai = 0; ai < 2; ++ai)
#pragma unroll
            for (int m = 0; m < 4; ++m)
#pragma unroll
                for (int bj = 0; bj < 2; ++bj) bva[ai][m][bj] = *(const u32x4*)(Xb + (size_t)(row0 + ai * HALF + m * 16) * DM + col0 + bj * HALF);
        asm volatile("" :: "v"(bva[0][0][0]), "v"(bva[0][1][0]), "v"(bva[0][2][0]), "v"(bva[0][3][0]), "v"(bva[1][0][0]), "v"(bva[1][1][0]), "v"(bva[1][2][0]), "v"(bva[1][3][0]), "v"(bva[0][0][1]), "v"(bva[0][1][1]), "v"(bva[0][2][1]), "v"(bva[0][3][1]), "v"(bva[1][0][1]), "v"(bva[1][1][1]), "v"(bva[1][2][1]), "v"(bva[1][3][1]));
#pragma unroll
        for (int ai = 0; ai < 2; ++ai) {
#pragma unroll
            for (int m = 0; m < 4; ++m) { const int row = row0 + ai * HALF + m * 16; float ss = 0.f;
#pragma unroll
                for (int bj = 0; bj < 2; ++bj) { const size_t off = (size_t)row * DM + col0 + bj * HALF; const u32x4 b = bva[ai][m][bj];
                    f32x4 x0 = (f32x4){__builtin_bit_cast(float, b.x << 16), __builtin_bit_cast(float, b.x & 0xffff0000u), __builtin_bit_cast(float, b.y << 16), __builtin_bit_cast(float, b.y & 0xffff0000u)};
                    f32x4 x1 = (f32x4){__builtin_bit_cast(float, b.z << 16), __builtin_bit_cast(float, b.z & 0xffff0000u), __builtin_bit_cast(float, b.w << 16), __builtin_bit_cast(float, b.w & 0xffff0000u)};
                    x0 += acc[ai][bj][m][0]; x1 += acc[ai][bj][m][1];
                    ss += (x0[0] * x0[0] + x0[1] * x0[1]) + (x0[2] * x0[2] + x0[3] * x0[3]) + (x1[0] * x1[0] + x1[1] * x1[1]) + (x1[2] * x1[2] + x1[3] * x1[3]);
                    *(u32x4*)(Xb + off) = pack8(x0, x1); }
                ss = sum_fq(ss);
                if (fq == 0) SS[(size_t)row * 16 + u.pn * 4 + wc] = ss; }
        }
    }
};
__device__ __forceinline__ void row_rstd8(const float* SS, int row0, int fq, float (&rs)[2][4]) {
#pragma unroll
    for (int ai = 0; ai < 2; ++ai)
#pragma unroll
        for (int m = 0; m < 4; ++m) { const f32x4 t = *(const f32x4*)(SS + (size_t)(row0 + ai * HALF + m * 16) * 16 + 4 * fq); rs[ai][m] = (t[0] + t[1]) + (t[2] + t[3]); }
#pragma unroll
    for (int ai = 0; ai < 2; ++ai)
#pragma unroll
        for (int m = 0; m < 4; ++m) { float v = sum_fq(rs[ai][m]); rs[ai][m] = rsqrtf(v * (1.f / DM) + EPS); }
}
struct EpiGU {
    static constexpr bool PERM = true, AFTER_DRAIN = false;
    bf16_t* HM; const float* SS; const PG8_LAS float* rtab; int rtab_pm;
    __device__ __forceinline__ void operator()(const f32x4 (&acc)[2][2][4][2], const Unit& u, int wr, int wc, int fr, int fq) const {
        const int row0 = u.pm * BM + wr * 64 + fr, col0 = u.pn * HALF + wc * 32 + 8 * fq;
        float rs[2][4];
        if (u.pm == rtab_pm) {
#pragma unroll
            for (int ai = 0; ai < 2; ++ai)
#pragma unroll
                for (int m = 0; m < 4; ++m) rs[ai][m] = rtab[wr * 64 + fr + ai * HALF + m * 16];
        } else row_rstd8(SS, row0, fq, rs);
#pragma unroll
        for (int ai = 0; ai < 2; ++ai)
#pragma unroll
            for (int m = 0; m < 4; ++m) { const int row = row0 + ai * HALF + m * 16; const float r = rs[ai][m]; f32x4 v[2];
                const float r2 = -LOG2E * r, ir2 = __builtin_amdgcn_rcpf(r * r);
#pragma unroll
                for (int n = 0; n < 2; ++n) { const f32x4 gt = acc[ai][0][m][n], up = acc[ai][1][m][n];
                    const f32x4 t = gt * r2, gu = gt * up; f32x4 ex = (f32x4){__builtin_amdgcn_exp2f(t[0]), __builtin_amdgcn_exp2f(t[1]), __builtin_amdgcn_exp2f(t[2]), __builtin_amdgcn_exp2f(t[3])};
                    const f32x4 den = ex * ir2 + ir2; const f32x4 rc = (f32x4){__builtin_amdgcn_rcpf(den[0]), __builtin_amdgcn_rcpf(den[1]), __builtin_amdgcn_rcpf(den[2]), __builtin_amdgcn_rcpf(den[3])};
                    v[n] = gu * rc; }
                *(u32x4*)(HM + (size_t)row * FF + col0) = pack8(v[0], v[1]); }
    }
};
struct EpiPG {
    static constexpr bool PERM = true, AFTER_DRAIN = false;
    float* out; const bf16_t* Xb; const bf16_t* PR; const float* SS; const PG8_LAS float* rtab; int rtab_pm;
    __device__ __forceinline__ void operator()(const f32x4 (&acc)[2][2][4][2], const Unit& u, int wr, int wc, int fr, int fq) const {
        const int row0 = u.pm * BM + wr * 64 + fr, col0 = u.pn * BM + wc * 32 + 8 * fq;
        float rs[2][4];
        if (u.pm == rtab_pm) {
#pragma unroll
            for (int ai = 0; ai < 2; ++ai)
#pragma unroll
                for (int m = 0; m < 4; ++m) rs[ai][m] = rtab[wr * 64 + fr + ai * HALF + m * 16];
        } else row_rstd8(SS, row0, fq, rs);
#pragma unroll
        for (int ai = 0; ai < 2; ++ai) {
            u32x4 prv[4][2], xbv[4][2];
#pragma unroll
            for (int m = 0; m < 4; ++m)
#pragma unroll
                for (int bj = 0; bj < 2; ++bj) { const size_t off = (size_t)(row0 + ai * HALF + m * 16) * DM + col0 + bj * HALF; prv[m][bj] = *(const u32x4*)(PR + off); xbv[m][bj] = *(const u32x4*)(Xb + off); }
#pragma unroll
            for (int m = 0; m < 4; ++m) { const int row = row0 + ai * HALF + m * 16; const float r = rs[ai][m];
#pragma unroll
                for (int bj = 0; bj < 2; ++bj) { const size_t off = (size_t)row * DM + col0 + bj * HALF;
                    const u32x4 pr = prv[m][bj], xb = xbv[m][bj];
                    const float rl = -LOG2E * r;
                    const f32x4 t0 = acc[ai][bj][m][0] * rl, t1 = acc[ai][bj][m][1] * rl;
                    const f32x4 d0 = (f32x4){__builtin_amdgcn_exp2f(t0[0]), __builtin_amdgcn_exp2f(t0[1]), __builtin_amdgcn_exp2f(t0[2]), __builtin_amdgcn_exp2f(t0[3])} + 1.f;
                    const f32x4 d1 = (f32x4){__builtin_amdgcn_exp2f(t1[0]), __builtin_amdgcn_exp2f(t1[1]), __builtin_amdgcn_exp2f(t1[2]), __builtin_amdgcn_exp2f(t1[3])} + 1.f;
                    const f32x4 s0 = (f32x4){__builtin_amdgcn_rcpf(d0[0]), __builtin_amdgcn_rcpf(d0[1]), __builtin_amdgcn_rcpf(d0[2]), __builtin_amdgcn_rcpf(d0[3])}, s1 = (f32x4){__builtin_amdgcn_rcpf(d1[0]), __builtin_amdgcn_rcpf(d1[1]), __builtin_amdgcn_rcpf(d1[2]), __builtin_amdgcn_rcpf(d1[3])};
                    const f32x4 x0 = (f32x4){__builtin_bit_cast(float, xb.x << 16), __builtin_bit_cast(float, xb.x & 0xffff0000u), __builtin_bit_cast(float, xb.y << 16), __builtin_bit_cast(float, xb.y & 0xffff0000u)};
                    const f32x4 x1 = (f32x4){__builtin_bit_cast(float, xb.z << 16), __builtin_bit_cast(float, xb.z & 0xffff0000u), __builtin_bit_cast(float, xb.w << 16), __builtin_bit_cast(float, xb.w & 0xffff0000u)};
                    const f32x4 p0 = (f32x4){__builtin_bit_cast(float, pr.x << 16), __builtin_bit_cast(float, pr.x & 0xffff0000u), __builtin_bit_cast(float, pr.y << 16), __builtin_bit_cast(float, pr.y & 0xffff0000u)};
                    const f32x4 p1 = (f32x4){__builtin_bit_cast(float, pr.z << 16), __builtin_bit_cast(float, pr.z & 0xffff0000u), __builtin_bit_cast(float, pr.w << 16), __builtin_bit_cast(float, pr.w & 0xffff0000u)};
                    const f32x4 o0 = s0 * p0 + x0, o1 = s1 * p1 + x1;
                    __builtin_nontemporal_store(o0, (f32x4*)(out + off)); __builtin_nontemporal_store(o1, (f32x4*)(out + off + 4)); } }
        }
    }
};
struct HelperOrder {
    int G, c;
    __device__ __forceinline__ bool next(int i, Unit& u) const {
        const int h0 = G >> 1; if (c < h0) return false;
        if ((G & 15) == 0) {
            const int x = c & 7, rank = c >> 3, nr = G >> 3, r0 = nr >> 1, lu = (rank - r0) + (nr - r0) * i; if (lu >= 32) return false; u.pm = 8 * x + (lu >> 2); u.pn = lu & 3; return true; }
        const int L = (c - h0) + (G - h0) * i; if (L >= 256) return false; u.pm = L >> 2; u.pn = L & 3; return true; }
    __device__ __forceinline__ void a_ready(const Unit&) const {}
    __device__ __forceinline__ void done(const Unit&) const {}
};

template <class Epi, class Sched, bool ALIGN_EPI = false, bool SP2 = false>
__device__ __forceinline__ void gemm_phase(PG8_LAS unsigned char* lds, const Gemm g, const Sched& S, const Epi& E) {
    const int tid = threadIdx.x, wid = __builtin_amdgcn_readfirstlane(tid >> 6), lane = tid & 63, wr = wid >> 2, wc = wid & 3, fr = lane & 15, fq = lane >> 4;
    const int K = g.K, nt = K / BK;
    unsigned voffA[2], voffB[2];
#pragma unroll
    for (int i = 0; i < 2; ++i) { int R, C; stage_rc(tid * 16 + i * 8192, R, C); const int Rb = Epi::PERM ? ((R & ~31) + perm32(R & 31)) : R;
        voffA[i] = (unsigned)(R * K + C) * 2u; voffB[i] = (unsigned)(Rb * K + C) * 2u; }
    const size_t kstep = (size_t)(BK * 2);
    const size_t hstep = (size_t)HALF * K * 2;
    const size_t tstep = 2 * hstep;
    const unsigned ldsw = (unsigned)wid * 1024u;
    const int aoff = lds_byte(wr * 64 + fr, fq * 8), boff = lds_byte(wc * 32 + fr, fq * 8);
#define PG8_SA(b, h) (((b) * 2 + (h)) * HTB)
#define PG8_SB(b, h) ((4 + (b) * 2 + (h)) * HTB)
#define PG8_STAGE(bufoff, gbase, voff) do { _Pragma("unroll") for (int _i = 0; _i < 2; ++_i) \
        __builtin_amdgcn_global_load_lds((const unsigned*)((const char*)(gbase) + (voff)[_i]), (PG8_LAS unsigned*)(lds + (bufoff) + ldsw + _i * 8192), 16, 0, 0); } while (0)
#define PG8_LDA(dst, b, h) do { _Pragma("unroll") for (int m = 0; m < 4; ++m) _Pragma("unroll") for (int k = 0; k < 2; ++k) dst[m][k] = *(const PG8_LAS bf16x8*)(lds + PG8_SA(b, h) + aoff + m * 2048 + k * 1024); } while (0)
#define PG8_LDB(dst, b, h) do { _Pragma("unroll") for (int n = 0; n < 2; ++n) _Pragma("unroll") for (int k = 0; k < 2; ++k) dst[n][k] = *(const PG8_LAS bf16x8*)(lds + PG8_SB(b, h) + boff + n * 2048 + k * 1024); } while (0)
#define PG8_MMA(ai, bj, At, Bt) do { __builtin_amdgcn_s_setprio(1); _Pragma("unroll") for (int m = 0; m < 4; ++m) _Pragma("unroll") for (int n = 0; n < 2; ++n) _Pragma("unroll") for (int k = 0; k < 2; ++k) \
        acc[ai][bj][m][n] = __builtin_amdgcn_mfma_f32_16x16x32_bf16(Bt[n][k], At[m][k], acc[ai][bj][m][n], 0, 0, 0); __builtin_amdgcn_s_setprio(0); } while (0)
#define PG8_WAIT_V(n) asm volatile("s_waitcnt vmcnt(" #n ")" ::: "memory")
#define PG8_WAIT_L(n) asm volatile("s_waitcnt lgkmcnt(" #n ")" ::: "memory")
#define PG8_BAR __builtin_amdgcn_s_barrier()
#define PG8_SCHED __builtin_amdgcn_sched_barrier(0)
    Unit cur, nxt; int ui = 0;
    if (!S.next(0, cur)) return;
    f32x4 acc[2][2][4][2];
#pragma unroll
    for (int a = 0; a < 2; ++a)
#pragma unroll
        for (int b = 0; b < 2; ++b)
#pragma unroll
            for (int m = 0; m < 4; ++m)
#pragma unroll
                for (int n = 0; n < 2; ++n) acc[a][b][m][n] = (f32x4){0.f, 0.f, 0.f, 0.f};
    bf16x8 At[4][2], B0[2][2], B1[2][2];
    const char* cA = (const char*)g.A + (size_t)cur.pm * tstep; const char* cB = (const char*)g.Bt + (size_t)cur.pn * tstep;
    S.a_ready(cur);
    if constexpr (SP2) {
        PG8_STAGE(PG8_SB(0, 0), cB, voffB); PG8_STAGE(PG8_SB(0, 1), cB + hstep, voffB); PG8_STAGE(PG8_SA(0, 0), cA, voffA); PG8_STAGE(PG8_SA(0, 1), cA + hstep, voffA);
        if (wr == 1) PG8_BAR;
        PG8_WAIT_V(2); PG8_BAR;
        PG8_STAGE(PG8_SB(1, 0), cB + kstep, voffB); PG8_STAGE(PG8_SA(1, 0), cA + kstep, voffA); PG8_STAGE(PG8_SB(1, 1), cB + hstep + kstep, voffB);
        PG8_WAIT_V(6); PG8_BAR;
    } else {
        PG8_STAGE(PG8_SB(0, 0), cB, voffB); PG8_STAGE(PG8_SA(0, 0), cA, voffA); PG8_STAGE(PG8_SB(0, 1), cB + hstep, voffB); PG8_STAGE(PG8_SA(0, 1), cA + hstep, voffA);
        if (wr == 1) PG8_BAR;
        PG8_WAIT_V(4); PG8_BAR;
        PG8_STAGE(PG8_SB(1, 0), cB + kstep, voffB); PG8_STAGE(PG8_SA(1, 0), cA + kstep, voffA); PG8_STAGE(PG8_SB(1, 1), cB + hstep + kstep, voffB);
        PG8_WAIT_V(6); PG8_BAR;
    }
    for (;;) {
        const bool has_next = S.next(ui + 1, nxt);
        const char* nA = has_next ? (const char*)g.A + (size_t)nxt.pm * tstep : cA; const char* nB = has_next ? (const char*)g.Bt + (size_t)nxt.pn * tstep : cB;
        for (int t = 0; t < nt; t += 2) {
            const bool last = (t == nt - 2);
            const char* a1 = cA + (size_t)(t + 1) * kstep;
            const char* a2 = last ? nA : cA + (size_t)(t + 2) * kstep; const char* b2 = last ? nB : cB + (size_t)(t + 2) * kstep;
            const char* a3 = a2 + kstep; const char* b3 = b2 + kstep;
            if (last && has_next) S.a_ready(nxt);
            if constexpr (SP2) {
            PG8_LDB(B0, 0, 0); PG8_LDB(B1, 0, 1); PG8_SCHED; PG8_LDA(At, 0, 0); PG8_STAGE(PG8_SA(1, 1), a1 + hstep, voffA);
            PG8_WAIT_V(8); PG8_WAIT_L(0); PG8_BAR; PG8_MMA(0, 0, At, B0); PG8_MMA(0, 1, At, B1); PG8_BAR; PG8_SCHED;
            PG8_LDA(At, 0, 1); PG8_STAGE(PG8_SB(0, 0), b2, voffB); PG8_STAGE(PG8_SB(0, 1), b2 + hstep, voffB); PG8_STAGE(PG8_SA(0, 0), a2, voffA);
            PG8_WAIT_V(8); PG8_WAIT_L(0); PG8_BAR; PG8_MMA(1, 0, At, B0); PG8_MMA(1, 1, At, B1); PG8_BAR; PG8_SCHED;
            PG8_LDB(B0, 1, 0); PG8_LDB(B1, 1, 1); PG8_SCHED; PG8_LDA(At, 1, 0); PG8_STAGE(PG8_SA(0, 1), a2 + hstep, voffA);
            PG8_WAIT_V(8); PG8_WAIT_L(0); PG8_BAR; PG8_MMA(0, 0, At, B0); PG8_MMA(0, 1, At, B1); PG8_BAR; PG8_SCHED;
            PG8_LDA(At, 1, 1); PG8_STAGE(PG8_SB(1, 0), b3, voffB); PG8_STAGE(PG8_SB(1, 1), b3 + hstep, voffB); PG8_STAGE(PG8_SA(1, 0), a3, voffA);
            PG8_WAIT_V(8); PG8_WAIT_L(0); PG8_BAR; PG8_MMA(1, 0, At, B0); PG8_MMA(1, 1, At, B1); PG8_BAR; PG8_SCHED;
            } else {
            PG8_LDB(B0, 0, 0); PG8_SCHED; PG8_LDA(At, 0, 0); PG8_STAGE(PG8_SA(1, 1), a1 + hstep, voffA);
            PG8_WAIT_L(8); PG8_BAR; PG8_WAIT_L(0); PG8_MMA(0, 0, At, B0); PG8_BAR; PG8_SCHED;
            PG8_LDB(B1, 0, 1); PG8_STAGE(PG8_SB(0, 0), b2, voffB);
            PG8_BAR; PG8_WAIT_L(0); PG8_MMA(0, 1, At, B1); PG8_BAR;
            PG8_LDA(At, 0, 1); PG8_STAGE(PG8_SA(0, 0), a2, voffA);
            PG8_BAR; PG8_WAIT_L(0); PG8_MMA(1, 0, At, B0); PG8_BAR; PG8_SCHED;
            PG8_STAGE(PG8_SB(0, 1), b2 + hstep, voffB);
            PG8_WAIT_V(6); PG8_BAR; PG8_MMA(1, 1, At, B1); PG8_BAR;
            PG8_LDB(B0, 1, 0); PG8_SCHED; PG8_LDA(At, 1, 0); PG8_STAGE(PG8_SA(0, 1), a2 + hstep, voffA);
            PG8_WAIT_L(8); PG8_BAR; PG8_WAIT_L(0); PG8_MMA(0, 0, At, B0); PG8_BAR; PG8_SCHED;
            PG8_LDB(B1, 1, 1); PG8_STAGE(PG8_SB(1, 0), b3, voffB);
            PG8_BAR; PG8_WAIT_L(0); PG8_MMA(0, 1, At, B1); PG8_BAR;
            PG8_LDA(At, 1, 1); PG8_STAGE(PG8_SA(1, 0), a3, voffA);
            PG8_BAR; PG8_WAIT_L(0); PG8_MMA(1, 0, At, B0); PG8_BAR; PG8_SCHED;
            PG8_STAGE(PG8_SB(1, 1), b3 + hstep, voffB);
            PG8_WAIT_V(6); PG8_BAR; PG8_MMA(1, 1, At, B1); PG8_BAR;
            }
        }
        if constexpr (ALIGN_EPI) { if (wr == 0) PG8_BAR; }
        if constexpr (!Epi::AFTER_DRAIN) { E(acc, cur, wr, wc, fr, fq); S.done(cur); }
        if (!has_next) break;
#pragma unroll
        for (int a = 0; a < 2; ++a)
#pragma unroll
            for (int b = 0; b < 2; ++b)
#pragma unroll
                for (int m = 0; m < 4; ++m)
#pragma unroll
                    for (int n = 0; n < 2; ++n) acc[a][b][m][n] = (f32x4){0.f, 0.f, 0.f, 0.f};
        cur = nxt; cA = nA; cB = nB; ++ui;
        if constexpr (ALIGN_EPI) { if (wr == 1) PG8_BAR; }
    }
    PG8_WAIT_V(0);
    if constexpr (!ALIGN_EPI) { if (wr == 0) PG8_BAR; }
    PG8_BAR;
    if constexpr (Epi::AFTER_DRAIN) { E.fused(acc, cur, wr, wc, fr, fq, lds, wid, lane); S.done(cur); }
#undef PG8_SA
#undef PG8_SB
#undef PG8_STAGE
#undef PG8_LDA
#undef PG8_LDB
#undef PG8_MMA
#undef PG8_WAIT_V
#undef PG8_WAIT_L
#undef PG8_BAR
#undef PG8_SCHED
}
}

#ifndef PG8_SP2
#define PG8_SP2 true
#endif
#ifndef PG8_ALIGN
#define PG8_ALIGN true
#endif
#define GAS __attribute__((address_space(1)))
#define LAS __attribute__((address_space(3)))
typedef unsigned short bf16;
typedef unsigned v4u __attribute__((ext_vector_type(4)));
typedef float f32x4 __attribute__((ext_vector_type(4)));
typedef short bf16x8 __attribute__((ext_vector_type(8)));
typedef GAS unsigned gu32;
typedef GAS unsigned long long gu64;
#define RLX_AGENT __ATOMIC_RELAXED, __HIP_MEMORY_SCOPE_AGENT
#define LDS_WAIT() asm volatile("s_waitcnt lgkmcnt(0)" ::: "memory")
#define VM_WAIT() asm volatile("s_waitcnt vmcnt(0)" ::: "memory")
__device__ __forceinline__ unsigned long long rt() { return __builtin_amdgcn_s_memrealtime(); }
__device__ __forceinline__ unsigned f2bf(float f) { unsigned u = __builtin_bit_cast(unsigned, f); return (u + 0x7fffu + ((u >> 16) & 1u)) >> 16; }
__device__ __forceinline__ unsigned pk2(float lo, float hi) { return f2bf(lo) | (f2bf(hi) << 16); }

#define XB_TMO      128
#define XB_XCNT(j)  (256  + 64 * (j))
#define XB_XSUB(j)  (1280 + 64 * (j))
#define XB_XGEN(j)  (2304 + 64 * (j))
#define XB_TOP      3328
#define XB_TOPGEN   3392
#define XB_LSUB(j)  (3456 + 64 * (j))
#define XB_LGEN(j)  (4480 + 64 * (j))
#define XCD_BAR_WORDS 5504
#define XB_SPIN_CAP (1u << 18)

__device__ __forceinline__ unsigned xb_ld(unsigned* p)              { return __hip_atomic_load(p, __ATOMIC_RELAXED, __HIP_MEMORY_SCOPE_AGENT); }
__device__ __forceinline__ unsigned xb_add(unsigned* p, unsigned v) { return __hip_atomic_fetch_add(p, v, __ATOMIC_RELAXED, __HIP_MEMORY_SCOPE_AGENT); }
__device__ __forceinline__ unsigned xb_xcc_id() { return (unsigned)__builtin_amdgcn_s_getreg((3 << 11) | 20) & 0xFu; }
#define XB_SPIN(cond, bar) do { unsigned _sp = 0; while (cond) { __builtin_amdgcn_s_sleep(1); \
    if ((++_sp & 255u) == 0u) { if (xb_ld(&(bar)[XB_TMO])) break; if (_sp > XB_SPIN_CAP) { atomicAdd(&(bar)[XB_TMO], 1u); break; } } } } while (0)

struct XcdBarrier {
    unsigned* bar; unsigned x;
    volatile LAS unsigned* st;
};

__device__ __forceinline__ XcdBarrier xcd_barrier_post(unsigned* bar, volatile LAS unsigned* st) {
    XcdBarrier b; b.bar = bar; b.x = xb_xcc_id(); b.st = st;
    if (threadIdx.x == 0) st[2] = xb_add(&bar[XB_XCNT(b.x)], 1u);
    return b;
}
__device__ __forceinline__ void xcd_barrier_complete(unsigned* bar, unsigned x, unsigned& nloc, unsigned& nx, unsigned& uniform) {
    const unsigned G = gridDim.x * gridDim.y * gridDim.z;
    unsigned sum, cnt, mine, odd, sp = 0u;
    for (;;) {
        sum = 0u; cnt = 0u; mine = 0u; odd = 0u;
#pragma unroll
        for (unsigned j = 0; j < 16; ++j) { const unsigned c = xb_ld(&bar[XB_XCNT(j)]); sum += c; cnt += (c > 0u) ? 1u : 0u; mine = (j == x) ? c : mine; odd |= (j < 8u) ? (c * 8u != G ? 1u : 0u) : (c != 0u ? 1u : 0u); }
        if (sum == G) { uniform = odd ? 0u : 1u; break; }
        __builtin_amdgcn_s_sleep(1);
        if ((++sp & 255u) == 0u) { if (xb_ld(&bar[XB_TMO])) { uniform = 0u; break; } if (sp > XB_SPIN_CAP) { atomicAdd(&bar[XB_TMO], 1u); uniform = 0u; break; } }
    }
    nloc = mine > 0u ? mine : 1u; nx = cnt > 0u ? cnt : 1u;
}

__device__ __forceinline__ void xcd_barrier(const XcdBarrier& b) {
    asm volatile("s_waitcnt vmcnt(0)" ::: "memory");
    __syncthreads();
    if (threadIdx.x == 0) {
        unsigned* bar = b.bar;
        __builtin_amdgcn_s_waitcnt(0);
        unsigned nloc = b.st[0], nx = b.st[1];
        if (nloc == 0u) { unsigned uni = 0u; xcd_barrier_complete(bar, b.x, nloc, nx, uni); b.st[0] = nloc; b.st[1] = nx; b.st[3] = uni; }
        const unsigned old = xb_add(&bar[XB_XSUB(b.x)], 1u);
        const unsigned gen = old / nloc;
        if (old + 1u == (gen + 1u) * nloc) {
            __builtin_amdgcn_fence(__ATOMIC_RELEASE, "agent");
            asm volatile("s_waitcnt vmcnt(0)" ::: "memory");
            const unsigned og = xb_add(&bar[XB_TOP], 1u);
            const unsigned tg = og / nx;
            if (og + 1u == (tg + 1u) * nx) xb_add(&bar[XB_TOPGEN], 1u);
            else XB_SPIN(xb_ld(&bar[XB_TOPGEN]) == tg, bar);
            __builtin_amdgcn_fence(__ATOMIC_ACQUIRE, "agent");
            xb_add(&bar[XB_XGEN(b.x)], 1u);
            asm volatile("s_waitcnt vmcnt(0)" ::: "memory");
        } else {
            XB_SPIN(xb_ld(&bar[XB_XGEN(b.x)]) == gen, bar);
            __builtin_amdgcn_fence(__ATOMIC_ACQUIRE, "agent");
            asm volatile("s_waitcnt vmcnt(0)" ::: "memory");
        }
    }
    __syncthreads();
}

__device__ __forceinline__ void xcd_local_barrier(const XcdBarrier& b) {
    asm volatile("s_waitcnt vmcnt(0)" ::: "memory");
    __syncthreads();
    if (threadIdx.x == 0) {
        unsigned* bar = b.bar;
        __builtin_amdgcn_s_waitcnt(0);
        const unsigned nloc = b.st[0];
        const unsigned old = xb_add(&bar[XB_LSUB(b.x)], 1u);
        const unsigned gen = old / nloc;
        if (old + 1u == (gen + 1u) * nloc) (void)xb_add(&bar[XB_LGEN(b.x)], 1u);
        else XB_SPIN(xb_ld(&bar[XB_LGEN(b.x)]) == gen, bar);
        __builtin_amdgcn_fence(__ATOMIC_ACQUIRE, "agent");
        asm volatile("s_waitcnt vmcnt(0)" ::: "memory");
    }
    __syncthreads();
}


constexpr size_t MiB = 1u << 20;
constexpr size_t WS_CTL = 0, CTL_ZERO_BYTES = 1 * MiB;
constexpr size_t WS_WIN = 2 * MiB, WS_WOUT = 7 * MiB, WS_WGU = 9 * MiB, WS_WDN = 20 * MiB, WS_WPG = 26 * MiB, WS_WPP = 28 * MiB;
constexpr size_t WS_SS0 = 28 * MiB + 512 * 1024  , WS_SS1 = 29 * MiB, WS_SS2 = 30 * MiB;
constexpr size_t WS_XN = 32 * MiB;
constexpr size_t WS_Q = 64 * MiB, WS_KIMG = 80 * MiB, WS_VIMG = 96 * MiB, WS_U = 112 * MiB, WS_SLAB = 128 * MiB;
constexpr size_t WS_HM = 64 * MiB;
constexpr size_t WS_PB = 184 * MiB, WS_PROJ = 192 * MiB, WS_MIX = 224 * MiB, WS_END = 256 * MiB;
static_assert(WS_HM + (size_t)M * FF * 2 <= WS_PB && WS_SLAB + 56 * MiB <= WS_PB, "HM overlay");
constexpr int CW_TMO = 0, CW_CODE = 1, CW_QMAX = 32, CW_KMAX = 33, CW_KBAR = 34  , CW_QUEUE = 64, CW_UCNT = 1024  , CW_BAR = 4096;
constexpr int MAX_SPLIT_UNITS = 144;

constexpr int RING_OFF = 0, RING_BYTES = 131072;
constexpr int LDSCTL_OFF = RING_BYTES, MISC_OFF = LDSCTL_OFF + 320;
constexpr int LDS_BYTES = 147456;
constexpr int NWAVES = 8;

__device__ __forceinline__ float wave_sum(float v) {
#pragma unroll
    for (int o = 1; o < 64; o <<= 1) v += __shfl_xor(v, o);
    return v;
}
__device__ __forceinline__ float wave_max(float v) {
#pragma unroll
    for (int o = 1; o < 64; o <<= 1) v = fmaxf(v, __shfl_xor(v, o));
    return v;
}
__device__ __forceinline__ float bflo(unsigned w) { return __builtin_bit_cast(float, w << 16); }
__device__ __forceinline__ float bfhi(unsigned w) { return __builtin_bit_cast(float, w & 0xffff0000u); }

__device__ __forceinline__ void transpose_item(const float* W, int ldw, int K, bf16* WT, int k0, int n0, int dst0, LAS float* scr, int lane, const float* rowgain = nullptr) {
    float v[32];
#pragma unroll
    for (int i = 0; i < 32; ++i) { const int kk = 2 * i + (lane >> 5); v[i] = __builtin_nontemporal_load(&W[(size_t)(k0 + kk) * ldw + n0 + (lane & 31)]); }
    if (rowgain) {
#pragma unroll
        for (int i = 0; i < 32; ++i) v[i] *= rowgain[k0 + 2 * i + (lane >> 5)]; }
#pragma unroll
    for (int i = 0; i < 32; ++i) scr[(2 * i + (lane >> 5)) * 33 + (lane & 31)] = v[i];
    LDS_WAIT(); asm volatile("" ::: "memory");
    const int c = lane & 7;
#pragma unroll
    for (int j = 0; j < 4; ++j) { const int n = (lane >> 3) + 8 * j; const LAS float* s = scr + (8 * c) * 33 + n;
        v4u o; o.x = pk2(s[0 * 33], s[1 * 33]); o.y = pk2(s[2 * 33], s[3 * 33]); o.z = pk2(s[4 * 33], s[5 * 33]); o.w = pk2(s[6 * 33], s[7 * 33]);
        *(GAS v4u*)(WT + (size_t)(dst0 + n) * K + k0 + 8 * c) = o; }
    LDS_WAIT(); asm volatile("" ::: "memory");
}
__device__ __forceinline__ int in_dst_row(int s) {
    if (s < 1024) { const int part = s >> 9, sp = s & 511, tp = sp >> 8, sl = sp & 255, wc = sl >> 6, bj = (sl >> 5) & 1; return (part * 2 + tp) * 256 + 128 * bj + 32 * wc; }
    if (s < 1536) return s;
    if (s < 2048) { const int ch = s - 1536; return 1536 + 256 * (ch >> 7) + (ch & 127); }
    const int ch = s - 2048; return 1536 + 256 * (ch >> 7) + 128 + (ch & 127);
}
struct Args { const float* in[23]; float* out; unsigned char* ws; int ph_lo, ph_hi, li, pad; };

__device__ __forceinline__ void p0_prologue(const Args& a, LAS unsigned char* lds, int vcu, int G, int wave, int lane) {
    LAS float* scr = (LAS float*)(lds + RING_OFF + wave * 16384);
    const int gw = vcu * NWAVES + wave, NGW = G * NWAVES;
    unsigned char* ws = a.ws;
    constexpr int I_IN = 16 * 80, I_PP = 4 * 32;
    for (int it = gw; it < I_IN + I_PP; it += NGW) {
        if (it < I_IN) { const int kb = it / 80, nb = it % 80; transpose_item(a.in[3], NIN, DM, (bf16*)(ws + WS_WIN), 64 * kb, 32 * nb, in_dst_row(32 * nb), scr, lane, a.in[2]); }
        else { const int r = it - I_IN, kb = r / 32, nb = r % 32; transpose_item(a.in[22], DM, PD, (bf16*)(ws + WS_WPP), 64 * kb, 32 * nb, 32 * nb, scr, lane); }
    }
    const float* x = a.in[0]; const float* p = a.in[1];
    bf16* XN = (bf16*)(ws + WS_XN); bf16* PB = (bf16*)(ws + WS_PB); float* SS0 = (float*)(ws + WS_SS0);
    for (int m = gw; m < M; m += NGW) {
        const GAS f32x4* xr = (const GAS f32x4*)(x + (size_t)m * DM) + lane;
        f32x4 v[4]; float s = 0.f;
#pragma unroll
        for (int j = 0; j < 4; ++j) { v[j] = __builtin_nontemporal_load(&xr[64 * j]); s += (v[j].x * v[j].x + v[j].y * v[j].y) + (v[j].z * v[j].z + v[j].w * v[j].w); }
        GAS unsigned long long* o8 = (GAS unsigned long long*)(XN + (size_t)m * DM) + lane;
#pragma unroll
        for (int j = 0; j < 4; ++j) o8[64 * j] = (unsigned long long)pk2(v[j].x, v[j].y) | ((unsigned long long)pk2(v[j].z, v[j].w) << 32);
        const f32x4 pv = __builtin_nontemporal_load(&((const GAS f32x4*)(p + (size_t)m * PD))[lane]);
        ((GAS unsigned long long*)(PB + (size_t)m * PD))[lane] = (unsigned long long)pk2(pv.x, pv.y) | ((unsigned long long)pk2(pv.z, pv.w) << 32);
        s = wave_sum(s);
        if (lane == 0) SS0[m] = s;
    }
}
constexpr int WI_OUT = 16 * 32, WI_G = 16 * 88, WI_DN = 44 * 32, WI_PG = 16 * 32, W_ITEMS = WI_OUT + 2 * WI_G + WI_DN + WI_PG, N_W_UNITS = (W_ITEMS + 31) / 32;
__device__ __forceinline__ void weight_unit(int wu, const Args& a, LAS unsigned char* lds, int wave, int lane) {
    asm volatile("" : "+v"(lane));
    LAS float* scr = (LAS float*)(lds + RING_OFF + wave * 16384);
    unsigned char* ws = a.ws;
    for (int q = 0; q < 4; ++q) {
        int r = wu * 32 + wave * 4 + q; if (r >= W_ITEMS) break;
        if (r < WI_OUT) { const int kb = r / 32, nb = r % 32; transpose_item(a.in[15], DM, DM, (bf16*)(ws + WS_WOUT), 64 * kb, 32 * nb, 32 * nb, scr, lane); continue; } r -= WI_OUT;
        if (r < WI_G) { const int kb = r / 88, nb = r % 88, n0 = 32 * nb; transpose_item(a.in[17], FF, DM, (bf16*)(ws + WS_WGU), 64 * kb, n0, 256 * (n0 >> 7) + (n0 & 127), scr, lane, a.in[16]); continue; } r -= WI_G;
        if (r < WI_G) { const int kb = r / 88, nb = r % 88, n0 = 32 * nb; transpose_item(a.in[18], FF, DM, (bf16*)(ws + WS_WGU), 64 * kb, n0, 256 * (n0 >> 7) + 128 + (n0 & 127), scr, lane, a.in[16]); continue; } r -= WI_G;
        if (r < WI_DN) { const int kb = r / 32, nb = r % 32; transpose_item(a.in[19], DM, FF, (bf16*)(ws + WS_WDN), 64 * kb, 32 * nb, 32 * nb, scr, lane); continue; } r -= WI_DN;
        { const int kb = r / 32, nb = r % 32; transpose_item(a.in[21], DM, DM, (bf16*)(ws + WS_WPG), 64 * kb, 32 * nb, 32 * nb, scr, lane, a.in[20]); }
    }
    __syncthreads();
}

constexpr int CONV_W_LDS = 96 * 1024;
__device__ __forceinline__ void conv_unit(int cu, const bf16* U, const float* cw, const float* cb, const float* lg, const float* lb, bf16* MIX, LAS unsigned char* lds, int tid, int wave, int lane, bool& w_staged) {
    asm volatile("" : "+v"(tid), "+v"(lane));
    const int r0 = cu * 64;
    const f32x4 b0 = *(const f32x4*)(cb + 8 * lane), b1 = *(const f32x4*)(cb + 8 * lane + 4);
    const f32x4 g0 = *(const f32x4*)(lg + 8 * lane), g1 = *(const f32x4*)(lg + 8 * lane + 4), c0 = *(const f32x4*)(lb + 8 * lane), c1 = *(const f32x4*)(lb + 8 * lane + 4);
    if (!w_staged) {
        f32x4 wv[4][2];
#pragma unroll
        for (int k = 0; k < 4; ++k) { const int i = tid + 512 * k; if (i < KC * 64) { wv[k][0] = *(const f32x4*)(cw + 8 * i); wv[k][1] = *(const f32x4*)(cw + 8 * i + 4); } }
#pragma unroll
        for (int k = 0; k < 4; ++k) { const int i = tid + 512 * k; if (i < KC * 64) { v4u o;
            o.x = __builtin_bit_cast(unsigned, __builtin_amdgcn_cvt_pkrtz(wv[k][0].x, wv[k][0].y)); o.y = __builtin_bit_cast(unsigned, __builtin_amdgcn_cvt_pkrtz(wv[k][0].z, wv[k][0].w));
            o.z = __builtin_bit_cast(unsigned, __builtin_amdgcn_cvt_pkrtz(wv[k][1].x, wv[k][1].y)); o.w = __builtin_bit_cast(unsigned, __builtin_amdgcn_cvt_pkrtz(wv[k][1].z, wv[k][1].w));
            *(LAS v4u*)(lds + CONV_W_LDS + i * 16) = o; } }
        w_staged = true;
    }
    { v4u uv[12];
#pragma unroll
      for (int k = 0; k < 12; ++k) { const int i = tid + 512 * k, rr = i >> 6, pc = i & 63, r = r0 - 15 + rr, rc = r < 0 ? 0 : (r > M - 1 ? M - 1 : r);
          uv[k] = *(const GAS v4u*)(U + (size_t)rc * CW + pc * 8); }
#pragma unroll
      for (int k = 0; k < 12; ++k) { const int i = tid + 512 * k, rr = i >> 6, pc = i & 63, r = r0 - 15 + rr; const bool in = r >= 0 && r < M;
          v4u v = uv[k]; v.x = in ? v.x : 0u; v.y = in ? v.y : 0u; v.z = in ? v.z : 0u; v.w = in ? v.w : 0u;
          if (i < 94 * 64) *(LAS v4u*)(lds + rr * 1024 + pc * 16) = v; } }
    __syncthreads();
    typedef _Float16 h2 __attribute__((ext_vector_type(2)));
    h2 hacc[8][4];
    { const h2 i0 = __builtin_bit_cast(h2, __builtin_amdgcn_cvt_pkrtz(b0.x, b0.y)), i1 = __builtin_bit_cast(h2, __builtin_amdgcn_cvt_pkrtz(b0.z, b0.w)), i2 = __builtin_bit_cast(h2, __builtin_amdgcn_cvt_pkrtz(b1.x, b1.y)), i3 = __builtin_bit_cast(h2, __builtin_amdgcn_cvt_pkrtz(b1.z, b1.w));
#pragma unroll
      for (int j = 0; j < 8; ++j) { hacc[j][0] = i0; hacc[j][1] = i1; hacc[j][2] = i2; hacc[j][3] = i3; } }
    {
        typedef _Float16 h8 __attribute__((ext_vector_type(8)));
        const LAS unsigned char* ub = lds + (wave * 8) * 1024 + lane * 16; const LAS unsigned char* wb = lds + CONV_W_LDS + lane * 16;
        h8 uu[8];
#pragma unroll
        for (int j = 0; j < 7; ++j) uu[j] = *(const LAS h8*)(ub + j * 1024);
        h8 kw = *(const LAS h8*)(wb);
#pragma unroll
        for (int t = 0; t < KC; ++t) {
            uu[(t + 7) & 7] = *(const LAS h8*)(ub + (t + 7) * 1024);
            const h8 kwn = *(const LAS h8*)(wb + (t + 1 < KC ? t + 1 : t) * 1024);
            const h2 k0 = __builtin_shufflevector(kw, kw, 0, 1), k1 = __builtin_shufflevector(kw, kw, 2, 3), k2 = __builtin_shufflevector(kw, kw, 4, 5), k3 = __builtin_shufflevector(kw, kw, 6, 7);
#pragma unroll
            for (int j = 0; j < 8; ++j) { const h8 u = uu[(t + j) & 7];
                hacc[j][0] = __builtin_shufflevector(u, u, 0, 1) * k0 + hacc[j][0]; hacc[j][1] = __builtin_shufflevector(u, u, 2, 3) * k1 + hacc[j][1];
                hacc[j][2] = __builtin_shufflevector(u, u, 4, 5) * k2 + hacc[j][2]; hacc[j][3] = __builtin_shufflevector(u, u, 6, 7) * k3 + hacc[j][3]; }
            kw = kwn;
        }
    }
    float acc[8][8];
#pragma unroll
    for (int j = 0; j < 8; ++j)
#pragma unroll
        for (int k = 0; k < 4; ++k) { acc[j][2 * k] = (float)hacc[j][k][0]; acc[j][2 * k + 1] = (float)hacc[j][k][1]; }
#pragma unroll
    for (int j = 0; j < 8; ++j) {
        float s = ((acc[j][0] + acc[j][1]) + (acc[j][2] + acc[j][3])) + ((acc[j][4] + acc[j][5]) + (acc[j][6] + acc[j][7]));
        const float mu = wave_sum(s) * (1.f / CW); float q = 0.f;
#pragma unroll
        for (int e = 0; e < 8; ++e) { acc[j][e] -= mu; q += acc[j][e] * acc[j][e]; }
        const float r = rsqrtf(wave_sum(q) * (1.f / CW) + EPS);
        float z[8];
        z[0] = acc[j][0] * r * g0.x + c0.x; z[1] = acc[j][1] * r * g0.y + c0.y; z[2] = acc[j][2] * r * g0.z + c0.z; z[3] = acc[j][3] * r * g0.w + c0.w;
        z[4] = acc[j][4] * r * g1.x + c1.x; z[5] = acc[j][5] * r * g1.y + c1.y; z[6] = acc[j][6] * r * g1.z + c1.z; z[7] = acc[j][7] * r * g1.w + c1.w;
#pragma unroll
        for (int e = 0; e < 8; ++e) z[e] = z[e] * fsigmoid(z[e]);
        v4u o; o.x = pk2(z[0], z[1]); o.y = pk2(z[2], z[3]); o.z = pk2(z[4], z[5]); o.w = pk2(z[6], z[7]);
        *(GAS v4u*)(MIX + (size_t)(r0 + wave * 8 + j) * DM + AW + 8 * lane) = o;
    }
    __syncthreads();
}

namespace att {
typedef short bf16x8 __attribute__((ext_vector_type(8)));
typedef short s16x4 __attribute__((ext_vector_type(4)));
typedef float f32x16 __attribute__((ext_vector_type(16)));
typedef float f32x4 __attribute__((ext_vector_type(4)));
typedef unsigned u32x4 __attribute__((ext_vector_type(4)));
constexpr int LDS_HN = 8 * 16384 + 13312;
constexpr int SLOT = 16384, LDS_K = 0, LDS_V = 4 * SLOT, LDS_WS = 8 * SLOT + 4096  , XSTRIDE = 132, SLAB_FLOATS = 8 * 4160;
typedef __attribute__((address_space(3))) const char* lds_cptr;
typedef short v4i16_t __attribute__((ext_vector_type(4)));
__device__ __forceinline__ int crow(int r, int hi) { return (r & 3) + 8 * (r >> 2) + 4 * hi; }
__device__ __forceinline__ void glds2k(const unsigned char* sbase, unsigned voff, unsigned lds_dst) { unsigned keep; const unsigned lds_dst2 = lds_dst + 1024u, voff2 = voff + 1024u;
    asm volatile("s_mov_b32 %0, m0\n\ts_mov_b32 m0, %3\n\ts_nop 0\n\tglobal_load_lds_dwordx4 %1, %2\n\ts_nop 0\n\ts_mov_b32 m0, %4\n\ts_nop 0\n\tglobal_load_lds_dwordx4 %5, %2\n\ts_nop 0\n\ts_mov_b32 m0, %0"
                 : "=&s"(keep) : "v"(voff), "s"(sbase), "s"(lds_dst), "s"(lds_dst2), "v"(voff2) : "memory"); }
#define ATT_WAIT_BAR(N) asm volatile("s_waitcnt vmcnt(" #N ") lgkmcnt(0)\n\ts_barrier" ::: "memory")
__device__ __forceinline__ unsigned cvtpk(float lo, float hi) { unsigned r; asm volatile("v_cvt_pk_bf16_f32 %0, %1, %2" : "=v"(r) : "v"(lo), "v"(hi)); return r; }
__device__ __forceinline__ int v_rd_base(int lane) { return ((lane >> 4) & 1) * 32 + (lane & 3) * 8 + (4 * (lane >> 5) + ((lane & 15) >> 2)) * 64; }
__device__ __forceinline__ s16x4 vtr(lds_cptr p) { return __builtin_bit_cast(s16x4, __builtin_amdgcn_ds_read_tr16_b64_v4i16((__attribute__((address_space(3))) v4i16_t*)p)); }
#define SBAR() __builtin_amdgcn_sched_barrier(0)
__device__ __forceinline__ void qkt_acc(f32x16& p0, f32x16& p1, lds_cptr kp, const bf16x8* qr) {
#pragma unroll
    for (int d0 = 0; d0 < 4; ++d0) {
        const bf16x8 b0 = *(const __attribute__((address_space(3))) bf16x8*)(kp + d0 * 2048);
        const bf16x8 b1 = *(const __attribute__((address_space(3))) bf16x8*)(kp + d0 * 2048 + 512);
        p0 = __builtin_amdgcn_mfma_f32_32x32x16_bf16(b0, qr[d0], p0, 0, 0, 0);
        p1 = __builtin_amdgcn_mfma_f32_32x32x16_bf16(b1, qr[d0], p1, 0, 0, 0);
    }
}
__device__ __forceinline__ void bias_general(f32x16& p0, f32x16& p1, float dq, float nslope2, float shift2) {
#pragma unroll
    for (int r = 0; r < 16; ++r) { const float c = (float)((r & 3) + 8 * (r >> 2)); p0[r] = __builtin_fmaf(nslope2, __builtin_fabsf(dq - c), -shift2); p1[r] = __builtin_fmaf(nslope2, __builtin_fabsf(dq - (c + 32.f)), -shift2); }
}
__device__ __forceinline__ void softmax_first(f32x16& p0, f32x16& p1, bf16x8& pa0, bf16x8& pa1, bf16x8& pa2) {
#pragma unroll
    for (int r = 0; r < 16; ++r) { p0[r] = __builtin_amdgcn_exp2f(p0[r]); p1[r] = __builtin_amdgcn_exp2f(p1[r]); }
    { u32x4 w = {cvtpk(p0[0], p0[1]), cvtpk(p0[2], p0[3]), cvtpk(p0[4], p0[5]), cvtpk(p0[6], p0[7])}; pa0 = __builtin_bit_cast(bf16x8, w); }
    { u32x4 w = {cvtpk(p0[8], p0[9]), cvtpk(p0[10], p0[11]), cvtpk(p0[12], p0[13]), cvtpk(p0[14], p0[15])}; pa1 = __builtin_bit_cast(bf16x8, w); }
    { u32x4 w = {cvtpk(p1[0], p1[1]), cvtpk(p1[2], p1[3]), cvtpk(p1[4], p1[5]), cvtpk(p1[6], p1[7])}; pa2 = __builtin_bit_cast(bf16x8, w); }
}
template <int KBITS> __device__ __forceinline__ float fmamk_s(float a, float c) { float r; asm("v_fmamk_f32 %0, %1, %2, %3" : "=v"(r) : "v"(a), "n"(KBITS), "v"(c)); return r; }
#define ATT_ROT3(x) do { (x) = ((x) + SLOT) & (4 * SLOT - 1); } while (0)
#define ATT_DMA2(src, tile, dstoff) do { int t_ = (tile); t_ = t_ < t_hi ? t_ : t_hi; glds2k((src) + (size_t)t_ * SLOT, lane16, (unsigned)(dstoff)); } while (0)
#define ATT_ISSUE_DMA() do { ATT_DMA2(ksrc, tj + 4, kdst + sk_dma); ATT_DMA2(vsrc, tj + 2, vdst + sv_dma); ++tj; } while (0)
#define ATT_STEP(P0, P1, X0, X1, DO_EXP, DO_QK, JJ) do { \
    if (lead_half || (JJ) == 0) { ATT_WAIT_BAR(4); } \
    ATT_ISSUE_DMA(); \
    { const lds_cptr vb_ = vp0 + sv_cur; const lds_cptr kb_ = kp0 + sk_cur; \
      s16x4 vl0, vh0, vl1, vh1, vl2, vh2; bf16x8 kf0, kf1, kf2; unsigned t0_, t1_, t2_, t3_; \
      const int k02_ = (tj + 1) * 64  ; const bool right_ = k02_ >= qw0 + 31, mixed_ = !right_ && (k02_ + 63 > qw0); \
      const float dq2_ = dq1 - 64.f, ss_ = right_ ? nslope2 : -nslope2, xl0_ = __builtin_fmaf(-ss_, dq2_, -shift2), xl1_ = __builtin_fmaf(ss_, 32.f, xl0_); \
      vl0 = vtr(vb_ + 0); vh0 = vtr(vb_ + 512); vl1 = vtr(vb_ + 4096); vh1 = vtr(vb_ + 4608); SBAR(); \
      vl2 = vtr(vb_ + 8192); vh2 = vtr(vb_ + 8704); o[0] = __builtin_amdgcn_mfma_f32_32x32x16_bf16(pa0, (bf16x8){vl0[0], vl0[1], vl0[2], vl0[3], vh0[0], vh0[1], vh0[2], vh0[3]}, o[0], 0, 0, 0); if (DO_EXP) { X0[0] = __builtin_amdgcn_exp2f(X0[0]); } t0_ = cvtpk(P1[8], P1[9]); t1_ = cvtpk(P1[10], P1[11]); SBAR(); \
      vl0 = vtr(vb_ + 12288); vh0 = vtr(vb_ + 12800); o[1] = __builtin_amdgcn_mfma_f32_32x32x16_bf16(pa0, (bf16x8){vl1[0], vl1[1], vl1[2], vl1[3], vh1[0], vh1[1], vh1[2], vh1[3]}, o[1], 0, 0, 0); if (DO_EXP) { X0[1] = __builtin_amdgcn_exp2f(X0[1]); } t2_ = cvtpk(P1[12], P1[13]); t3_ = cvtpk(P1[14], P1[15]); { u32x4 w_ = {t0_, t1_, t2_, t3_}; pa3 = __builtin_bit_cast(bf16x8, w_); } SBAR(); \
      vl1 = vtr(vb_ + 1024); vh1 = vtr(vb_ + 1536); o[2] = __builtin_amdgcn_mfma_f32_32x32x16_bf16(pa0, (bf16x8){vl2[0], vl2[1], vl2[2], vl2[3], vh2[0], vh2[1], vh2[2], vh2[3]}, o[2], 0, 0, 0); if (DO_EXP) { X0[2] = __builtin_amdgcn_exp2f(X0[2]); } if (DO_EXP) { X0[3] = __builtin_amdgcn_exp2f(X0[3]); } SBAR(); \
      vl2 = vtr(vb_ + 5120); vh2 = vtr(vb_ + 5632); o[3] = __builtin_amdgcn_mfma_f32_32x32x16_bf16(pa0, (bf16x8){vl0[0], vl0[1], vl0[2], vl0[3], vh0[0], vh0[1], vh0[2], vh0[3]}, o[3], 0, 0, 0); lacc4 = __builtin_amdgcn_mfma_f32_16x16x32_bf16(lmask, pa0, lacc4, 0, 0, 0); if (DO_EXP) { X0[4] = __builtin_amdgcn_exp2f(X0[4]); } if (DO_QK) { P0[0] = fmamk_s<0>(ss_, xl0_); } if (DO_QK) { P0[1] = fmamk_s<1065353216>(ss_, xl0_); } if (DO_QK) { P0[2] = fmamk_s<1073741824>(ss_, xl0_); } SBAR(); \
      vl0 = vtr(vb_ + 9216); vh0 = vtr(vb_ + 9728); o[0] = __builtin_amdgcn_mfma_f32_32x32x16_bf16(pa1, (bf16x8){vl1[0], vl1[1], vl1[2], vl1[3], vh1[0], vh1[1], vh1[2], vh1[3]}, o[0], 0, 0, 0); if (DO_EXP) { X0[5] = __builtin_amdgcn_exp2f(X0[5]); } if (DO_QK) { P0[3] = fmamk_s<1077936128>(ss_, xl0_); } if (DO_QK) { P0[4] = fmamk_s<1090519040>(ss_, xl0_); } SBAR(); \
      vl1 = vtr(vb_ + 13312); vh1 = vtr(vb_ + 13824); o[1] = __builtin_amdgcn_mfma_f32_32x32x16_bf16(pa1, (bf16x8){vl2[0], vl2[1], vl2[2], vl2[3], vh2[0], vh2[1], vh2[2], vh2[3]}, o[1], 0, 0, 0); if (DO_EXP) { X0[6] = __builtin_amdgcn_exp2f(X0[6]); } if (DO_EXP) { X0[7] = __builtin_amdgcn_exp2f(X0[7]); } if (DO_QK) { P0[5] = fmamk_s<1091567616>(ss_, xl0_); } if (DO_QK) { P0[6] = fmamk_s<1092616192>(ss_, xl0_); } if (DO_QK) { P0[7] = fmamk_s<1093664768>(ss_, xl0_); } SBAR(); \
      vl2 = vtr(vb_ + 2048); vh2 = vtr(vb_ + 2560); o[2] = __builtin_amdgcn_mfma_f32_32x32x16_bf16(pa1, (bf16x8){vl0[0], vl0[1], vl0[2], vl0[3], vh0[0], vh0[1], vh0[2], vh0[3]}, o[2], 0, 0, 0); if (DO_EXP) { X0[8] = __builtin_amdgcn_exp2f(X0[8]); } if (DO_EXP) { t0_ = cvtpk(X0[0], X0[1]); t1_ = cvtpk(X0[2], X0[3]); } if (DO_QK) { P0[8] = fmamk_s<1098907648>(ss_, xl0_); } if (DO_QK) { P0[9] = fmamk_s<1099431936>(ss_, xl0_); } SBAR(); \
      vl0 = vtr(vb_ + 6144); vh0 = vtr(vb_ + 6656); o[3] = __builtin_amdgcn_mfma_f32_32x32x16_bf16(pa1, (bf16x8){vl1[0], vl1[1], vl1[2], vl1[3], vh1[0], vh1[1], vh1[2], vh1[3]}, o[3], 0, 0, 0); lacc4 = __builtin_amdgcn_mfma_f32_16x16x32_bf16(lmask, pa1, lacc4, 0, 0, 0); if (DO_EXP) { X0[9] = __builtin_amdgcn_exp2f(X0[9]); } if (DO_EXP) { t2_ = cvtpk(X0[4], X0[5]); t3_ = cvtpk(X0[6], X0[7]); { u32x4 w_ = {t0_, t1_, t2_, t3_}; pa0 = __builtin_bit_cast(bf16x8, w_); } } if (DO_QK) { P0[10] = fmamk_s<1099956224>(ss_, xl0_); } if (DO_QK) { P0[11] = fmamk_s<1100480512>(ss_, xl0_); } if (DO_QK) { P0[12] = fmamk_s<1103101952>(ss_, xl0_); } SBAR(); \
      vl1 = vtr(vb_ + 10240); vh1 = vtr(vb_ + 10752); o[0] = __builtin_amdgcn_mfma_f32_32x32x16_bf16(pa2, (bf16x8){vl2[0], vl2[1], vl2[2], vl2[3], vh2[0], vh2[1], vh2[2], vh2[3]}, o[0], 0, 0, 0); if (DO_EXP) { X0[10] = __builtin_amdgcn_exp2f(X0[10]); } if (DO_EXP) { X0[11] = __builtin_amdgcn_exp2f(X0[11]); } if (DO_QK) { P0[13] = fmamk_s<1103626240>(ss_, xl0_); } if (DO_QK) { P0[14] = fmamk_s<1104150528>(ss_, xl0_); } SBAR(); \
      vl2 = vtr(vb_ + 14336); vh2 = vtr(vb_ + 14848); o[1] = __builtin_amdgcn_mfma_f32_32x32x16_bf16(pa2, (bf16x8){vl0[0], vl0[1], vl0[2], vl0[3], vh0[0], vh0[1], vh0[2], vh0[3]}, o[1], 0, 0, 0); if (DO_EXP) { X0[12] = __builtin_amdgcn_exp2f(X0[12]); } if (DO_QK) { P0[15] = fmamk_s<1104674816>(ss_, xl0_); } if (DO_QK) { P1[0] = fmamk_s<0>(ss_, xl1_); } if (DO_QK) { P1[1] = fmamk_s<1065353216>(ss_, xl1_); } SBAR(); \
      vl0 = vtr(vb_ + 3072); vh0 = vtr(vb_ + 3584); o[2] = __builtin_amdgcn_mfma_f32_32x32x16_bf16(pa2, (bf16x8){vl1[0], vl1[1], vl1[2], vl1[3], vh1[0], vh1[1], vh1[2], vh1[3]}, o[2], 0, 0, 0); if (DO_EXP) { X0[13] = __builtin_amdgcn_exp2f(X0[13]); } if (DO_QK) { P1[2] = fmamk_s<1073741824>(ss_, xl1_); } if (DO_QK) { P1[3] = fmamk_s<1077936128>(ss_, xl1_); } SBAR(); \
      vl1 = vtr(vb_ + 7168); vh1 = vtr(vb_ + 7680); o[3] = __builtin_amdgcn_mfma_f32_32x32x16_bf16(pa2, (bf16x8){vl2[0], vl2[1], vl2[2], vl2[3], vh2[0], vh2[1], vh2[2], vh2[3]}, o[3], 0, 0, 0); lacc4 = __builtin_amdgcn_mfma_f32_16x16x32_bf16(lmask, pa2, lacc4, 0, 0, 0); if (DO_EXP) { X0[14] = __builtin_amdgcn_exp2f(X0[14]); } if (DO_EXP) { X0[15] = __builtin_amdgcn_exp2f(X0[15]); } if (DO_QK) { P1[4] = fmamk_s<1090519040>(ss_, xl1_); } if (DO_QK) { P1[5] = fmamk_s<1091567616>(ss_, xl1_); } if (DO_QK) { P1[6] = fmamk_s<1092616192>(ss_, xl1_); } SBAR(); \
      if (!lead_half && (JJ) + 1 < NT) { ATT_WAIT_BAR(4); }     \
      vl2 = vtr(vb_ + 11264); vh2 = vtr(vb_ + 11776); o[0] = __builtin_amdgcn_mfma_f32_32x32x16_bf16(pa3, (bf16x8){vl0[0], vl0[1], vl0[2], vl0[3], vh0[0], vh0[1], vh0[2], vh0[3]}, o[0], 0, 0, 0); if (DO_EXP) { X1[0] = __builtin_amdgcn_exp2f(X1[0]); } if (DO_EXP) { t0_ = cvtpk(X0[8], X0[9]); t1_ = cvtpk(X0[10], X0[11]); } if (DO_QK) { P1[7] = fmamk_s<1093664768>(ss_, xl1_); } if (DO_QK) { P1[8] = fmamk_s<1098907648>(ss_, xl1_); } SBAR(); \
      vl0 = vtr(vb_ + 15360); vh0 = vtr(vb_ + 15872); o[1] = __builtin_amdgcn_mfma_f32_32x32x16_bf16(pa3, (bf16x8){vl1[0], vl1[1], vl1[2], vl1[3], vh1[0], vh1[1], vh1[2], vh1[3]}, o[1], 0, 0, 0); if (DO_EXP) { X1[1] = __builtin_amdgcn_exp2f(X1[1]); } if (DO_EXP) { t2_ = cvtpk(X0[12], X0[13]); t3_ = cvtpk(X0[14], X0[15]); { u32x4 w_ = {t0_, t1_, t2_, t3_}; pa1 = __builtin_bit_cast(bf16x8, w_); } } if (DO_QK) { P1[9] = fmamk_s<1099431936>(ss_, xl1_); } if (DO_QK) { P1[10] = fmamk_s<1099956224>(ss_, xl1_); } if (DO_QK) { P1[11] = fmamk_s<1100480512>(ss_, xl1_); } SBAR(); \
      if (DO_QK) kf0 = *(const __attribute__((address_space(3))) bf16x8*)(kb_ + 0); o[2] = __builtin_amdgcn_mfma_f32_32x32x16_bf16(pa3, (bf16x8){vl2[0], vl2[1], vl2[2], vl2[3], vh2[0], vh2[1], vh2[2], vh2[3]}, o[2], 0, 0, 0); if (DO_EXP) { X1[2] = __builtin_amdgcn_exp2f(X1[2]); } if (DO_EXP) { X1[3] = __builtin_amdgcn_exp2f(X1[3]); } if (DO_QK) { P1[12] = fmamk_s<1103101952>(ss_, xl1_); } if (DO_QK) { P1[13] = fmamk_s<1103626240>(ss_, xl1_); } SBAR(); \
      if (DO_QK) kf1 = *(const __attribute__((address_space(3))) bf16x8*)(kb_ + 512); o[3] = __builtin_amdgcn_mfma_f32_32x32x16_bf16(pa3, (bf16x8){vl0[0], vl0[1], vl0[2], vl0[3], vh0[0], vh0[1], vh0[2], vh0[3]}, o[3], 0, 0, 0); lacc4 = __builtin_amdgcn_mfma_f32_16x16x32_bf16(lmask, pa3, lacc4, 0, 0, 0); if (DO_EXP) { X1[4] = __builtin_amdgcn_exp2f(X1[4]); } if (DO_QK) { P1[14] = fmamk_s<1104150528>(ss_, xl1_); } if (DO_QK) { P1[15] = fmamk_s<1104674816>(ss_, xl1_); } SBAR(); if (DO_QK && mixed_) { const float c2_ = -2.f * nslope2; P0[0] += c2_ * __builtin_fminf(dq2_ - 0.f, 0.f); P0[1] += c2_ * __builtin_fminf(dq2_ - 1.f, 0.f); P0[2] += c2_ * __builtin_fminf(dq2_ - 2.f, 0.f); P0[3] += c2_ * __builtin_fminf(dq2_ - 3.f, 0.f); P0[4] += c2_ * __builtin_fminf(dq2_ - 8.f, 0.f); P0[5] += c2_ * __builtin_fminf(dq2_ - 9.f, 0.f); P0[6] += c2_ * __builtin_fminf(dq2_ - 10.f, 0.f); P0[7] += c2_ * __builtin_fminf(dq2_ - 11.f, 0.f); P0[8] += c2_ * __builtin_fminf(dq2_ - 16.f, 0.f); P0[9] += c2_ * __builtin_fminf(dq2_ - 17.f, 0.f); P0[10] += c2_ * __builtin_fminf(dq2_ - 18.f, 0.f); P0[11] += c2_ * __builtin_fminf(dq2_ - 19.f, 0.f); P0[12] += c2_ * __builtin_fminf(dq2_ - 24.f, 0.f); P0[13] += c2_ * __builtin_fminf(dq2_ - 25.f, 0.f); P0[14] += c2_ * __builtin_fminf(dq2_ - 26.f, 0.f); P0[15] += c2_ * __builtin_fminf(dq2_ - 27.f, 0.f); P1[0] += c2_ * __builtin_fminf(dq2_ - 32.f, 0.f); P1[1] += c2_ * __builtin_fminf(dq2_ - 33.f, 0.f); P1[2] += c2_ * __builtin_fminf(dq2_ - 34.f, 0.f); P1[3] += c2_ * __builtin_fminf(dq2_ - 35.f, 0.f); P1[4] += c2_ * __builtin_fminf(dq2_ - 40.f, 0.f); P1[5] += c2_ * __builtin_fminf(dq2_ - 41.f, 0.f); P1[6] += c2_ * __builtin_fminf(dq2_ - 42.f, 0.f); P1[7] += c2_ * __builtin_fminf(dq2_ - 43.f, 0.f); P1[8] += c2_ * __builtin_fminf(dq2_ - 48.f, 0.f); P1[9] += c2_ * __builtin_fminf(dq2_ - 49.f, 0.f); P1[10] += c2_ * __builtin_fminf(dq2_ - 50.f, 0.f); P1[11] += c2_ * __builtin_fminf(dq2_ - 51.f, 0.f); P1[12] += c2_ * __builtin_fminf(dq2_ - 56.f, 0.f); P1[13] += c2_ * __builtin_fminf(dq2_ - 57.f, 0.f); P1[14] += c2_ * __builtin_fminf(dq2_ - 58.f, 0.f); P1[15] += c2_ * __builtin_fminf(dq2_ - 59.f, 0.f); } SBAR(); \
      if (DO_QK) kf2 = *(const __attribute__((address_space(3))) bf16x8*)(kb_ + 2048); if (DO_QK) P0 = __builtin_amdgcn_mfma_f32_32x32x16_bf16(kf0, qr[0], P0, 0, 0, 0); if (DO_EXP) { X1[5] = __builtin_amdgcn_exp2f(X1[5]); } SBAR(); \
      if (DO_QK) kf0 = *(const __attribute__((address_space(3))) bf16x8*)(kb_ + 2560); if (DO_QK) P1 = __builtin_amdgcn_mfma_f32_32x32x16_bf16(kf1, qr[0], P1, 0, 0, 0); if (DO_EXP) { X1[6] = __builtin_amdgcn_exp2f(X1[6]); } if (DO_EXP) { X1[7] = __builtin_amdgcn_exp2f(X1[7]); } SBAR(); \
      if (DO_QK) kf1 = *(const __attribute__((address_space(3))) bf16x8*)(kb_ + 4096); if (DO_QK) P0 = __builtin_amdgcn_mfma_f32_32x32x16_bf16(kf2, qr[1], P0, 0, 0, 0); if (DO_EXP) { X1[8] = __builtin_amdgcn_exp2f(X1[8]); } if (DO_EXP) { t0_ = cvtpk(X1[0], X1[1]); t1_ = cvtpk(X1[2], X1[3]); } SBAR(); \
      if (DO_QK) kf2 = *(const __attribute__((address_space(3))) bf16x8*)(kb_ + 4608); if (DO_QK) P1 = __builtin_amdgcn_mfma_f32_32x32x16_bf16(kf0, qr[1], P1, 0, 0, 0); if (DO_EXP) { X1[9] = __builtin_amdgcn_exp2f(X1[9]); } if (DO_EXP) { t2_ = cvtpk(X1[4], X1[5]); t3_ = cvtpk(X1[6], X1[7]); { u32x4 w_ = {t0_, t1_, t2_, t3_}; pa2 = __builtin_bit_cast(bf16x8, w_); } } SBAR(); \
      if (DO_QK) kf0 = *(const __attribute__((address_space(3))) bf16x8*)(kb_ + 6144); if (DO_QK) P0 = __builtin_amdgcn_mfma_f32_32x32x16_bf16(kf1, qr[2], P0, 0, 0, 0); if (DO_EXP) { X1[10] = __builtin_amdgcn_exp2f(X1[10]); } if (DO_EXP) { X1[11] = __builtin_amdgcn_exp2f(X1[11]); } SBAR(); \
      if (DO_QK) kf1 = *(const __attribute__((address_space(3))) bf16x8*)(kb_ + 6656); if (DO_QK) P1 = __builtin_amdgcn_mfma_f32_32x32x16_bf16(kf2, qr[2], P1, 0, 0, 0); if (DO_EXP) { X1[12] = __builtin_amdgcn_exp2f(X1[12]); } SBAR(); \
      if (DO_QK) P0 = __builtin_amdgcn_mfma_f32_32x32x16_bf16(kf0, qr[3], P0, 0, 0, 0); if (DO_EXP) { X1[13] = __builtin_amdgcn_exp2f(X1[13]); } SBAR(); \
      if (DO_QK) P1 = __builtin_amdgcn_mfma_f32_32x32x16_bf16(kf1, qr[3], P1, 0, 0, 0); if (DO_EXP) { X1[14] = __builtin_amdgcn_exp2f(X1[14]); } if (DO_EXP) { X1[15] = __builtin_amdgcn_exp2f(X1[15]); } SBAR(); \
    } \
    dq1 -= 64.f; ATT_ROT3(sk_cur); ATT_ROT3(sv_cur); ATT_ROT3(sk_dma); ATT_ROT3(sv_dma); } while (0)

struct UnitDesc { int u, h, qb, nc, ci, sid, t_lo, t_hi; float slope; };
constexpr int ITEM_FROM_PRE = 8192 - 1024;
__device__ __forceinline__ float att_window(float Bn, float Cn, float slope) {
    const float a1 = 2.f * Bn + 18.2f, a2 = Bn + Cn + 63.f * slope + __logf(1.f / (64.f * slope)) + 18.2f;
    return (ATT_EXACT_ZERO ? 104.f + 2.f * Bn : fminf(a1, a2)) / slope;
}
__device__ __forceinline__ UnitDesc decode_unit(int idx, float Bn, float Cn, const __attribute__((address_space(3))) unsigned short* pre, const __attribute__((address_space(3))) unsigned short* sidx) {
    UnitDesc d;
    const unsigned it_ = (unsigned)__builtin_amdgcn_readfirstlane((int)((const __attribute__((address_space(3))) unsigned*)((const __attribute__((address_space(3))) unsigned char*)pre + ITEM_FROM_PRE))[idx]);
    d.u = (int)(it_ & 511u); d.ci = (int)((it_ >> 10) & 3u); d.nc = (int)((it_ >> 12) & 3u); d.sid = __builtin_amdgcn_readfirstlane((int)sidx[d.u]);
    const int k = d.u & 127; d.h = 3 - (d.u >> 7); d.qb = (k & 1) ? 63 - (k >> 1) : 64 + (k >> 1);
    d.slope = exp2f(-2.f * (float)(d.h + 1));
    const float Rf = att_window(Bn, Cn, d.slope);
    const int R = __builtin_amdgcn_readfirstlane(Rf < 20000.f ? (int)Rf + 1 : 20000);
    const int q0 = d.qb * 128; const int klo = q0 - R < 0 ? 0 : q0 - R, khi = q0 + 127 + R > M - 1 ? M - 1 : q0 + 127 + R;
    const int tlo = klo >> 6, nt = (khi >> 6) - tlo + 1, base = nt / d.nc, rem = nt - base * d.nc;
    d.t_lo = tlo + d.ci * base + (d.ci < rem ? d.ci : rem); d.t_hi = d.t_lo + base + (d.ci < rem ? 1 : 0) - 1;
    return d;
}
__device__ __forceinline__ void attn_unit(int idx, float Bn, float Cn, float lam, const __attribute__((address_space(3))) unsigned short* pre, const __attribute__((address_space(3))) unsigned short* sidx,
                                          const unsigned short* Q, const unsigned char* Kimg, const unsigned char* Vimg, unsigned short* MIX, const float* hn, char* shm,
                                          float* slabs, unsigned* cnts, volatile __attribute__((address_space(3))) unsigned* bcast, unsigned& nx, gu32* qctr) {
    const int tid = threadIdx.x, lane = tid & 63, r32 = lane & 31, hi = lane >> 5; const int wid = __builtin_amdgcn_readfirstlane(tid >> 6), rg = wid >> 1, mp = wid & 1;
    const UnitDesc D = decode_unit(idx, Bn, Cn, pre, sidx);
    const int h = D.h, t_lo = D.t_lo, t_hi = D.t_hi; const float slope2 = D.slope * LOG2E;
    const float shift2 = fmaxf(0.f, Bn * LOG2E - 24.f);
    const int q0 = D.qb * 128, NT = t_hi - t_lo + 1;
    const unsigned lds0 = (unsigned)(uintptr_t)shm;
    const unsigned char* ksrc = Kimg + (size_t)h * 256 * SLOT + wid * 2048;
    const unsigned char* vsrc = Vimg + (size_t)h * 256 * SLOT + wid * 2048;
    const unsigned lane16 = (unsigned)lane * 16u;
    const unsigned kdst = lds0 + LDS_K + wid * 2048, vdst = lds0 + LDS_V + wid * 2048;
    const unsigned short* Qw = Q + (size_t)(q0 + rg * 32 + r32) * AW + h * 128 + mp * 64 + hi * 8;
    bf16x8 qr[4];
#pragma unroll
    for (int d0 = 0; d0 < 4; ++d0) qr[d0] = *(const bf16x8*)(Qw + d0 * 16);
    int tj = t_lo;
    ATT_DMA2(ksrc, tj, kdst); ATT_DMA2(ksrc, tj + 1, kdst + SLOT); ATT_DMA2(vsrc, tj, vdst); ATT_DMA2(ksrc, tj + 2, kdst + 2 * SLOT); ATT_DMA2(ksrc, tj + 3, kdst + 3 * SLOT); ATT_DMA2(vsrc, tj + 1, vdst + SLOT);
    const lds_cptr shm3 = (lds_cptr)shm;
    const lds_cptr kp0 = shm3 + LDS_K + (8 * mp + hi) * 1024 + r32 * 16;
    const lds_cptr vp0 = shm3 + LDS_V + v_rd_base(lane);
    const float dq0 = (float)(q0 + rg * 32 + r32 - t_lo * 64 - 4 * hi);
    const int qw0 = q0 + rg * 32;
    const float nslope2 = -slope2;
    f32x16 o[4]; o[0] = f32x16{}; o[1] = f32x16{}; o[2] = f32x16{}; o[3] = f32x16{};
    f32x4 lacc4 = f32x4{0.f, 0.f, 0.f, 0.f};
    bf16x8 lmask; { const int row_ = lane & 15, kg_ = lane >> 4; const bool on_ = (((row_ & 7) == 0) && ((kg_ & 1) == 0)) || (((row_ & 7) == 4) && ((kg_ & 1) == 1));
                    const short one_ = on_ ? (short)0x3F80 : (short)0; lmask = (bf16x8){one_, one_, one_, one_, one_, one_, one_, one_}; }
    f32x16 sA0, sA1, sB0, sB1; bf16x8 pa0, pa1, pa2, pa3 = bf16x8{};
    bias_general(sA0, sA1, dq0, nslope2, shift2);
    bias_general(sB0, sB1, dq0 - 64.f, nslope2, shift2);
    ATT_WAIT_BAR(8);
    qkt_acc(sA0, sA1, kp0, qr);
    qkt_acc(sB0, sB1, kp0 + SLOT, qr);
    softmax_first(sA0, sA1, pa0, pa1, pa2);
    float dq1 = dq0 - 64.f;
    int sk_cur = 2 * SLOT, sv_cur = 0, sk_dma = 0, sv_dma = 2 * SLOT;
    const bool lead_half = wid < 4;
    if (wid >= 4) __builtin_amdgcn_s_setprio(1);
    int j = 0;
    for (; j + 2 < NT; j += 2) { ATT_STEP(sA0, sA1, sB0, sB1, true, true, j); ATT_STEP(sB0, sB1, sA0, sA1, true, true, j + 1); }
    if (NT - j == 2) { ATT_STEP(sA0, sA1, sB0, sB1, true, true, j);
#pragma unroll
        for (int r = 8; r < 16; ++r) sA1[r] = sB1[r];
        ATT_STEP(sA0, sA1, sB0, sB1, false, false, j + 1); }
    else { ATT_STEP(sA0, sA1, sB0, sB1, false, false, j); }
    __builtin_amdgcn_s_setprio(0);
    if (threadIdx.x == 0) nx = __hip_atomic_fetch_add(qctr, 1u, __ATOMIC_RELAXED, __HIP_MEMORY_SCOPE_AGENT);
    float l_acc = lacc4[0];
    ATT_WAIT_BAR(0);
    int idx_e = idx; asm volatile("" : "+s"(idx_e));
    int tid_e = threadIdx.x; asm volatile("" : "+v"(tid_e));
    const int lane_e = tid_e & 63, r32_e = lane_e & 31, hi_e = lane_e >> 5, wid_e = __builtin_amdgcn_readfirstlane(tid_e >> 6), rg_e = wid_e >> 1, mp_e = wid_e & 1;
    const UnitDesc E = decode_unit(idx_e, Bn, Cn, pre, sidx);
    const int nc = E.nc, ci = E.ci, h_e = E.h, q0_e = E.qb * 128;
    float* slab_u = slabs + (size_t)E.sid * 3 * SLAB_FLOATS; unsigned* cnt_u = cnts + E.u;
    if (nc > 1) {
        float* sl = slab_u + (size_t)ci * SLAB_FLOATS + wid_e * 4160;
#pragma unroll
        for (int d0 = 0; d0 < 4; ++d0)
#pragma unroll
            for (int i = 0; i < 4; ++i) { const f32x4 v_ = (f32x4){o[d0][4 * i], o[d0][4 * i + 1], o[d0][4 * i + 2], o[d0][4 * i + 3]};
                asm volatile("global_store_dwordx4 %0, %1, off sc1\n\ts_nop 1" :: "v"(sl + ((d0 * 4 + i) * 64 + lane_e) * 4), "v"(v_) : "memory"); }
        asm volatile("global_store_dword %0, %1, off sc1\n\ts_nop 1" :: "v"(sl + 4096 + lane_e), "v"(l_acc) : "memory");
        asm volatile("s_waitcnt vmcnt(0)" ::: "memory");
        __syncthreads();
        if (tid_e == 0) bcast[0] = __hip_atomic_fetch_add(cnt_u, 1u, __ATOMIC_RELAXED, __HIP_MEMORY_SCOPE_AGENT);
        __syncthreads();
        const unsigned old = bcast[0];
        __syncthreads();
        if ((int)old != nc - 1) return;
        if (tid_e == 0) { __builtin_amdgcn_fence(__ATOMIC_ACQUIRE, "agent"); asm volatile("s_waitcnt vmcnt(0)" ::: "memory"); }
        __syncthreads();
        o[0] = f32x16{}; o[1] = f32x16{}; o[2] = f32x16{}; o[3] = f32x16{}; l_acc = 0.f;
        for (int cc = 0; cc < nc; ++cc) { const float* rs = slab_u + (size_t)cc * SLAB_FLOATS + wid_e * 4160;
            f32x4 sv[16];
#pragma unroll
            for (int k = 0; k < 16; ++k) sv[k] = *(const f32x4*)(rs + (k * 64 + lane_e) * 4);
            const float sl_l = rs[4096 + lane_e];
            asm volatile("" :: "v"(sv[0]), "v"(sv[1]), "v"(sv[2]), "v"(sv[3]), "v"(sv[4]), "v"(sv[5]), "v"(sv[6]), "v"(sv[7]), "v"(sv[8]), "v"(sv[9]), "v"(sv[10]), "v"(sv[11]), "v"(sv[12]), "v"(sv[13]), "v"(sv[14]), "v"(sv[15]));
#pragma unroll
            for (int d0 = 0; d0 < 4; ++d0)
#pragma unroll
                for (int i = 0; i < 4; ++i) { const f32x4 v = sv[d0 * 4 + i]; o[d0][4 * i] += v[0]; o[d0][4 * i + 1] += v[1]; o[d0][4 * i + 2] += v[2]; o[d0][4 * i + 3] += v[3]; }
            l_acc += sl_l; }
    }
    float* wsf = (float*)(shm + LDS_WS) + wid_e * 64;
    if (hi_e == 0) wsf[r32_e] = l_acc;
    asm volatile("s_waitcnt lgkmcnt(0)" ::: "memory");
    float rli[16];
#pragma unroll
    for (int r = 0; r < 16; ++r) rli[r] = __builtin_amdgcn_rcpf(wsf[crow(r, hi_e)]);
    float* X = (float*)shm + rg_e * 32 * XSTRIDE;
    if (mp_e == 1) {
#pragma unroll
        for (int r = 0; r < 16; ++r)
#pragma unroll
            for (int d0 = 0; d0 < 4; ++d0) X[crow(r, hi_e) * XSTRIDE + d0 * 32 + r32_e] = lam * o[d0][r] * rli[r];
    }
    ATT_WAIT_BAR(0);
    if (mp_e == 0) {
#pragma unroll
        for (int r = 0; r < 16; ++r)
#pragma unroll
            for (int d0 = 0; d0 < 4; ++d0) { float* xp = X + crow(r, hi_e) * XSTRIDE + d0 * 32 + r32_e; *xp = o[d0][r] * rli[r] - *xp; }
        asm volatile("s_waitcnt lgkmcnt(0)" ::: "memory");
        const float* xr = X + r32_e * XSTRIDE + hi_e * 64;
        f32x4 v[16]; float ss = 0.f;
#pragma unroll
        for (int i = 0; i < 16; ++i) { v[i] = *(const f32x4*)(xr + 4 * i); ss += (v[i][0] * v[i][0] + v[i][1] * v[i][1]) + (v[i][2] * v[i][2] + v[i][3] * v[i][3]); }
        { auto rr = __builtin_amdgcn_permlane32_swap(__float_as_uint(ss), __float_as_uint(ss), false, false); ss = __uint_as_float(rr[0]) + __uint_as_float(rr[1]); }
        const float rn = rsqrtf(ss * (1.f / 128.f) + EPS) * (1.f - LAM_INIT);
        unsigned short* orow = MIX + (size_t)(q0_e + rg_e * 32 + r32_e) * DM + h_e * 128 + hi_e * 64;
        const __attribute__((address_space(3))) f32x4* g = (const __attribute__((address_space(3))) f32x4*)((lds_cptr)shm + LDS_HN + hi_e * 256);
#pragma unroll
        for (int i = 0; i < 8; ++i) { const f32x4 g0 = g[2 * i], g1 = g[2 * i + 1]; const f32x4 a = v[2 * i] * rn * g0, b = v[2 * i + 1] * rn * g1;
            u32x4 w; w.x = cvtpk(a[0], a[1]); w.y = cvtpk(a[2], a[3]); w.z = cvtpk(b[0], b[1]); w.w = cvtpk(b[2], b[3]); *(u32x4*)(orow + 8 * i) = w; }
    }
    ATT_WAIT_BAR(0);
}
}

constexpr int N_LAUNCHES = MK_N_LAUNCHES, PER_PHASE = 7;
constexpr int N_ATT_UNITS = NH * (M / 128), N_CONV_UNITS = M / 64;

__global__ void __launch_bounds__(NWAVES * 64, 2) fwd(Args args) {
    extern __shared__ __attribute__((aligned(16))) unsigned char lds_raw[];
    LAS unsigned char* lds = (LAS unsigned char*)lds_raw;
    volatile LAS unsigned* MISC = (volatile LAS unsigned*)(lds + MISC_OFF);
    const int tid = threadIdx.x, lane = tid & 63, wave = __builtin_amdgcn_readfirstlane(tid >> 6);
    const int G = gridDim.x; const int bx = blockIdx.x; const int vcu = (G % 8 == 0) ? (bx % 8) * (G / 8) + bx / 8 : bx;
    unsigned char* ws = args.ws;
    gu32* ctl = (gu32*)(ws + WS_CTL);
    for (int u = tid; u < (LDS_BYTES - LDSCTL_OFF) / 4; u += NWAVES * 64) ((LAS unsigned*)(lds + LDSCTL_OFF))[u] = 0u;
    __syncthreads();
    XcdBarrier bar; bar.bar = (unsigned*)(ctl + CW_BAR); bar.x = 0; bar.st = nullptr;
    if (N_LAUNCHES != PER_PHASE) bar = xcd_barrier_post((unsigned*)(ctl + CW_BAR), MISC + 8);
#define GRID_BAR() do { if (N_LAUNCHES != PER_PHASE) xcd_barrier(bar); } while (0)
    const int lo = args.ph_lo, hi = args.ph_hi;
#define IN(k) (lo <= (k) && (k) < hi)
#define BOTH(k) (IN(k) && IN((k) + 1))
    bf16* XN = (bf16*)(ws + WS_XN); bf16* Qb = (bf16*)(ws + WS_Q); unsigned char* Kimg = ws + WS_KIMG; unsigned char* Vimg = ws + WS_VIMG; bf16* Ub = (bf16*)(ws + WS_U);
    bf16* MIX = (bf16*)(ws + WS_MIX); bf16* HM = (bf16*)(ws + WS_HM); bf16* PB = (bf16*)(ws + WS_PB); bf16* PR = (bf16*)(ws + WS_PROJ);
    float* SS1 = (float*)(ws + WS_SS1); float* SS2 = (float*)(ws + WS_SS2);

    if (IN(0)) { p0_prologue(args, lds, vcu, G, wave, lane); if (BOTH(0)) GRID_BAR(); }
    int vc = bx; bool xl = false;
    if (N_LAUNCHES == 1 && IN(0)) { xl = __builtin_amdgcn_readfirstlane((int)MISC[11]) != 0; if (xl) vc = (int)bar.x + 8 * __builtin_amdgcn_readfirstlane((int)MISC[10]); }
#define XCD_BAR() do { if (N_LAUNCHES != PER_PHASE) { if (xl) xcd_local_barrier(bar); else xcd_barrier(bar); } } while (0)

    constexpr int NT1 = (M / 256) * (NIN / 256);
    const int first_idle = NT1 - ((NT1 + G - 1) / G - 1) * G, w_p1 = (N_LAUNCHES == 1) ? ((G - first_idle) < N_W_UNITS ? (G - first_idle) : N_W_UNITS) : 0, w_p2 = N_W_UNITS - w_p1;
    if (IN(1)) {
        { pg8::Gemm g{XN, (const bf16*)(ws + WS_WIN), M, NIN, DM}; pg8::StaticOrder S; S.init(M, NIN, G, bx);
          LAS float* rtab = (LAS float*)(lds + LDSCTL_OFF + 12288); int rpm = -1;
          LAS float* gtab = (LAS float*)(lds + LDSCTL_OFF + 13824);
          if (tid >= 256 && tid < 384) gtab[tid - 256] = tid < 320 ? args.in[4][tid - 256] : args.in[5][tid - 320];
          { pg8::Unit u0; if (S.next(0, u0)) { rpm = u0.pm; if (tid < 256) rtab[tid] = rsqrtf(((const float*)(ws + WS_SS0))[rpm * 256 + tid] * (1.f / DM) + EPS); } __syncthreads(); }
          pg8::EpiIn E{Qb, Kimg, Vimg, Ub, args.in[4], args.in[5], (unsigned*)(ctl + CW_QMAX), (const float*)(ws + WS_SS0), rtab, rpm, gtab, (LAS unsigned*)(lds + LDSCTL_OFF + 14400)};
          pg8::gemm_phase<pg8::EpiIn, pg8::StaticOrder, PG8_ALIGN, PG8_SP2>(lds + RING_OFF, g, S, E);
          __syncthreads();
          if (tid < 3) { const unsigned v = ((LAS unsigned*)(lds + LDSCTL_OFF + 14400))[tid]; if (v) atomicMax((unsigned*)(ctl + CW_QMAX) + tid, v); } }
        if (w_p1 > 0 && bx >= first_idle && bx - first_idle < w_p1) weight_unit(bx - first_idle, args, lds, wave, lane);
        if (BOTH(1)) GRID_BAR();
    }

    if (IN(2)) {
        const unsigned mx3 = __hip_atomic_load((unsigned*)(ctl + CW_QMAX) + (lane < 3 ? lane : 0), __ATOMIC_RELAXED, __HIP_MEMORY_SCOPE_AGENT);
        const float qmax = __uint_as_float(__builtin_amdgcn_readlane(mx3, 0)), kmax = __uint_as_float(__builtin_amdgcn_readlane(mx3, 1)), kbar = __uint_as_float(__builtin_amdgcn_readlane(mx3, 2));
        const float Bn = qmax * kmax * (1.02f / LOG2E);
        const float Cn = qmax * kbar * (1.02f / LOG2E) + 0.05f;
        const float d1 = wave_sum(args.in[6][lane] * args.in[7][lane]), d2 = wave_sum(args.in[8][lane] * args.in[9][lane]);
        const float lam = __expf(d1) - __expf(d2) + LAM_INIT;
        LAS unsigned short* pre = (LAS unsigned short*)(lds + LDSCTL_OFF + 1024);
        LAS unsigned short* sidx = (LAS unsigned short*)(lds + LDSCTL_OFF + 2112);
        LAS unsigned* wtot = (LAS unsigned*)(lds + LDSCTL_OFF + 3200);
        if (tid < 128) ((LAS float*)(lds + att::LDS_HN))[tid] = args.in[10][tid];
        { const int u = tid, h = 3 - (u >> 7), k = u & 127, qb = (k & 1) ? 63 - (k >> 1) : 64 + (k >> 1);
          const float slope = exp2f(-2.f * (float)(h + 1));
          const float Rf = att::att_window(Bn, Cn, slope);
          const int R = Rf < 20000.f ? (int)Rf + 1 : 20000;
          const int q0 = qb * 128; const int klo = q0 - R < 0 ? 0 : q0 - R, khi = q0 + 127 + R > M - 1 ? M - 1 : q0 + 127 + R;
          const int my_nt = (khi >> 6) - (klo >> 6) + 1, want = my_nt > 100 ? 1 : 0;
          int v = want;
#pragma unroll
          for (int o = 1; o < 64; o <<= 1) { const int t = __shfl_up(v, o); if (lane >= o) v += t; }
          if (lane == 63) wtot[wave] = (unsigned)v;
          __syncthreads();
          int off = 0;
          for (int w = 0; w < wave; ++w) off += (int)wtot[w];
          const int sid = off + v - want;
          const int my_nc = (want && sid < MAX_SPLIT_UNITS) ? ((my_nt + 63) / 64 < 3 ? (my_nt + 63) / 64 : 3) : 1;
          sidx[u] = (unsigned short)sid;
          v = my_nc;
#pragma unroll
          for (int o = 1; o < 64; o <<= 1) { const int t = __shfl_up(v, o); if (lane >= o) v += t; }
          if (lane == 63) wtot[8 + wave] = (unsigned)v;
          __syncthreads();
          off = 0;
          for (int w = 0; w < wave; ++w) off += (int)wtot[8 + w];
          pre[u] = (unsigned short)(off + v - my_nc);
          if (u == 511) pre[512] = (unsigned short)(off + v);
          { LAS unsigned* item = (LAS unsigned*)(lds + LDSCTL_OFF + 8192);
            for (int ci = 0; ci < my_nc; ++ci) item[off + v - my_nc + ci] = (unsigned)u | ((unsigned)ci << 10) | ((unsigned)my_nc << 12); }
          __syncthreads(); }
        const int n_att = (int)pre[512];
        unsigned* slabs_cnt = (unsigned*)(ctl + CW_UCNT);
        bool conv_w_staged = false;
        unsigned nx = 0;
        if (tid == 0) nx = __hip_atomic_fetch_add(ctl + CW_QUEUE, 1u, __ATOMIC_RELAXED, __HIP_MEMORY_SCOPE_AGENT);
        for (;;) {
            if (tid == 0) MISC[16] = nx;
            __syncthreads();
            const int idx = __builtin_amdgcn_readfirstlane((int)MISC[16]);
            __syncthreads();
            if (idx >= n_att + w_p2 + N_CONV_UNITS) break;
            if (idx < n_att) {
                att::attn_unit(idx, Bn, Cn, lam, pre, sidx, Qb, Kimg, Vimg, MIX, args.in[10], (char*)lds_raw, (float*)(ws + WS_SLAB), slabs_cnt, MISC + 17, nx, ctl + CW_QUEUE);
            } else if (tid == 0) nx = __hip_atomic_fetch_add(ctl + CW_QUEUE, 1u, __ATOMIC_RELAXED, __HIP_MEMORY_SCOPE_AGENT);
            if (idx < n_att) {
            } else if (idx < n_att + w_p2) {
                weight_unit(w_p1 + idx - n_att, args, lds, wave, lane);
            } else {
                conv_unit(idx - n_att - w_p2, Ub, args.in[11], args.in[12], args.in[13], args.in[14], MIX, lds, tid, wave, lane, conv_w_staged);
            }
        }
        if (BOTH(2)) GRID_BAR();
    }

    if (IN(3)) {
        pg8::Gemm g{MIX, (const bf16*)(ws + WS_WOUT), M, DM, DM}; pg8::StaticOrder S; S.init(M, DM, G, vc);
        pg8::EpiRes<false> E{nullptr, XN, SS1};
        pg8::gemm_phase<pg8::EpiRes<false>, pg8::StaticOrder, PG8_ALIGN, PG8_SP2>(lds + RING_OFF, g, S, E);
        if (BOTH(3)) XCD_BAR();
    }
    if (IN(4)) {
        { pg8::Gemm g{XN, (const bf16*)(ws + WS_WGU), M, 2 * FF, DM}; pg8::StaticOrder S; S.init(M, 2 * FF, G, vc);
          LAS float* rtab = (LAS float*)(lds + LDSCTL_OFF + 12288); int rpm = -1;
          { pg8::Unit u0; if (S.next(0, u0)) { rpm = u0.pm; if (tid < 256) { const f32x4* sp = (const f32x4*)(SS1 + (size_t)(rpm * 256 + tid) * 16); const f32x4 a = sp[0], b = sp[1], c = sp[2], d = sp[3];
                rtab[tid] = rsqrtf((((a[0] + a[1]) + (a[2] + a[3])) + ((b[0] + b[1]) + (b[2] + b[3])) + ((c[0] + c[1]) + (c[2] + c[3])) + ((d[0] + d[1]) + (d[2] + d[3]))) * (1.f / DM) + EPS); } } __syncthreads(); }
          pg8::EpiGU E{HM, SS1, rtab, rpm};
          pg8::gemm_phase<pg8::EpiGU, pg8::StaticOrder, PG8_ALIGN, PG8_SP2>(lds + RING_OFF, g, S, E); }
        { int kproj = PD; asm volatile("" : "+s"(kproj));
          pg8::Gemm g{PB, (const bf16*)(ws + WS_WPP), M, DM, kproj}; pg8::HelperOrder S{G, vc};
          pg8::EpiBf16 E{PR, DM};
          pg8::gemm_phase<pg8::EpiBf16, pg8::HelperOrder, PG8_ALIGN, PG8_SP2>(lds + RING_OFF, g, S, E); }
        if (BOTH(4)) XCD_BAR();
    }
    if (IN(5)) {
        pg8::Gemm g{HM, (const bf16*)(ws + WS_WDN), M, DM, FF}; pg8::StaticOrder S; S.init(M, DM, G, vc);
        pg8::EpiRes<false> E{nullptr, XN, SS2};
        pg8::gemm_phase<pg8::EpiRes<false>, pg8::StaticOrder, PG8_ALIGN, PG8_SP2>(lds + RING_OFF, g, S, E);
        if (BOTH(5)) XCD_BAR();
    }
    if (IN(6)) {
        pg8::Gemm g{XN, (const bf16*)(ws + WS_WPG), M, DM, DM}; pg8::StaticOrder S; S.init(M, DM, G, vc);
        LAS float* rtab = (LAS float*)(lds + LDSCTL_OFF + 12288); int rpm = -1;
        { pg8::Unit u0; if (S.next(0, u0)) { rpm = u0.pm; if (tid < 256) { const f32x4* sp = (const f32x4*)(SS2 + (size_t)(rpm * 256 + tid) * 16); const f32x4 a = sp[0], b = sp[1], c = sp[2], d = sp[3];
              rtab[tid] = rsqrtf((((a[0] + a[1]) + (a[2] + a[3])) + ((b[0] + b[1]) + (b[2] + b[3])) + ((c[0] + c[1]) + (c[2] + c[3])) + ((d[0] + d[1]) + (d[2] + d[3]))) * (1.f / DM) + EPS); } } __syncthreads(); }
        pg8::EpiPG E{args.out, XN, PR, SS2, rtab, rpm};
        pg8::gemm_phase<pg8::EpiPG, pg8::StaticOrder, PG8_ALIGN, PG8_SP2>(lds + RING_OFF, g, S, E);
    }
#undef IN
#undef BOTH
#undef GRID_BAR
#undef XCD_BAR
}

extern "C" void kernel_launch(void* const* d_in, const int* in_sizes, int n_in, void* d_out, int out_size, void* d_ws, size_t ws_size, hipStream_t stream) {
    static int grid = 0;
    if (grid == 0) {
        if (n_in != 23 || in_sizes[0] != M * DM || out_size != M * DM || ws_size < WS_END) { fprintf(stderr, "kernel_launch: unexpected shapes (n_in %d, out %d, ws %zu); nothing launched\n", n_in, out_size, ws_size); grid = -1; return; }
        int dev = 0, cus = 0, per_cu = 0;
        if (hipGetDevice(&dev) != hipSuccess || hipDeviceGetAttribute(&cus, hipDeviceAttributeMultiprocessorCount, dev) != hipSuccess) { grid = -1; return; }
        if (hipFuncSetAttribute((const void*)fwd, hipFuncAttributeMaxDynamicSharedMemorySize, LDS_BYTES) != hipSuccess) { fprintf(stderr, "kernel_launch: hipFuncSetAttribute failed\n"); grid = -1; return; }
        const hipError_t oe = hipOccupancyMaxActiveBlocksPerMultiprocessor(&per_cu, (const void*)fwd, NWAVES * 64, LDS_BYTES);
        (void)hipGetLastError();
        if (oe == hipSuccess && per_cu < 1) { fprintf(stderr, "kernel_launch: the occupancy query admits no workgroup of this kernel per CU; nothing launched\n"); grid = -1; return; }
        grid = cus;
    }
    if (grid < 0) return;
    if (hipMemsetAsync((char*)d_ws + WS_CTL, 0, CTL_ZERO_BYTES, stream) != hipSuccess) { fprintf(stderr, "kernel_launch: memset failed\n"); return; }
    Args a{};
    for (int i = 0; i < 23; ++i) a.in[i] = (const float*)d_in[i];
    a.out = (float*)d_out; a.ws = (unsigned char*)d_ws;
    for (int li = 0; li < N_LAUNCHES; ++li) {
        a.ph_lo = (N_LAUNCHES == PER_PHASE) ? li : 0; a.ph_hi = (N_LAUNCHES == PER_PHASE) ? li + 1 : PER_PHASE; a.li = li;
        hipLaunchKernelGGL(fwd, dim3(grid), dim3(NWAVES * 64), LDS_BYTES, stream, a);
        const hipError_t le = hipPeekAtLastError();
        if (le != hipSuccess) { fprintf(stderr, "kernel_launch: launch %d failed: %s\n", li, hipGetErrorName(le)); break; }
    }
}
```

```cpp
#include <hip/hip_runtime.h>
#include <cstdio>
#include <cstdint>

#ifndef ATT_EXACT_ZERO
#define ATT_EXACT_ZERO 0
#endif
#ifndef MK_N_LAUNCHES
#define MK_N_LAUNCHES 1
#endif

constexpr int M = 16384, DM = 1024, NIN = 2560, AW = 512, CW = 512, NH = 4, DH = 64, VH = 128, KC = 31, FF = 2816, PD = 256;
constexpr float EPS = 1e-6f;
constexpr float LOG2E = 1.4426950408889634f;
constexpr float QSCALE = 0.125f * LOG2E;
constexpr float LAM_INIT = 0.2f;

__host__ __device__ __forceinline__ int v_st(int k, int c) { return ((c >> 5) * 4 + (k >> 4)) * 1024 + (k & 15) * 64 + (c & 31) * 2; }
__host__ __device__ __forceinline__ int k_st(int k, int c) { return (c >> 3) * 1024 + k * 16 + (c & 7) * 2; }
__device__ __forceinline__ float fsigmoid(float x) { return __builtin_amdgcn_rcpf(1.f + __builtin_amdgcn_exp2f(-LOG2E * x)); }

namespace pg8 {
#define PG8_LAS __attribute__((address_space(3)))
typedef unsigned short bf16_t;
typedef short bf16x8 __attribute__((ext_vector_type(8)));
typedef float f32x4 __attribute__((ext_vector_type(4)));
typedef unsigned u32x4 __attribute__((ext_vector_type(4)));
constexpr int BM = 256, BK = 64, HALF = 128, HTB = HALF * BK * 2  , STAGE_BYTES = 8 * HTB, NXCD = 8, WGM = 8;

__host__ __device__ __forceinline__ int lds_byte(int r, int c) { const int st = (r >> 4) * 2 + (c >> 5), rr = r & 15, cc = c & 31, ob = rr * 64 + cc * 2; return st * 1024 + (ob ^ (((ob >> 9) & 1) << 5)); }
__host__ __device__ __forceinline__ void stage_rc(int b, int& R, int& C) { const int st = b / 1024, sb = b % 1024, swz = sb ^ (((sb >> 9) & 1) << 5); R = (st >> 1) * 16 + swz / 64; C = (st & 1) * 32 + (swz % 64) / 2; }
__host__ __device__ __forceinline__ int perm32(int rho) { const int n = rho >> 4, i = rho & 15; return 8 * (i >> 2) + 4 * n + (i & 3); }

struct Unit { int pm, pn; };
struct Gemm { const bf16_t* A; const bf16_t* Bt; int M, N, K; };

struct StaticOrder {
    int nM, nN, nwg, G, c;
    __host__ __device__ void init(int M, int N, int G_, int c_) { nM = M / BM; nN = N / BM; nwg = nM * nN; G = G_; c = c_; }
    __host__ __device__ bool next(int i, Unit& u) const {
        const long L = (long)i * G + c; if (L >= nwg) return false;
        int wgid = (int)L; { const int q = nwg / NXCD, r = nwg % NXCD, xcd = wgid % NXCD, off = wgid / NXCD; wgid = (xcd < r ? xcd * (q + 1) : r * (q + 1) + (xcd - r) * q) + off; }
        const int nig = WGM * nN, gid = wgid / nig, fm = gid * WGM, gsz = (nM - fm) < WGM ? (nM - fm) : WGM;
        u.pm = fm + ((wgid % nig) % gsz); u.pn = (wgid % nig) / gsz; return true;
    }
    __device__ __forceinline__ void a_ready(const Unit&) const {}
    __device__ __forceinline__ void done(const Unit&) const {}
};


__device__ __forceinline__ float sum_fq(float v) {
    { auto r = __builtin_amdgcn_permlane32_swap(__float_as_uint(v), __float_as_uint(v), false, false); v = __uint_as_float(r[0]) + __uint_as_float(r[1]); }
    { auto r = __builtin_amdgcn_permlane16_swap(__float_as_uint(v), __float_as_uint(v), false, false); v = __uint_as_float(r[0]) + __uint_as_float(r[1]); }
    return v;
}
__device__ __forceinline__ unsigned cvt_pk_bf16(float lo, float hi) { unsigned r; asm volatile("v_cvt_pk_bf16_f32 %0, %1, %2" : "=v"(r) : "v"(lo), "v"(hi)); return r; }
typedef _Float16 half2_t __attribute__((ext_vector_type(2)));
__device__ __forceinline__ unsigned pkh(float lo, float hi) { return __builtin_bit_cast(unsigned, __builtin_amdgcn_cvt_pkrtz(lo, hi)); }
__device__ __forceinline__ u32x4 pack8_f16(const f32x4 a, const f32x4 b) { u32x4 w; w.x = pkh(a[0], a[1]); w.y = pkh(a[2], a[3]); w.z = pkh(b[0], b[1]); w.w = pkh(b[2], b[3]); return w; }
__device__ __forceinline__ u32x4 pack8(const f32x4 a, const f32x4 b) { u32x4 w; w.x = cvt_pk_bf16(a[0], a[1]); w.y = cvt_pk_bf16(a[2], a[3]); w.z = cvt_pk_bf16(b[0], b[1]); w.w = cvt_pk_bf16(b[2], b[3]); return w; }

struct EpiBf16 {
    static constexpr bool PERM = true, AFTER_DRAIN = false;
    bf16_t* O; int ldc;
    __device__ __forceinline__ void operator()(const f32x4 (&acc)[2][2][4][2], const Unit& u, int wr, int wc, int fr, int fq) const {
        const int row0 = u.pm * BM + wr * 64 + fr, col0 = u.pn * BM + wc * 32 + 8 * fq;
#pragma unroll
        for (int ai = 0; ai < 2; ++ai)
#pragma unroll
            for (int m = 0; m < 4; ++m) { bf16_t* rowp = O + (size_t)(row0 + ai * HALF + m * 16) * ldc + col0;
#pragma unroll
                for (int bj = 0; bj < 2; ++bj) *(u32x4*)(rowp + bj * HALF) = pack8(acc[ai][bj][m][0], acc[ai][bj][m][1]); }
    }
};

struct EpiIn {
    static constexpr bool PERM = true, AFTER_DRAIN = false;
    bf16_t* Q; unsigned char* Kimg; unsigned char* Vimg; bf16_t* U; const float* qn; const float* kn; unsigned* nmax; const float* SS0; const PG8_LAS float* rtab; int rtab_pm; const PG8_LAS float* gtab; PG8_LAS unsigned* nmax_lds;
    __device__ __forceinline__ void operator()(const f32x4 (&acc)[2][2][4][2], const Unit& u, int wr, int wc, int fr, int fq) const {
        const int row0 = u.pm * BM + wr * 64 + fr;
        float r0s[2][4];
        if (u.pm == rtab_pm) {
#pragma unroll
            for (int ai = 0; ai < 2; ++ai)
#pragma unroll
                for (int m = 0; m < 4; ++m) r0s[ai][m] = rtab[wr * 64 + fr + ai * HALF + m * 16];
        } else {
#pragma unroll
            for (int ai = 0; ai < 2; ++ai)
#pragma unroll
                for (int m = 0; m < 4; ++m) r0s[ai][m] = SS0[row0 + ai * HALF + m * 16];
#pragma unroll
            for (int ai = 0; ai < 2; ++ai)
#pragma unroll
                for (int m = 0; m < 4; ++m) r0s[ai][m] = rsqrtf(r0s[ai][m] * (1.f / DM) + EPS);
        }
        if (u.pn < 4) {
            float nn_max = 0.f;
            const bool isq = u.pn < 2; const PG8_LAS float* gn = gtab + (isq ? 0 : 64); const float sc = isq ? QSCALE : 1.f;
            const int gidx = (u.pn & 1) * 4 + wc;
            f32x4 g[2][2];
#pragma unroll
            for (int bj = 0; bj < 2; ++bj)
#pragma unroll
                for (int n = 0; n < 2; ++n) g[bj][n] = *(const PG8_LAS f32x4*)(gn + 32 * bj + 8 * fq + 4 * n);
            float kbar2_max = 0.f;
#pragma unroll
            for (int ai = 0; ai < 2; ++ai) {
                f32x4 cs[2][2];
#pragma unroll
                for (int bj = 0; bj < 2; ++bj) { cs[bj][0] = (f32x4){0.f, 0.f, 0.f, 0.f}; cs[bj][1] = (f32x4){0.f, 0.f, 0.f, 0.f}; }
#pragma unroll
                for (int m = 0; m < 4; ++m) {
                    float ss = 0.f;
#pragma unroll
                    for (int bj = 0; bj < 2; ++bj)
#pragma unroll
                        for (int n = 0; n < 2; ++n) { const f32x4 x = acc[ai][bj][m][n]; ss += (x[0] * x[0] + x[1] * x[1]) + (x[2] * x[2] + x[3] * x[3]); }
                    ss = sum_fq(ss);
                    const int row = row0 + ai * HALF + m * 16; float nn = 0.f;
                    const float r0 = r0s[ai][m];
                    const float r = rsqrtf(ss * (r0 * r0) * (1.f / 64.f) + EPS) * (r0 * sc);
#pragma unroll
                    for (int bj = 0; bj < 2; ++bj) {
                        const f32x4 v0 = acc[ai][bj][m][0] * r * g[bj][0], v1 = acc[ai][bj][m][1] * r * g[bj][1];
                        nn += (v0[0] * v0[0] + v0[1] * v0[1]) + (v0[2] * v0[2] + v0[3] * v0[3]) + (v1[0] * v1[0] + v1[1] * v1[1]) + (v1[2] * v1[2] + v1[3] * v1[3]);
                        if (!isq) { cs[bj][0] += v0; cs[bj][1] += v1; }
                        const u32x4 w = pack8(v0, v1);
                        if (isq) *(u32x4*)(Q + (size_t)row * AW + gidx * 64 + 32 * bj + 8 * fq) = w;
                        else *(u32x4*)(Kimg + (size_t)((gidx >> 1) * 256 + (row >> 6)) * 16384 + k_st(row & 63, (gidx & 1) * 64 + 32 * bj + 8 * fq)) = w;
                    }
                    nn = sum_fq(nn); nn_max = fmaxf(nn_max, nn);
                }
                if (!isq) {
                    float kb = 0.f;
#pragma unroll
                    for (int bj = 0; bj < 2; ++bj)
#pragma unroll
                        for (int n = 0; n < 2; ++n)
#pragma unroll
                            for (int e = 0; e < 4; ++e) { float c = cs[bj][n][e];
#pragma unroll
                                for (int o = 1; o < 16; o <<= 1) c += __shfl_xor(c, o);
                                kb += c * c; }
                    kb = sum_fq(kb);
                    kbar2_max = fmaxf(kbar2_max, kb * (1.f / 4096.f));
                }
            }
#pragma unroll
            for (int o = 1; o < 16; o <<= 1) nn_max = fmaxf(nn_max, __shfl_xor(nn_max, o));
            if ((threadIdx.x & 63) == 0) (void)__hip_atomic_fetch_max(nmax_lds + (isq ? 0 : 1), __float_as_uint(sqrtf(nn_max)), __ATOMIC_RELAXED, __HIP_MEMORY_SCOPE_WORKGROUP);
            if (!isq && (threadIdx.x & 63) == 0) (void)__hip_atomic_fetch_max(nmax_lds + 2, __float_as_uint(sqrtf(kbar2_max)), __ATOMIC_RELAXED, __HIP_MEMORY_SCOPE_WORKGROUP);
        } else if (u.pn < 6) {
#pragma unroll
            for (int ai = 0; ai < 2; ++ai)
#pragma unroll
                for (int m = 0; m < 4; ++m) { const int row = row0 + ai * HALF + m * 16; const float r0 = r0s[ai][m];
#pragma unroll
                    for (int bj = 0; bj < 2; ++bj) { const int h = (u.pn - 4) * 2 + bj;
                        *(u32x4*)(Vimg + (size_t)(h * 256 + (row >> 6)) * 16384 + v_st(row & 63, wc * 32 + 8 * fq)) = pack8(acc[ai][bj][m][0] * r0, acc[ai][bj][m][1] * r0); } }
        } else {
            const int ch0 = (u.pn - 6) * 128 + wc * 32 + 8 * fq;
#pragma unroll
            for (int ai = 0; ai < 2; ++ai)
#pragma unroll
                for (int m = 0; m < 4; ++m) { const int row = row0 + ai * HALF + m * 16; f32x4 v[2]; const float r0 = r0s[ai][m];
                    const float r2 = -LOG2E * r0, ir0 = __builtin_amdgcn_rcpf(r0);
#pragma unroll
                    for (int n = 0; n < 2; ++n) { const f32x4 a = acc[ai][0][m][n], gt = acc[ai][1][m][n];
                        const f32x4 t = gt * r2; const f32x4 ex = (f32x4){__builtin_amdgcn_exp2f(t[0]), __builtin_amdgcn_exp2f(t[1]), __builtin_amdgcn_exp2f(t[2]), __builtin_amdgcn_exp2f(t[3])};
                        const f32x4 den = ex * ir0 + ir0; v[n] = a * (f32x4){__builtin_amdgcn_rcpf(den[0]), __builtin_amdgcn_rcpf(den[1]), __builtin_amdgcn_rcpf(den[2]), __builtin_amdgcn_rcpf(den[3])}; }
                    *(u32x4*)(U + (size_t)row * CW + ch0) = pack8_f16(v[0], v[1]); }
        }
    }
};

template <bool F32BASE> struct EpiRes {
    static constexpr bool PERM = true, AFTER_DRAIN = false;
    const float* base; bf16_t* Xb; float* SS;
    __device__ __forceinline__ void operator()(const f32x4 (&acc)[2][2][4][2], const Unit& u, int wr, int wc, int fr, int fq) const {
        static_assert(!F32BASE, "the residual base is the bf16 stream");
        const int row0 = u.pm * BM + wr * 64 + fr, col0 = u.pn * BM + wc * 32 + 8 * fq;
        u32x4 bva[2][4][2];
#pragma unroll
        for (int ai = 0; ai < 2; ++ai)
#pragma unroll
            for (int m = 0; m < 4; ++m)
#pragma unroll
                for (int bj = 0; bj < 2; ++bj) bva[ai][m][bj] = *(const u32x4*)(Xb + (size_t)(row0 + ai * HALF + m * 16) * DM + col0 + bj * HALF);
        asm volatile("" :: "v"(bva[0][0][0]), "v"(bva[0][1][0]), "v"(bva[0][2][0]), "v"(bva[0][3][0]), "v"(bva[1][0][0]), "v"(bva[1][1][0]), "v"(bva[1][2][0]), "v"(bva[1][3][0]), "v"(bva[0][0][1]), "v"(bva[0][1][1]), "v"(bva[0][2][1]), "v"(bva[0][3][1]), "v"(bva[1][0][1]), "v"(bva[1][1][1]), "v"(bva[1][2][1]), "v"(bva[1][3][1]));
#pragma unroll
        for (int ai = 0; ai < 2; ++ai) {
#pragma unroll
            for (int m = 0; m < 4; ++m) { const int row = row0 + ai * HALF + m * 16; float ss = 0.f;
#pragma unroll
                for (int bj = 0; bj < 2; ++bj) { const size_t off = (size_t)row * DM + col0 + bj * HALF; const u32x4 b = bva[ai][m][bj];
                    f32x4 x0 = (f32x4){__builtin_bit_cast(float, b.x << 16), __builtin_bit_cast(float, b.x & 0xffff0000u), __builtin_bit_cast(float, b.y << 16), __builtin_bit_cast(float, b.y & 0xffff0000u)};
                    f32x4 x1 = (f32x4){__builtin_bit_cast(float, b.z << 16), __builtin_bit_cast(float, b.z & 0xffff0000u), __builtin_bit_cast(float, b.w << 16), __builtin_bit_cast(float, b.w & 0xffff0000u)};
                    x0 += acc[ai][bj][m][0]; x1 += acc[ai][bj][m][1];
                    ss += (x0[0] * x0[0] + x0[1] * x0[1]) + (x0[2] * x0[2] + x0[3] * x0[3]) + (x1[0] * x1[0] + x1[1] * x1[1]) + (x1[2] * x1[2] + x1[3] * x1[3]);
                    *(u32x4*)(Xb + off) = pack8(x0, x1); }
                ss = sum_fq(ss);
                if (fq == 0) SS[(size_t)row * 16 + u.pn * 4 + wc] = ss; }
        }
    }
};
__device__ __forceinline__ void row_rstd8(const float* SS, int row0, int fq, float (&rs)[2][4]) {
#pragma unroll
    for (int ai = 0; ai < 2; ++ai)
#pragma unroll
        for (int m = 0; m < 4; ++m) { const f32x4 t = *(const f32x4*)(SS + (size_t)(row0 + ai * HALF + m * 16) * 16 + 4 * fq); rs[ai][m] = (t[0] + t[1]) + (t[2] + t[3]); }
#pragma unroll
    for (int ai = 0; ai < 2; ++ai)
#pragma unroll
        for (int m = 0; m < 4; ++m) { float v = sum_fq(rs[ai][m]); rs[ai][m] = rsqrtf(v * (1.f / DM) + EPS); }
}
struct EpiGU {
    static constexpr bool PERM = true, AFTER_DRAIN = false;
    bf16_t* HM; const float* SS; const PG8_LAS float* rtab; int rtab_pm;
    __device__ __forceinline__ void operator()(const f32x4 (&acc)[2][2][4][2], const Unit& u, int wr, int wc, int fr, int fq) const {
        const int row0 = u.pm * BM + wr * 64 + fr, col0 = u.pn * HALF + wc * 32 + 8 * fq;
        float rs[2][4];
        if (u.pm == rtab_pm) {
#pragma unroll
            for (int ai = 0; ai < 2; ++ai)
#pragma unroll
                for (int m = 0; m < 4; ++m) rs[ai][m] = rtab[wr * 64 + fr + ai * HALF + m * 16];
        } else row_rstd8(SS, row0, fq, rs);
#pragma unroll
        for (int ai = 0; ai < 2; ++ai)
#pragma unroll
            for (int m = 0; m < 4; ++m) { const int row = row0 + ai * HALF + m * 16; const float r = rs[ai][m]; f32x4 v[2];
                const float r2 = -LOG2E * r, ir2 = __builtin_amdgcn_rcpf(r * r);
#pragma unroll
                for (int n = 0; n < 2; ++n) { const f32x4 gt = acc[ai][0][m][n], up = acc[ai][1][m][n];
                    const f32x4 t = gt * r2, gu = gt * up; f32x4 ex = (f32x4){__builtin_amdgcn_exp2f(t[0]), __builtin_amdgcn_exp2f(t[1]), __builtin_amdgcn_exp2f(t[2]), __builtin_amdgcn_exp2f(t[3])};
                    const f32x4 den = ex * ir2 + ir2; const f32x4 rc = (f32x4){__builtin_amdgcn_rcpf(den[0]), __builtin_amdgcn_rcpf(den[1]), __builtin_amdgcn_rcpf(den[2]), __builtin_amdgcn_rcpf(den[3])};
                    v[n] = gu * rc; }
                *(u32x4*)(HM + (size_t)row * FF + col0) = pack8(v[0], v[1]); }
    }
};
struct EpiPG {
    static constexpr bool PERM = true, AFTER_DRAIN = false;
    float* out; const bf16_t* Xb; const bf16_t* PR; const float* SS; const PG8_LAS float* rtab; int rtab_pm;
    __device__ __forceinline__ void operator()(const f32x4 (&acc)[2][2][4][2], const Unit& u, int wr, int wc, int fr, int fq) const {
        const int row0 = u.pm * BM + wr * 64 + fr, col0 = u.pn * BM + wc * 32 + 8 * fq;
        float rs[2][4];
        if (u.pm == rtab_pm) {
#pragma unroll
            for (int ai = 0; ai < 2; ++ai)
#pragma unroll
                for (int m = 0; m < 4; ++m) rs[ai][m] = rtab[wr * 64 + fr + ai * HALF + m * 16];
        } else row_rstd8(SS, row0, fq, rs);
#pragma unroll
        for (int ai = 0; ai < 2; ++ai) {
            u32x4 prv[4][2], xbv[4][2];
#pragma unroll
            for (int m = 0; m < 4; ++m)
#pragma unroll
                for (int bj = 0; bj < 2; ++bj) { const size_t off = (size_t)(row0 + ai * HALF + m * 16) * DM + col0 + bj * HALF; prv[m][bj] = *(const u32x4*)(PR + off); xbv[m][bj] = *(const u32x4*)(Xb + off); }
#pragma unroll
            for (int m = 0; m < 4; ++m) { const int row = row0 + ai * HALF + m * 16; const float r = rs[ai][m];
#pragma unroll
                for (int bj = 0; bj < 2; ++bj) { const size_t off = (size_t)row * DM + col0 + bj * HALF;
                    const u32x4 pr = prv[m][bj], xb = xbv[m][bj];
                    const float rl = -LOG2E * r;
                    const f32x4 t0 = acc[ai][bj][m][0] * rl, t1 = acc[ai][bj][m][1] * rl;
                    const f32x4 d0 = (f32x4){__builtin_amdgcn_exp2f(t0[0]), __builtin_amdgcn_exp2f(t0[1]), __builtin_amdgcn_exp2f(t0[2]), __builtin_amdgcn_exp2f(t0[3])} + 1.f;
                    const f32x4 d1 = (f32x4){__builtin_amdgcn_exp2f(t1[0]), __builtin_amdgcn_exp2f(t1[1]), __builtin_amdgcn_exp2f(t1[2]), __builtin_amdgcn_exp2f(t1[3])} + 1.f;
                    const f32x4 s0 = (f32x4){__builtin_amdgcn_rcpf(d0[0]), __builtin_amdgcn_rcpf(d0[1]), __builtin_amdgcn_rcpf(d0[2]), __builtin_amdgcn_rcpf(d0[3])}, s1 = (f32x4){__builtin_amdgcn_rcpf(d1[0]), __builtin_amdgcn_rcpf(d1[1]), __builtin_amdgcn_rcpf(d1[2]), __builtin_amdgcn_rcpf(d1[3])};
                    const f32x4 x0 = (f32x4){__builtin_bit_cast(float, xb.x << 16), __builtin_bit_cast(float, xb.x & 0xffff0000u), __builtin_bit_cast(float, xb.y << 16), __builtin_bit_cast(float, xb.y & 0xffff0000u)};
                    const f32x4 x1 = (f32x4){__builtin_bit_cast(float, xb.z << 16), __builtin_bit_cast(float, xb.z & 0xffff0000u), __builtin_bit_cast(float, xb.w << 16), __builtin_bit_cast(float, xb.w & 0xffff0000u)};
                    const f32x4 p0 = (f32x4){__builtin_bit_cast(float, pr.x << 16), __builtin_bit_cast(float, pr.x & 0xffff0000u), __builtin_bit_cast(float, pr.y << 16), __builtin_bit_cast(float, pr.y & 0xffff0000u)};
                    const f32x4 p1 = (f32x4){__builtin_bit_cast(float, pr.z << 16), __builtin_bit_cast(float, pr.z & 0xffff0000u), __builtin_bit_cast(float, pr.w << 16), __builtin_bit_cast(float, pr.w & 0xffff0000u)};
                    const f32x4 o0 = s0 * p0 + x0, o1 = s1 * p1 + x1;
                    __builtin_nontemporal_store(o0, (f32x4*)(out + off)); __builtin_nontemporal_store(o1, (f32x4*)(out + off + 4)); } }
        }
    }
};
struct HelperOrder {
    int G, c;
    __device__ __forceinline__ bool next(int i, Unit& u) const {
        const int h0 = G >> 1; if (c < h0) return false;
        if ((G & 15) == 0) {
            const int x = c & 7, rank = c >> 3, nr = G >> 3, r0 = nr >> 1, lu = (rank - r0) + (nr - r0) * i; if (lu >= 32) return false; u.pm = 8 * x + (lu >> 2); u.pn = lu & 3; return true; }
        const int L = (c - h0) + (G - h0) * i; if (L >= 256) return false; u.pm = L >> 2; u.pn = L & 3; return true; }
    __device__ __forceinline__ void a_ready(const Unit&) const {}
    __device__ __forceinline__ void done(const Unit&) const {}
};

template <class Epi, class Sched, bool ALIGN_EPI = false, bool SP2 = false>
__device__ __forceinline__ void gemm_phase(PG8_LAS unsigned char* lds, const Gemm g, const Sched& S, const Epi& E) {
    const int tid = threadIdx.x, wid = __builtin_amdgcn_readfirstlane(tid >> 6), lane = tid & 63, wr = wid >> 2, wc = wid & 3, fr = lane & 15, fq = lane >> 4;
    const int K = g.K, nt = K / BK;
    unsigned voffA[2], voffB[2];
#pragma unroll
    for (int i = 0; i < 2; ++i) { int R, C; stage_rc(tid * 16 + i * 8192, R, C); const int Rb = Epi::PERM ? ((R & ~31) + perm32(R & 31)) : R;
        voffA[i] = (unsigned)(R * K + C) * 2u; voffB[i] = (unsigned)(Rb * K + C) * 2u; }
    const size_t kstep = (size_t)(BK * 2);
    const size_t hstep = (size_t)HALF * K * 2;
    const size_t tstep = 2 * hstep;
    const unsigned ldsw = (unsigned)wid * 1024u;
    const int aoff = lds_byte(wr * 64 + fr, fq * 8), boff = lds_byte(wc * 32 + fr, fq * 8);
#define PG8_SA(b, h) (((b) * 2 + (h)) * HTB)
#define PG8_SB(b, h) ((4 + (b) * 2 + (h)) * HTB)
#define PG8_STAGE(bufoff, gbase, voff) do { _Pragma("unroll") for (int _i = 0; _i < 2; ++_i) \
        __builtin_amdgcn_global_load_lds((const unsigned*)((const char*)(gbase) + (voff)[_i]), (PG8_LAS unsigned*)(lds + (bufoff) + ldsw + _i * 8192), 16, 0, 0); } while (0)
#define PG8_LDA(dst, b, h) do { _Pragma("unroll") for (int m = 0; m < 4; ++m) _Pragma("unroll") for (int k = 0; k < 2; ++k) dst[m][k] = *(const PG8_LAS bf16x8*)(lds + PG8_SA(b, h) + aoff + m * 2048 + k * 1024); } while (0)
#define PG8_LDB(dst, b, h) do { _Pragma("unroll") for (int n = 0; n < 2; ++n) _Pragma("unroll") for (int k = 0; k < 2; ++k) dst[n][k] = *(const PG8_LAS bf16x8*)(lds + PG8_SB(b, h) + boff + n * 2048 + k * 1024); } while (0)
#define PG8_MMA(ai, bj, At, Bt) do { __builtin_amdgcn_s_setprio(1); _Pragma("unroll") for (int m = 0; m < 4; ++m) _Pragma("unroll") for (int n = 0; n < 2; ++n) _Pragma("unroll") for (int k = 0; k < 2; ++k) \
        acc[ai][bj][m][n] = __builtin_amdgcn_mfma_f32_16x16x32_bf16(Bt[n][k], At[m][k], acc[ai][bj][m][n], 0, 0, 0); __builtin_amdgcn_s_setprio(0); } while (0)
#define PG8_WAIT_V(n) asm volatile("s_waitcnt vmcnt(" #n ")" ::: "memory")
#define PG8_WAIT_L(n) asm volatile("s_waitcnt lgkmcnt(" #n ")" ::: "memory")
#define PG8_BAR __builtin_amdgcn_s_barrier()
#define PG8_SCHED __builtin_amdgcn_sched_barrier(0)
    Unit cur, nxt; int ui = 0;
    if (!S.next(0, cur)) return;
    f32x4 acc[2][2][4][2];
#pragma unroll
    for (int a = 0; a < 2; ++a)
#pragma unroll
        for (int b = 0; b < 2; ++b)
#pragma unroll
            for (int m = 0; m < 4; ++m)
#pragma unroll
                for (int n = 0; n < 2; ++n) acc[a][b][m][n] = (f32x4){0.f, 0.f, 0.f, 0.f};
    bf16x8 At[4][2], B0[2][2], B1[2][2];
    const char* cA = (const char*)g.A + (size_t)cur.pm * tstep; const char* cB = (const char*)g.Bt + (size_t)cur.pn * tstep;
    S.a_ready(cur);
    if constexpr (SP2) {
        PG8_STAGE(PG8_SB(0, 0), cB, voffB); PG8_STAGE(PG8_SB(0, 1), cB + hstep, voffB); PG8_STAGE(PG8_SA(0, 0), cA, voffA); PG8_STAGE(PG8_SA(0, 1), cA + hstep, voffA);
        if (wr == 1) PG8_BAR;
        PG8_WAIT_V(2); PG8_BAR;
        PG8_STAGE(PG8_SB(1, 0), cB + kstep, voffB); PG8_STAGE(PG8_SA(1, 0), cA + kstep, voffA); PG8_STAGE(PG8_SB(1, 1), cB + hstep + kstep, voffB);
        PG8_WAIT_V(6); PG8_BAR;
    } else {
        PG8_STAGE(PG8_SB(0, 0), cB, voffB); PG8_STAGE(PG8_SA(0, 0), cA, voffA); PG8_STAGE(PG8_SB(0, 1), cB + hstep, voffB); PG8_STAGE(PG8_SA(0, 1), cA + hstep, voffA);
        if (wr == 1) PG8_BAR;
        PG8_WAIT_V(4); PG8_BAR;
        PG8_STAGE(PG8_SB(1, 0), cB + kstep, voffB); PG8_STAGE(PG8_SA(1, 0), cA + kstep, voffA); PG8_STAGE(PG8_SB(1, 1), cB + hstep + kstep, voffB);
        PG8_WAIT_V(6); PG8_BAR;
    }
    for (;;) {
        const bool has_next = S.next(ui + 1, nxt);
        const char* nA = has_next ? (const char*)g.A + (size_t)nxt.pm * tstep : cA; const char* nB = has_next ? (const char*)g.Bt + (size_t)nxt.pn * tstep : cB;
        for (int t = 0; t < nt; t += 2) {
            const bool last = (t == nt - 2);
            const char* a1 = cA + (size_t)(t + 1) * kstep;
            const char* a2 = last ? nA : cA + (size_t)(t + 2) * kstep; const char* b2 = last ? nB : cB + (size_t)(t + 2) * kstep;
            const char* a3 = a2 + kstep; const char* b3 = b2 + kstep;
            if (last && has_next) S.a_ready(nxt);
            if constexpr (SP2) {
            PG8_LDB(B0, 0, 0); PG8_LDB(B1, 0, 1); PG8_SCHED; PG8_LDA(At, 0, 0); PG8_STAGE(PG8_SA(1, 1), a1 + hstep, voffA);
            PG8_WAIT_V(8); PG8_WAIT_L(0); PG8_BAR; PG8_MMA(0, 0, At, B0); PG8_MMA(0, 1, At, B1); PG8_BAR; PG8_SCHED;
            PG8_LDA(At, 0, 1); PG8_STAGE(PG8_SB(0, 0), b2, voffB); PG8_STAGE(PG8_SB(0, 1), b2 + hstep, voffB); PG8_STAGE(PG8_SA(0, 0), a2, voffA);
            PG8_WAIT_V(8); PG8_WAIT_L(0); PG8_BAR; PG8_MMA(1, 0, At, B0); PG8_MMA(1, 1, At, B1); PG8_BAR; PG8_SCHED;
            PG8_LDB(B0, 1, 0); PG8_LDB(B1, 1, 1); PG8_SCHED; PG8_LDA(At, 1, 0); PG8_STAGE(PG8_SA(0, 1), a2 + hstep, voffA);
            PG8_WAIT_V(8); PG8_WAIT_L(0); PG8_BAR; PG8_MMA(0, 0, At, B0); PG8_MMA(0, 1, At, B1); PG8_BAR; PG8_SCHED;
            PG8_LDA(At, 1, 1); PG8_STAGE(PG8_SB(1, 0), b3, voffB); PG8_STAGE(PG8_SB(1, 1), b3 + hstep, voffB); PG8_STAGE(PG8_SA(1, 0), a3, voffA);
            PG8_WAIT_V(8); PG8_WAIT_L(0); PG8_BAR; PG8_MMA(1, 0, At, B0); PG8_MMA(1, 1, At, B1); PG8_BAR; PG8_SCHED;
            } else {
            PG8_LDB(B0, 0, 0); PG8_SCHED; PG8_LDA(At, 0, 0); PG8_STAGE(PG8_SA(1, 1), a1 + hstep, voffA);
            PG8_WAIT_L(8); PG8_BAR; PG8_WAIT_L(0); PG8_MMA(0, 0, At, B0); PG8_BAR; PG8_SCHED;
            PG8_LDB(B1, 0, 1); PG8_STAGE(PG8_SB(0, 0), b2, voffB);
            PG8_BAR; PG8_WAIT_L(0); PG8_MMA(0, 1, At, B1); PG8_BAR;
            PG8_LDA(At, 0, 1); PG8_STAGE(PG8_SA(0, 0), a2, voffA);
            PG8_BAR; PG8_WAIT_L(0); PG8_MMA(1, 0, At, B0); PG8_BAR; PG8_SCHED;
            PG8_STAGE(PG8_SB(0, 1), b2 + hstep, voffB);
            PG8_WAIT_V(6); PG8_BAR; PG8_MMA(1, 1, At, B1); PG8_BAR;
            PG8_LDB(B0, 1, 0); PG8_SCHED; PG8_LDA(At, 1, 0); PG8_STAGE(PG8_SA(0, 1), a2 + hstep, voffA);
            PG8_WAIT_L(8); PG8_BAR; PG8_WAIT_L(0); PG8_MMA(0, 0, At, B0); PG8_BAR; PG8_SCHED;
            PG8_LDB(B1, 1, 1); PG8_STAGE(PG8_SB(1, 0), b3, voffB);
            PG8_BAR; PG8_WAIT_L(0); PG8_MMA(0, 1, At, B1); PG8_BAR;
            PG8_LDA(At, 1, 1); PG8_STAGE(PG8_SA(1, 0), a3, voffA);
            PG8_BAR; PG8_WAIT_L(0); PG8_MMA(1, 0, At, B0); PG8_BAR; PG8_SCHED;
            PG8_STAGE(PG8_SB(1, 1), b3 + hstep, voffB);
            PG8_WAIT_V(6); PG8_BAR; PG8_MMA(1, 1, At, B1); PG8_BAR;
            }
        }
        if constexpr (ALIGN_EPI) { if (wr == 0) PG8_BAR; }
        if constexpr (!Epi::AFTER_DRAIN) { E(acc, cur, wr, wc, fr, fq); S.done(cur); }
        if (!has_next) break;
#pragma unroll
        for (int a = 0; a < 2; ++a)
#pragma unroll
            for (int b = 0; b < 2; ++b)
#pragma unroll
                for (int m = 0; m < 4; ++m)
#pragma unroll
                    for (int n = 0; n < 2; ++n) acc[a][b][m][n] = (f32x4){0.f, 0.f, 0.f, 0.f};
        cur = nxt; cA = nA; cB = nB; ++ui;
        if constexpr (ALIGN_EPI) { if (wr == 1) PG8_BAR; }
    }
    PG8_WAIT_V(0);
    if constexpr (!ALIGN_EPI) { if (wr == 0) PG8_BAR; }
    PG8_BAR;
    if constexpr (Epi::AFTER_DRAIN) { E.fused(acc, cur, wr, wc, fr, fq, lds, wid, lane); S.done(cur); }
#undef PG8_SA
#undef PG8_SB
#undef PG8_STAGE
#undef PG8_LDA
#undef PG8_LDB
#undef PG8_MMA
#undef PG8_WAIT_V
#undef PG8_WAIT_L
#undef PG8_BAR
#undef PG8_SCHED
}
}

#ifndef PG8_SP2
#define PG8_SP2 true
#endif
#ifndef PG8_ALIGN
#define PG8_ALIGN true
#endif
#define GAS __attribute__((address_space(1)))
#define LAS __attribute__((address_space(3)))
typedef unsigned short bf16;
typedef unsigned v4u __attribute__((ext_vector_type(4)));
typedef float f32x4 __attribute__((ext_vector_type(4)));
typedef short bf16x8 __attribute__((ext_vector_type(8)));
typedef GAS unsigned gu32;
typedef GAS unsigned long long gu64;
#define RLX_AGENT __ATOMIC_RELAXED, __HIP_MEMORY_SCOPE_AGENT
#define LDS_WAIT() asm volatile("s_waitcnt lgkmcnt(0)" ::: "memory")
#define VM_WAIT() asm volatile("s_waitcnt vmcnt(0)" ::: "memory")
__device__ __forceinline__ unsigned long long rt() { return __builtin_amdgcn_s_memrealtime(); }
__device__ __forceinline__ unsigned f2bf(float f) { unsigned u = __builtin_bit_cast(unsigned, f); return (u + 0x7fffu + ((u >> 16) & 1u)) >> 16; }
__device__ __forceinline__ unsigned pk2(float lo, float hi) { return f2bf(lo) | (f2bf(hi) << 16); }

#define XB_TMO      128
#define XB_XCNT(j)  (256  + 64 * (j))
#define XB_XSUB(j)  (1280 + 64 * (j))
#define XB_XGEN(j)  (2304 + 64 * (j))
#define XB_TOP      3328
#define XB_TOPGEN   3392
#define XB_LSUB(j)  (3456 + 64 * (j))
#define XB_LGEN(j)  (4480 + 64 * (j))
#define XCD_BAR_WORDS 5504
#define XB_SPIN_CAP (1u << 18)

__device__ __forceinline__ unsigned xb_ld(unsigned* p)              { return __hip_atomic_load(p, __ATOMIC_RELAXED, __HIP_MEMORY_SCOPE_AGENT); }
__device__ __forceinline__ unsigned xb_add(unsigned* p, unsigned v) { return __hip_atomic_fetch_add(p, v, __ATOMIC_RELAXED, __HIP_MEMORY_SCOPE_AGENT); }
__device__ __forceinline__ unsigned xb_xcc_id() { return (unsigned)__builtin_amdgcn_s_getreg((3 << 11) | 20) & 0xFu; }
#define XB_SPIN(cond, bar) do { unsigned _sp = 0; while (cond) { __builtin_amdgcn_s_sleep(1); \
    if ((++_sp & 255u) == 0u) { if (xb_ld(&(bar)[XB_TMO])) break; if (_sp > XB_SPIN_CAP) { atomicAdd(&(bar)[XB_TMO], 1u); break; } } } } while (0)

struct XcdBarrier {
    unsigned* bar; unsigned x;
    volatile LAS unsigned* st;
};

__device__ __forceinline__ XcdBarrier xcd_barrier_post(unsigned* bar, volatile LAS unsigned* st) {
    XcdBarrier b; b.bar = bar; b.x = xb_xcc_id(); b.st = st;
    if (threadIdx.x == 0) st[2] = xb_add(&bar[XB_XCNT(b.x)], 1u);
    return b;
}
__device__ __forceinline__ void xcd_barrier_complete(unsigned* bar, unsigned x, unsigned& nloc, unsigned& nx, unsigned& uniform) {
    const unsigned G = gridDim.x * gridDim.y * gridDim.z;
    unsigned sum, cnt, mine, odd, sp = 0u;
    for (;;) {
        sum = 0u; cnt = 0u; mine = 0u; odd = 0u;
#pragma unroll
        for (unsigned j = 0; j < 16; ++j) { const unsigned c = xb_ld(&bar[XB_XCNT(j)]); sum += c; cnt += (c > 0u) ? 1u : 0u; mine = (j == x) ? c : mine; odd |= (j < 8u) ? (c * 8u != G ? 1u : 0u) : (c != 0u ? 1u : 0u); }
        if (sum == G) { uniform = odd ? 0u : 1u; break; }
        __builtin_amdgcn_s_sleep(1);
        if ((++sp & 255u) == 0u) { if (xb_ld(&bar[XB_TMO])) { uniform = 0u; break; } if (sp > XB_SPIN_CAP) { atomicAdd(&bar[XB_TMO], 1u); uniform = 0u; break; } }
    }
    nloc = mine > 0u ? mine : 1u; nx = cnt > 0u ? cnt : 1u;
}

__device__ __forceinline__ void xcd_barrier(const XcdBarrier& b) {
    asm volatile("s_waitcnt vmcnt(0)" ::: "memory");
    __syncthreads();
    if (threadIdx.x == 0) {
        unsigned* bar = b.bar;
        __builtin_amdgcn_s_waitcnt(0);
        unsigned nloc = b.st[0], nx = b.st[1];
        if (nloc == 0u) { unsigned uni = 0u; xcd_barrier_complete(bar, b.x, nloc, nx, uni); b.st[0] = nloc; b.st[1] = nx; b.st[3] = uni; }
        const unsigned old = xb_add(&bar[XB_XSUB(b.x)], 1u);
        const unsigned gen = old / nloc;
        if (old + 1u == (gen + 1u) * nloc) {
            __builtin_amdgcn_fence(__ATOMIC_RELEASE, "agent");
            asm volatile("s_waitcnt vmcnt(0)" ::: "memory");
            const unsigned og = xb_add(&bar[XB_TOP], 1u);
            const unsigned tg = og / nx;
            if (og + 1u == (tg + 1u) * nx) xb_add(&bar[XB_TOPGEN], 1u);
            else XB_SPIN(xb_ld(&bar[XB_TOPGEN]) == tg, bar);
            __builtin_amdgcn_fence(__ATOMIC_ACQUIRE, "agent");
            xb_add(&bar[XB_XGEN(b.x)], 1u);
            asm volatile("s_waitcnt vmcnt(0)" ::: "memory");
        } else {
            XB_SPIN(xb_ld(&bar[XB_XGEN(b.x)]) == gen, bar);
            __builtin_amdgcn_fence(__ATOMIC_ACQUIRE, "agent");
            asm volatile("s_waitcnt vmcnt(0)" ::: "memory");
        }
    }
    __syncthreads();
}

__device__ __forceinline__ void xcd_local_barrier(const XcdBarrier& b) {
    asm volatile("s_waitcnt vmcnt(0)" ::: "memory");
    __syncthreads();
    if (threadIdx.x == 0) {
        unsigned* bar = b.bar;
        __builtin_amdgcn_s_waitcnt(0);
        const unsigned nloc = b.st[0];
        const unsigned old = xb_add(&bar[XB_LSUB(b.x)], 1u);
        const unsigned gen = old / nloc;
        if (old + 1u == (gen + 1u) * nloc) (void)xb_add(&bar[XB_LGEN(b.x)], 1u);
        else XB_SPIN(xb_ld(&bar[XB_LGEN(b.x)]) == gen, bar);
        __builtin_amdgcn_fence(__ATOMIC_ACQUIRE, "agent");
        asm volatile("s_waitcnt vmcnt(0)" ::: "memory");
    }
    __syncthreads();
}


constexpr size_t MiB = 1u << 20;
constexpr size_t WS_CTL = 0, CTL_ZERO_BYTES = 1 * MiB;
constexpr size_t WS_WIN = 2 * MiB, WS_WOUT = 7 * MiB, WS_WGU = 9 * MiB, WS_WDN = 20 * MiB, WS_WPG = 26 * MiB, WS_WPP = 28 * MiB;
constexpr size_t WS_SS0 = 28 * MiB + 512 * 1024  , WS_SS1 = 29 * MiB, WS_SS2 = 30 * MiB;
constexpr size_t WS_CW16 = 31 * MiB;
constexpr size_t WS_XN = 32 * MiB;
constexpr size_t WS_Q = 64 * MiB, WS_KIMG = 80 * MiB, WS_VIMG = 96 * MiB, WS_U = 112 * MiB, WS_SLAB = 128 * MiB;
constexpr size_t WS_HM = 64 * MiB;
constexpr size_t WS_PB = 184 * MiB, WS_PROJ = 192 * MiB, WS_MIX = 224 * MiB, WS_END = 256 * MiB;
static_assert(WS_HM + (size_t)M * FF * 2 <= WS_PB && WS_SLAB + 56 * MiB <= WS_PB, "HM overlay");
constexpr int CW_TMO = 0, CW_CODE = 1, CW_QMAX = 32, CW_KMAX = 33, CW_KBAR = 34  , CW_QUEUE = 64, CW_UCNT = 1024  , CW_BAR = 4096;
constexpr int MAX_SPLIT_UNITS = 144;

constexpr int RING_OFF = 0, RING_BYTES = 131072;
constexpr int LDSCTL_OFF = RING_BYTES, MISC_OFF = LDSCTL_OFF + 320;
constexpr int LDS_BYTES = 147456;
constexpr int NWAVES = 8;

__device__ __forceinline__ float wave_sum(float v) {
#pragma unroll
    for (int o = 1; o < 64; o <<= 1) v += __shfl_xor(v, o);
    return v;
}
__device__ __forceinline__ float wave_max(float v) {
#pragma unroll
    for (int o = 1; o < 64; o <<= 1) v = fmaxf(v, __shfl_xor(v, o));
    return v;
}
__device__ __forceinline__ float bflo(unsigned w) { return __builtin_bit_cast(float, w << 16); }
__device__ __forceinline__ float bfhi(unsigned w) { return __builtin_bit_cast(float, w & 0xffff0000u); }

__device__ __forceinline__ void transpose_item(const float* W, int ldw, int K, bf16* WT, int k0, int n0, int dst0, LAS float* scr, int lane, const float* rowgain = nullptr) {
    float v[32];
#pragma unroll
    for (int i = 0; i < 32; ++i) { const int kk = 2 * i + (lane >> 5); v[i] = __builtin_nontemporal_load(&W[(size_t)(k0 + kk) * ldw + n0 + (lane & 31)]); }
    if (rowgain) {
#pragma unroll
        for (int i = 0; i < 32; ++i) v[i] *= rowgain[k0 + 2 * i + (lane >> 5)]; }
#pragma unroll
    for (int i = 0; i < 32; ++i) scr[(2 * i + (lane >> 5)) * 33 + (lane & 31)] = v[i];
    LDS_WAIT(); asm volatile("" ::: "memory");
    const int c = lane & 7;
#pragma unroll
    for (int j = 0; j < 4; ++j) { const int n = (lane >> 3) + 8 * j; const LAS float* s = scr + (8 * c) * 33 + n;
        v4u o; o.x = pk2(s[0 * 33], s[1 * 33]); o.y = pk2(s[2 * 33], s[3 * 33]); o.z = pk2(s[4 * 33], s[5 * 33]); o.w = pk2(s[6 * 33], s[7 * 33]);
        *(GAS v4u*)(WT + (size_t)(dst0 + n) * K + k0 + 8 * c) = o; }
    LDS_WAIT(); asm volatile("" ::: "memory");
}
__device__ __forceinline__ int in_dst_row(int s) {
    if (s < 1024) { const int part = s >> 9, sp = s & 511, tp = sp >> 8, sl = sp & 255, wc = sl >> 6, bj = (sl >> 5) & 1; return (part * 2 + tp) * 256 + 128 * bj + 32 * wc; }
    if (s < 1536) return s;
    if (s < 2048) { const int ch = s - 1536; return 1536 + 256 * (ch >> 7) + (ch & 127); }
    const int ch = s - 2048; return 1536 + 256 * (ch >> 7) + 128 + (ch & 127);
}
struct Args { const float* in[23]; float* out; unsigned char* ws; int ph_lo, ph_hi, li, pad; };

__device__ __forceinline__ void p0_prologue(const Args& a, LAS unsigned char* lds, int vcu, int G, int wave, int lane) {
    LAS float* scr = (LAS float*)(lds + RING_OFF + wave * 16384);
    const int gw = vcu * NWAVES + wave, NGW = G * NWAVES;
    unsigned char* ws = a.ws;
    constexpr int I_IN = 16 * 80, I_PP = 4 * 32;
    for (int it = gw; it < I_IN + I_PP; it += NGW) {
        if (it < I_IN) { const int kb = it / 80, nb = it % 80; transpose_item(a.in[3], NIN, DM, (bf16*)(ws + WS_WIN), 64 * kb, 32 * nb, in_dst_row(32 * nb), scr, lane, a.in[2]); }
        else { const int r = it - I_IN, kb = r / 32, nb = r % 32; transpose_item(a.in[22], DM, PD, (bf16*)(ws + WS_WPP), 64 * kb, 32 * nb, 32 * nb, scr, lane); }
    }
    for (int i = gw * 64 + lane; i < KC * 64; i += NGW * 64) {
        const f32x4 w0 = *(const f32x4*)(a.in[11] + 8 * i), w1 = *(const f32x4*)(a.in[11] + 8 * i + 4); v4u o;
        o.x = __builtin_bit_cast(unsigned, __builtin_amdgcn_cvt_pkrtz(w0.x, w0.y)); o.y = __builtin_bit_cast(unsigned, __builtin_amdgcn_cvt_pkrtz(w0.z, w0.w));
        o.z = __builtin_bit_cast(unsigned, __builtin_amdgcn_cvt_pkrtz(w1.x, w1.y)); o.w = __builtin_bit_cast(unsigned, __builtin_amdgcn_cvt_pkrtz(w1.z, w1.w));
        *(GAS v4u*)(ws + WS_CW16 + (size_t)i * 16) = o; }
    const float* x = a.in[0]; const float* p = a.in[1];
    bf16* XN = (bf16*)(ws + WS_XN); bf16* PB = (bf16*)(ws + WS_PB); float* SS0 = (float*)(ws + WS_SS0);
    for (int m = gw; m < M; m += NGW) {
        const GAS f32x4* xr = (const GAS f32x4*)(x + (size_t)m * DM) + lane;
        f32x4 v[4]; float s = 0.f;
#pragma unroll
        for (int j = 0; j < 4; ++j) { v[j] = __builtin_nontemporal_load(&xr[64 * j]); s += (v[j].x * v[j].x + v[j].y * v[j].y) + (v[j].z * v[j].z + v[j].w * v[j].w); }
        GAS unsigned long long* o8 = (GAS unsigned long long*)(XN + (size_t)m * DM) + lane;
#pragma unroll
        for (int j = 0; j < 4; ++j) o8[64 * j] = (unsigned long long)pk2(v[j].x, v[j].y) | ((unsigned long long)pk2(v[j].z, v[j].w) << 32);
        const f32x4 pv = __builtin_nontemporal_load(&((const GAS f32x4*)(p + (size_t)m * PD))[lane]);
        ((GAS unsigned long long*)(PB + (size_t)m * PD))[lane] = (unsigned long long)pk2(pv.x, pv.y) | ((unsigned long long)pk2(pv.z, pv.w) << 32);
        s = wave_sum(s);
        if (lane == 0) SS0[m] = s;
    }
}
constexpr int WI_OUT = 16 * 32, WI_G = 16 * 88, WI_DN = 44 * 32, WI_PG = 16 * 32, W_ITEMS = WI_OUT + 2 * WI_G + WI_DN + WI_PG, N_W_UNITS = (W_ITEMS + 31) / 32;
__device__ __forceinline__ void weight_unit(int wu, const Args& a, LAS unsigned char* lds, int wave, int lane) {
    asm volatile("" : "+v"(lane));
    LAS float* scr = (LAS float*)(lds + RING_OFF + wave * 16384);
    unsigned char* ws = a.ws;
    for (int q = 0; q < 4; ++q) {
        int r = wu * 32 + wave * 4 + q; if (r >= W_ITEMS) break;
        if (r < WI_OUT) { const int kb = r / 32, nb = r % 32; transpose_item(a.in[15], DM, DM, (bf16*)(ws + WS_WOUT), 64 * kb, 32 * nb, 32 * nb, scr, lane); continue; } r -= WI_OUT;
        if (r < WI_G) { const int kb = r / 88, nb = r % 88, n0 = 32 * nb; transpose_item(a.in[17], FF, DM, (bf16*)(ws + WS_WGU), 64 * kb, n0, 256 * (n0 >> 7) + (n0 & 127), scr, lane, a.in[16]); continue; } r -= WI_G;
        if (r < WI_G) { const int kb = r / 88, nb = r % 88, n0 = 32 * nb; transpose_item(a.in[18], FF, DM, (bf16*)(ws + WS_WGU), 64 * kb, n0, 256 * (n0 >> 7) + 128 + (n0 & 127), scr, lane, a.in[16]); continue; } r -= WI_G;
        if (r < WI_DN) { const int kb = r / 32, nb = r % 32; transpose_item(a.in[19], DM, FF, (bf16*)(ws + WS_WDN), 64 * kb, 32 * nb, 32 * nb, scr, lane); continue; } r -= WI_DN;
        { const int kb = r / 32, nb = r % 32; transpose_item(a.in[21], DM, DM, (bf16*)(ws + WS_WPG), 64 * kb, 32 * nb, 32 * nb, scr, lane, a.in[20]); }
    }
    __syncthreads();
}

constexpr int CONV_ROWS = 32, CONV_RW = CONV_ROWS / NWAVES  , CONV_STAGE = CONV_ROWS + KC - 1  , CONV_W_LDS = 64 * 1024;
static_assert(CONV_RW == 4 && CONV_STAGE * 1024 <= CONV_W_LDS && CONV_W_LDS + KC * 1024 <= RING_BYTES, "conv unit LDS layout");
__device__ __forceinline__ void conv_unit(int cu, const bf16* U, const unsigned char* cw16, const float* cb, const float* lg, const float* lb, bf16* MIX, LAS unsigned char* lds, int tid, int wave, int lane, bool& w_staged) {
    asm volatile("" : "+v"(tid), "+v"(lane));
    const int r0 = cu * CONV_ROWS;
    const f32x4 b0 = *(const f32x4*)(cb + 8 * lane), b1 = *(const f32x4*)(cb + 8 * lane + 4);
    const f32x4 g0 = *(const f32x4*)(lg + 8 * lane), g1 = *(const f32x4*)(lg + 8 * lane + 4), c0 = *(const f32x4*)(lb + 8 * lane), c1 = *(const f32x4*)(lb + 8 * lane + 4);
    v4u wv[4] = {}; v4u uv[8];
    if (!w_staged) {
#pragma unroll
        for (int k = 0; k < 4; ++k) { const int i = tid + 512 * k; wv[k] = *(const GAS v4u*)(cw16 + (size_t)(i < KC * 64 ? i : 0) * 16); } }
#pragma unroll
    for (int k = 0; k < 8; ++k) { const int i = tid + 512 * k, rr = i >> 6, pc = i & 63, r = r0 - 15 + rr, rc = r < 0 ? 0 : (r > M - 1 ? M - 1 : r);
        uv[k] = *(const GAS v4u*)(U + (size_t)rc * CW + pc * 8); }
    if (!w_staged) {
#pragma unroll
        for (int k = 0; k < 4; ++k) { const int i = tid + 512 * k; if (i < KC * 64) *(LAS v4u*)(lds + CONV_W_LDS + i * 16) = wv[k]; }
        w_staged = true; }
#pragma unroll
    for (int k = 0; k < 8; ++k) { const int i = tid + 512 * k, rr = i >> 6, pc = i & 63, r = r0 - 15 + rr; const bool in = r >= 0 && r < M;
        v4u v = uv[k]; v.x = in ? v.x : 0u; v.y = in ? v.y : 0u; v.z = in ? v.z : 0u; v.w = in ? v.w : 0u;
        if (i < CONV_STAGE * 64) *(LAS v4u*)(lds + rr * 1024 + pc * 16) = v; }
    __syncthreads();
    typedef _Float16 h2 __attribute__((ext_vector_type(2)));
    h2 hacc[CONV_RW][4];
    { const h2 i0 = __builtin_bit_cast(h2, __builtin_amdgcn_cvt_pkrtz(b0.x, b0.y)), i1 = __builtin_bit_cast(h2, __builtin_amdgcn_cvt_pkrtz(b0.z, b0.w)), i2 = __builtin_bit_cast(h2, __builtin_amdgcn_cvt_pkrtz(b1.x, b1.y)), i3 = __builtin_bit_cast(h2, __builtin_amdgcn_cvt_pkrtz(b1.z, b1.w));
#pragma unroll
      for (int j = 0; j < CONV_RW; ++j) { hacc[j][0] = i0; hacc[j][1] = i1; hacc[j][2] = i2; hacc[j][3] = i3; } }
    {
        typedef _Float16 h8 __attribute__((ext_vector_type(8)));
        const LAS unsigned char* ub = lds + (wave * CONV_RW) * 1024 + lane * 16; const LAS unsigned char* wb = lds + CONV_W_LDS + lane * 16;
        h8 uu[CONV_RW];
#pragma unroll
        for (int j = 0; j < CONV_RW - 1; ++j) uu[j] = *(const LAS h8*)(ub + j * 1024);
        h8 kw = *(const LAS h8*)(wb);
#pragma unroll
        for (int t = 0; t < KC; ++t) {
            uu[(t + CONV_RW - 1) & (CONV_RW - 1)] = *(const LAS h8*)(ub + (t + CONV_RW - 1) * 1024);
            const h8 kwn = *(const LAS h8*)(wb + (t + 1 < KC ? t + 1 : t) * 1024);
            const h2 k0 = __builtin_shufflevector(kw, kw, 0, 1), k1 = __builtin_shufflevector(kw, kw, 2, 3), k2 = __builtin_shufflevector(kw, kw, 4, 5), k3 = __builtin_shufflevector(kw, kw, 6, 7);
#pragma unroll
            for (int j = 0; j < CONV_RW; ++j) { const h8 u = uu[(t + j) & (CONV_RW - 1)];
                hacc[j][0] = __builtin_shufflevector(u, u, 0, 1) * k0 + hacc[j][0]; hacc[j][1] = __builtin_shufflevector(u, u, 2, 3) * k1 + hacc[j][1];
                hacc[j][2] = __builtin_shufflevector(u, u, 4, 5) * k2 + hacc[j][2]; hacc[j][3] = __builtin_shufflevector(u, u, 6, 7) * k3 + hacc[j][3]; }
            kw = kwn;
        }
    }
    float acc[CONV_RW][8];
#pragma unroll
    for (int j = 0; j < CONV_RW; ++j)
#pragma unroll
        for (int k = 0; k < 4; ++k) { acc[j][2 * k] = (float)hacc[j][k][0]; acc[j][2 * k + 1] = (float)hacc[j][k][1]; }
#pragma unroll
    for (int j = 0; j < CONV_RW; ++j) {
        float s = ((acc[j][0] + acc[j][1]) + (acc[j][2] + acc[j][3])) + ((acc[j][4] + acc[j][5]) + (acc[j][6] + acc[j][7]));
        const float mu = wave_sum(s) * (1.f / CW); float q = 0.f;
#pragma unroll
        for (int e = 0; e < 8; ++e) { acc[j][e] -= mu; q += acc[j][e] * acc[j][e]; }
        const float r = rsqrtf(wave_sum(q) * (1.f / CW) + EPS);
        float z[8];
        z[0] = acc[j][0] * r * g0.x + c0.x; z[1] = acc[j][1] * r * g0.y + c0.y; z[2] = acc[j][2] * r * g0.z + c0.z; z[3] = acc[j][3] * r * g0.w + c0.w;
        z[4] = acc[j][4] * r * g1.x + c1.x; z[5] = acc[j][5] * r * g1.y + c1.y; z[6] = acc[j][6] * r * g1.z + c1.z; z[7] = acc[j][7] * r * g1.w + c1.w;
#pragma unroll
        for (int e = 0; e < 8; ++e) z[e] = z[e] * fsigmoid(z[e]);
        v4u o; o.x = pk2(z[0], z[1]); o.y = pk2(z[2], z[3]); o.z = pk2(z[4], z[5]); o.w = pk2(z[6], z[7]);
        *(GAS v4u*)(MIX + (size_t)(r0 + wave * CONV_RW + j) * DM + AW + 8 * lane) = o;
    }
    __syncthreads();
}

namespace att {
typedef short bf16x8 __attribute__((ext_vector_type(8)));
typedef short s16x4 __attribute__((ext_vector_type(4)));
typedef float f32x16 __attribute__((ext_vector_type(16)));
typedef float f32x4 __attribute__((ext_vector_type(4)));
typedef unsigned u32x4 __attribute__((ext_vector_type(4)));
constexpr int LDS_HN = 8 * 16384 + 13312;
constexpr int SLOT = 16384, LDS_K = 0, LDS_V = 4 * SLOT, LDS_WS = 8 * SLOT + 4096  , XSTRIDE = 132, SLAB_FLOATS = 8 * 4160;
typedef __attribute__((address_space(3))) const char* lds_cptr;
typedef short v4i16_t __attribute__((ext_vector_type(4)));
__device__ __forceinline__ int crow(int r, int hi) { return (r & 3) + 8 * (r >> 2) + 4 * hi; }
__device__ __forceinline__ void glds2k(const unsigned char* sbase, unsigned voff, unsigned lds_dst) { unsigned keep; const unsigned lds_dst2 = lds_dst + 1024u, voff2 = voff + 1024u;
    asm volatile("s_mov_b32 %0, m0\n\ts_mov_b32 m0, %3\n\ts_nop 0\n\tglobal_load_lds_dwordx4 %1, %2\n\ts_nop 0\n\ts_mov_b32 m0, %4\n\ts_nop 0\n\tglobal_load_lds_dwordx4 %5, %2\n\ts_nop 0\n\ts_mov_b32 m0, %0"
                 : "=&s"(keep) : "v"(voff), "s"(sbase), "s"(lds_dst), "s"(lds_dst2), "v"(voff2) : "memory"); }
#define ATT_WAIT_BAR(N) asm volatile("s_waitcnt vmcnt(" #N ") lgkmcnt(0)\n\ts_barrier" ::: "memory")
__device__ __forceinline__ unsigned cvtpk(float lo, float hi) { unsigned r; asm volatile("v_cvt_pk_bf16_f32 %0, %1, %2" : "=v"(r) : "v"(lo), "v"(hi)); return r; }
__device__ __forceinline__ int v_rd_base(int lane) { return ((lane >> 4) & 1) * 32 + (lane & 3) * 8 + (4 * (lane >> 5) + ((lane & 15) >> 2)) * 64; }
__device__ __forceinline__ s16x4 vtr(lds_cptr p) { return __builtin_bit_cast(s16x4, __builtin_amdgcn_ds_read_tr16_b64_v4i16((__attribute__((address_space(3))) v4i16_t*)p)); }
#define SBAR() __builtin_amdgcn_sched_barrier(0)
__device__ __forceinline__ void qkt_acc(f32x16& p0, f32x16& p1, lds_cptr kp, const bf16x8* qr) {
#pragma unroll
    for (int d0 = 0; d0 < 4; ++d0) {
        const bf16x8 b0 = *(const __attribute__((address_space(3))) bf16x8*)(kp + d0 * 2048);
        const bf16x8 b1 = *(const __attribute__((address_space(3))) bf16x8*)(kp + d0 * 2048 + 512);
        p0 = __builtin_amdgcn_mfma_f32_32x32x16_bf16(b0, qr[d0], p0, 0, 0, 0);
        p1 = __builtin_amdgcn_mfma_f32_32x32x16_bf16(b1, qr[d0], p1, 0, 0, 0);
    }
}
__device__ __forceinline__ void bias_general(f32x16& p0, f32x16& p1, float dq, float nslope2, float shift2) {
#pragma unroll
    for (int r = 0; r < 16; ++r) { const float c = (float)((r & 3) + 8 * (r >> 2)); p0[r] = __builtin_fmaf(nslope2, __builtin_fabsf(dq - c), -shift2); p1[r] = __builtin_fmaf(nslope2, __builtin_fabsf(dq - (c + 32.f)), -shift2); }
}
__device__ __forceinline__ void softmax_first(f32x16& p0, f32x16& p1, bf16x8& pa0, bf16x8& pa1, bf16x8& pa2) {
#pragma unroll
    for (int r = 0; r < 16; ++r) { p0[r] = __builtin_amdgcn_exp2f(p0[r]); p1[r] = __builtin_amdgcn_exp2f(p1[r]); }
    { u32x4 w = {cvtpk(p0[0], p0[1]), cvtpk(p0[2], p0[3]), cvtpk(p0[4], p0[5]), cvtpk(p0[6], p0[7])}; pa0 = __builtin_bit_cast(bf16x8, w); }
    { u32x4 w = {cvtpk(p0[8], p0[9]), cvtpk(p0[10], p0[11]), cvtpk(p0[12], p0[13]), cvtpk(p0[14], p0[15])}; pa1 = __builtin_bit_cast(bf16x8, w); }
    { u32x4 w = {cvtpk(p1[0], p1[1]), cvtpk(p1[2], p1[3]), cvtpk(p1[4], p1[5]), cvtpk(p1[6], p1[7])}; pa2 = __builtin_bit_cast(bf16x8, w); }
}
template <int KBITS> __device__ __forceinline__ float fmamk_s(float a, float c) { float r; asm("v_fmamk_f32 %0, %1, %2, %3" : "=v"(r) : "v"(a), "n"(KBITS), "v"(c)); return r; }
#define ATT_ROT3(x) do { (x) = ((x) + SLOT) & (4 * SLOT - 1); } while (0)
#define ATT_DMA2(src, tile, dstoff) do { int t_ = (tile); t_ = t_ < t_hi ? t_ : t_hi; glds2k((src) + (size_t)t_ * SLOT, lane16, (unsigned)(dstoff)); } while (0)
#define ATT_ISSUE_DMA() do { ATT_DMA2(ksrc, tj + 4, kdst + sk_dma); ATT_DMA2(vsrc, tj + 2, vdst + sv_dma); ++tj; } while (0)
#define ATT_STEP(P0, P1, X0, X1, DO_EXP, DO_QK, JJ) do { \
    if (lead_half || (JJ) == 0) { ATT_WAIT_BAR(4); } \
    ATT_ISSUE_DMA(); \
    { const lds_cptr vb_ = vp0 + sv_cur; const lds_cptr kb_ = kp0 + sk_cur; \
      s16x4 vl0, vh0, vl1, vh1, vl2, vh2; bf16x8 kf0, kf1, kf2; unsigned t0_, t1_, t2_, t3_; \
      const int k02_ = (tj + 1) * 64  ; const bool right_ = k02_ >= qw0 + 31, mixed_ = !right_ && (k02_ + 63 > qw0); \
      const float dq2_ = dq1 - 64.f, ss_ = right_ ? nslope2 : -nslope2, xl0_ = __builtin_fmaf(-ss_, dq2_, -shift2), xl1_ = __builtin_fmaf(ss_, 32.f, xl0_); \
      vl0 = vtr(vb_ + 0); vh0 = vtr(vb_ + 512); vl1 = vtr(vb_ + 4096); vh1 = vtr(vb_ + 4608); SBAR(); \
      vl2 = vtr(vb_ + 8192); vh2 = vtr(vb_ + 8704); o[0] = __builtin_amdgcn_mfma_f32_32x32x16_bf16(pa0, (bf16x8){vl0[0], vl0[1], vl0[2], vl0[3], vh0[0], vh0[1], vh0[2], vh0[3]}, o[0], 0, 0, 0); if (DO_EXP) { X0[0] = __builtin_amdgcn_exp2f(X0[0]); } t0_ = cvtpk(P1[8], P1[9]); t1_ = cvtpk(P1[10], P1[11]); SBAR(); \
      vl0 = vtr(vb_ + 12288); vh0 = vtr(vb_ + 12800); o[1] = __builtin_amdgcn_mfma_f32_32x32x16_bf16(pa0, (bf16x8){vl1[0], vl1[1], vl1[2], vl1[3], vh1[0], vh1[1], vh1[2], vh1[3]}, o[1], 0, 0, 0); if (DO_EXP) { X0[1] = __builtin_amdgcn_exp2f(X0[1]); } t2_ = cvtpk(P1[12], P1[13]); t3_ = cvtpk(P1[14], P1[15]); { u32x4 w_ = {t0_, t1_, t2_, t3_}; pa3 = __builtin_bit_cast(bf16x8, w_); } SBAR(); \
      vl1 = vtr(vb_ + 1024); vh1 = vtr(vb_ + 1536); o[2] = __builtin_amdgcn_mfma_f32_32x32x16_bf16(pa0, (bf16x8){vl2[0], vl2[1], vl2[2], vl2[3], vh2[0], vh2[1], vh2[2], vh2[3]}, o[2], 0, 0, 0); if (DO_EXP) { X0[2] = __builtin_amdgcn_exp2f(X0[2]); } if (DO_EXP) { X0[3] = __builtin_amdgcn_exp2f(X0[3]); } SBAR(); \
      vl2 = vtr(vb_ + 5120); vh2 = vtr(vb_ + 5632); o[3] = __builtin_amdgcn_mfma_f32_32x32x16_bf16(pa0, (bf16x8){vl0[0], vl0[1], vl0[2], vl0[3], vh0[0], vh0[1], vh0[2], vh0[3]}, o[3], 0, 0, 0); lacc4 = __builtin_amdgcn_mfma_f32_16x16x32_bf16(lmask, pa0, lacc4, 0, 0, 0); if (DO_EXP) { X0[4] = __builtin_amdgcn_exp2f(X0[4]); } if (DO_QK) { P0[0] = fmamk_s<0>(ss_, xl0_); } if (DO_QK) { P0[1] = fmamk_s<1065353216>(ss_, xl0_); } if (DO_QK) { P0[2] = fmamk_s<1073741824>(ss_, xl0_); } SBAR(); \
      vl0 = vtr(vb_ + 9216); vh0 = vtr(vb_ + 9728); o[0] = __builtin_amdgcn_mfma_f32_32x32x16_bf16(pa1, (bf16x8){vl1[0], vl1[1], vl1[2], vl1[3], vh1[0], vh1[1], vh1[2], vh1[3]}, o[0], 0, 0, 0); if (DO_EXP) { X0[5] = __builtin_amdgcn_exp2f(X0[5]); } if (DO_QK) { P0[3] = fmamk_s<1077936128>(ss_, xl0_); } if (DO_QK) { P0[4] = fmamk_s<1090519040>(ss_, xl0_); } SBAR(); \
      vl1 = vtr(vb_ + 13312); vh1 = vtr(vb_ + 13824); o[1] = __builtin_amdgcn_mfma_f32_32x32x16_bf16(pa1, (bf16x8){vl2[0], vl2[1], vl2[2], vl2[3], vh2[0], vh2[1], vh2[2], vh2[3]}, o[1], 0, 0, 0); if (DO_EXP) { X0[6] = __builtin_amdgcn_exp2f(X0[6]); } if (DO_EXP) { X0[7] = __builtin_amdgcn_exp2f(X0[7]); } if (DO_QK) { P0[5] = fmamk_s<1091567616>(ss_, xl0_); } if (DO_QK) { P0[6] = fmamk_s<1092616192>(ss_, xl0_); } if (DO_QK) { P0[7] = fmamk_s<1093664768>(ss_, xl0_); } SBAR(); \
      vl2 = vtr(vb_ + 2048); vh2 = vtr(vb_ + 2560); o[2] = __builtin_amdgcn_mfma_f32_32x32x16_bf16(pa1, (bf16x8){vl0[0], vl0[1], vl0[2], vl0[3], vh0[0], vh0[1], vh0[2], vh0[3]}, o[2], 0, 0, 0); if (DO_EXP) { X0[8] = __builtin_amdgcn_exp2f(X0[8]); } if (DO_EXP) { t0_ = cvtpk(X0[0], X0[1]); t1_ = cvtpk(X0[2], X0[3]); } if (DO_QK) { P0[8] = fmamk_s<1098907648>(ss_, xl0_); } if (DO_QK) { P0[9] = fmamk_s<1099431936>(ss_, xl0_); } SBAR(); \
      vl0 = vtr(vb_ + 6144); vh0 = vtr(vb_ + 6656); o[3] = __builtin_amdgcn_mfma_f32_32x32x16_bf16(pa1, (bf16x8){vl1[0], vl1[1], vl1[2], vl1[3], vh1[0], vh1[1], vh1[2], vh1[3]}, o[3], 0, 0, 0); lacc4 = __builtin_amdgcn_mfma_f32_16x16x32_bf16(lmask, pa1, lacc4, 0, 0, 0); if (DO_EXP) { X0[9] = __builtin_amdgcn_exp2f(X0[9]); } if (DO_EXP) { t2_ = cvtpk(X0[4], X0[5]); t3_ = cvtpk(X0[6], X0[7]); { u32x4 w_ = {t0_, t1_, t2_, t3_}; pa0 = __builtin_bit_cast(bf16x8, w_); } } if (DO_QK) { P0[10] = fmamk_s<1099956224>(ss_, xl0_); } if (DO_QK) { P0[11] = fmamk_s<1100480512>(ss_, xl0_); } if (DO_QK) { P0[12] = fmamk_s<1103101952>(ss_, xl0_); } SBAR(); \
      vl1 = vtr(vb_ + 10240); vh1 = vtr(vb_ + 10752); o[0] = __builtin_amdgcn_mfma_f32_32x32x16_bf16(pa2, (bf16x8){vl2[0], vl2[1], vl2[2], vl2[3], vh2[0], vh2[1], vh2[2], vh2[3]}, o[0], 0, 0, 0); if (DO_EXP) { X0[10] = __builtin_amdgcn_exp2f(X0[10]); } if (DO_EXP) { X0[11] = __builtin_amdgcn_exp2f(X0[11]); } if (DO_QK) { P0[13] = fmamk_s<1103626240>(ss_, xl0_); } if (DO_QK) { P0[14] = fmamk_s<1104150528>(ss_, xl0_); } SBAR(); \
      vl2 = vtr(vb_ + 14336); vh2 = vtr(vb_ + 14848); o[1] = __builtin_amdgcn_mfma_f32_32x32x16_bf16(pa2, (bf16x8){vl0[0], vl0[1], vl0[2], vl0[3], vh0[0], vh0[1], vh0[2], vh0[3]}, o[1], 0, 0, 0); if (DO_EXP) { X0[12] = __builtin_amdgcn_exp2f(X0[12]); } if (DO_QK) { P0[15] = fmamk_s<1104674816>(ss_, xl0_); } if (DO_QK) { P1[0] = fmamk_s<0>(ss_, xl1_); } if (DO_QK) { P1[1] = fmamk_s<1065353216>(ss_, xl1_); } SBAR(); \
      vl0 = vtr(vb_ + 3072); vh0 = vtr(vb_ + 3584); o[2] = __builtin_amdgcn_mfma_f32_32x32x16_bf16(pa2, (bf16x8){vl1[0], vl1[1], vl1[2], vl1[3], vh1[0], vh1[1], vh1[2], vh1[3]}, o[2], 0, 0, 0); if (DO_EXP) { X0[13] = __builtin_amdgcn_exp2f(X0[13]); } if (DO_QK) { P1[2] = fmamk_s<1073741824>(ss_, xl1_); } if (DO_QK) { P1[3] = fmamk_s<1077936128>(ss_, xl1_); } SBAR(); \
      vl1 = vtr(vb_ + 7168); vh1 = vtr(vb_ + 7680); o[3] = __builtin_amdgcn_mfma_f32_32x32x16_bf16(pa2, (bf16x8){vl2[0], vl2[1], vl2[2], vl2[3], vh2[0], vh2[1], vh2[2], vh2[3]}, o[3], 0, 0, 0); lacc4 = __builtin_amdgcn_mfma_f32_16x16x32_bf16(lmask, pa2, lacc4, 0, 0, 0); if (DO_EXP) { X0[14] = __builtin_amdgcn_exp2f(X0[14]); } if (DO_EXP) { X0[15] = __builtin_amdgcn_exp2f(X0[15]); } if (DO_QK) { P1[4] = fmamk_s<1090519040>(ss_, xl1_); } if (DO_QK) { P1[5] = fmamk_s<1091567616>(ss_, xl1_); } if (DO_QK) { P1[6] = fmamk_s<1092616192>(ss_, xl1_); } SBAR(); \
      if (!lead_half && (JJ) + 1 < NT) { ATT_WAIT_BAR(4); }     \
      vl2 = vtr(vb_ + 11264); vh2 = vtr(vb_ + 11776); o[0] = __builtin_amdgcn_mfma_f32_32x32x16_bf16(pa3, (bf16x8){vl0[0], vl0[1], vl0[2], vl0[3], vh0[0], vh0[1], vh0[2], vh0[3]}, o[0], 0, 0, 0); if (DO_EXP) { X1[0] = __builtin_amdgcn_exp2f(X1[0]); } if (DO_EXP) { t0_ = cvtpk(X0[8], X0[9]); t1_ = cvtpk(X0[10], X0[11]); } if (DO_QK) { P1[7] = fmamk_s<1093664768>(ss_, xl1_); } if (DO_QK) { P1[8] = fmamk_s<1098907648>(ss_, xl1_); } SBAR(); \
      vl0 = vtr(vb_ + 15360); vh0 = vtr(vb_ + 15872); o[1] = __builtin_amdgcn_mfma_f32_32x32x16_bf16(pa3, (bf16x8){vl1[0], vl1[1], vl1[2], vl1[3], vh1[0], vh1[1], vh1[2], vh1[3]}, o[1], 0, 0, 0); if (DO_EXP) { X1[1] = __builtin_amdgcn_exp2f(X1[1]); } if (DO_EXP) { t2_ = cvtpk(X0[12], X0[13]); t3_ = cvtpk(X0[14], X0[15]); { u32x4 w_ = {t0_, t1_, t2_, t3_}; pa1 = __builtin_bit_cast(bf16x8, w_); } } if (DO_QK) { P1[9] = fmamk_s<1099431936>(ss_, xl1_); } if (DO_QK) { P1[10] = fmamk_s<1099956224>(ss_, xl1_); } if (DO_QK) { P1[11] = fmamk_s<1100480512>(ss_, xl1_); } SBAR(); \
      if (DO_QK) kf0 = *(const __attribute__((address_space(3))) bf16x8*)(kb_ + 0); o[2] = __builtin_amdgcn_mfma_f32_32x32x16_bf16(pa3, (bf16x8){vl2[0], vl2[1], vl2[2], vl2[3], vh2[0], vh2[1], vh2[2], vh2[3]}, o[2], 0, 0, 0); if (DO_EXP) { X1[2] = __builtin_amdgcn_exp2f(X1[2]); } if (DO_EXP) { X1[3] = __builtin_amdgcn_exp2f(X1[3]); } if (DO_QK) { P1[12] = fmamk_s<1103101952>(ss_, xl1_); } if (DO_QK) { P1[13] = fmamk_s<1103626240>(ss_, xl1_); } SBAR(); \
      if (DO_QK) kf1 = *(const __attribute__((address_space(3))) bf16x8*)(kb_ + 512); o[3] = __builtin_amdgcn_mfma_f32_32x32x16_bf16(pa3, (bf16x8){vl0[0], vl0[1], vl0[2], vl0[3], vh0[0], vh0[1], vh0[2], vh0[3]}, o[3], 0, 0, 0); lacc4 = __builtin_amdgcn_mfma_f32_16x16x32_bf16(lmask, pa3, lacc4, 0, 0, 0); if (DO_EXP) { X1[4] = __builtin_amdgcn_exp2f(X1[4]); } if (DO_QK) { P1[14] = fmamk_s<1104150528>(ss_, xl1_); } if (DO_QK) { P1[15] = fmamk_s<1104674816>(ss_, xl1_); } SBAR(); if (DO_QK && mixed_) { const float c2_ = -2.f * nslope2; P0[0] += c2_ * __builtin_fminf(dq2_ - 0.f, 0.f); P0[1] += c2_ * __builtin_fminf(dq2_ - 1.f, 0.f); P0[2] += c2_ * __builtin_fminf(dq2_ - 2.f, 0.f); P0[3] += c2_ * __builtin_fminf(dq2_ - 3.f, 0.f); P0[4] += c2_ * __builtin_fminf(dq2_ - 8.f, 0.f); P0[5] += c2_ * __builtin_fminf(dq2_ - 9.f, 0.f); P0[6] += c2_ * __builtin_fminf(dq2_ - 10.f, 0.f); P0[7] += c2_ * __builtin_fminf(dq2_ - 11.f, 0.f); P0[8] += c2_ * __builtin_fminf(dq2_ - 16.f, 0.f); P0[9] += c2_ * __builtin_fminf(dq2_ - 17.f, 0.f); P0[10] += c2_ * __builtin_fminf(dq2_ - 18.f, 0.f); P0[11] += c2_ * __builtin_fminf(dq2_ - 19.f, 0.f); P0[12] += c2_ * __builtin_fminf(dq2_ - 24.f, 0.f); P0[13] += c2_ * __builtin_fminf(dq2_ - 25.f, 0.f); P0[14] += c2_ * __builtin_fminf(dq2_ - 26.f, 0.f); P0[15] += c2_ * __builtin_fminf(dq2_ - 27.f, 0.f); P1[0] += c2_ * __builtin_fminf(dq2_ - 32.f, 0.f); P1[1] += c2_ * __builtin_fminf(dq2_ - 33.f, 0.f); P1[2] += c2_ * __builtin_fminf(dq2_ - 34.f, 0.f); P1[3] += c2_ * __builtin_fminf(dq2_ - 35.f, 0.f); P1[4] += c2_ * __builtin_fminf(dq2_ - 40.f, 0.f); P1[5] += c2_ * __builtin_fminf(dq2_ - 41.f, 0.f); P1[6] += c2_ * __builtin_fminf(dq2_ - 42.f, 0.f); P1[7] += c2_ * __builtin_fminf(dq2_ - 43.f, 0.f); P1[8] += c2_ * __builtin_fminf(dq2_ - 48.f, 0.f); P1[9] += c2_ * __builtin_fminf(dq2_ - 49.f, 0.f); P1[10] += c2_ * __builtin_fminf(dq2_ - 50.f, 0.f); P1[11] += c2_ * __builtin_fminf(dq2_ - 51.f, 0.f); P1[12] += c2_ * __builtin_fminf(dq2_ - 56.f, 0.f); P1[13] += c2_ * __builtin_fminf(dq2_ - 57.f, 0.f); P1[14] += c2_ * __builtin_fminf(dq2_ - 58.f, 0.f); P1[15] += c2_ * __builtin_fminf(dq2_ - 59.f, 0.f); } SBAR(); \
      if (DO_QK) kf2 = *(const __attribute__((address_space(3))) bf16x8*)(kb_ + 2048); if (DO_QK) P0 = __builtin_amdgcn_mfma_f32_32x32x16_bf16(kf0, qr[0], P0, 0, 0, 0); if (DO_EXP) { X1[5] = __builtin_amdgcn_exp2f(X1[5]); } SBAR(); \
      if (DO_QK) kf0 = *(const __attribute__((address_space(3))) bf16x8*)(kb_ + 2560); if (DO_QK) P1 = __builtin_amdgcn_mfma_f32_32x32x16_bf16(kf1, qr[0], P1, 0, 0, 0); if (DO_EXP) { X1[6] = __builtin_amdgcn_exp2f(X1[6]); } if (DO_EXP) { X1[7] = __builtin_amdgcn_exp2f(X1[7]); } SBAR(); \
      if (DO_QK) kf1 = *(const __attribute__((address_space(3))) bf16x8*)(kb_ + 4096); if (DO_QK) P0 = __builtin_amdgcn_mfma_f32_32x32x16_bf16(kf2, qr[1], P0, 0, 0, 0); if (DO_EXP) { X1[8] = __builtin_amdgcn_exp2f(X1[8]); } if (DO_EXP) { t0_ = cvtpk(X1[0], X1[1]); t1_ = cvtpk(X1[2], X1[3]); } SBAR(); \
      if (DO_QK) kf2 = *(const __attribute__((address_space(3))) bf16x8*)(kb_ + 4608); if (DO_QK) P1 = __builtin_amdgcn_mfma_f32_32x32x16_bf16(kf0, qr[1], P1, 0, 0, 0); if (DO_EXP) { X1[9] = __builtin_amdgcn_exp2f(X1[9]); } if (DO_EXP) { t2_ = cvtpk(X1[4], X1[5]); t3_ = cvtpk(X1[6], X1[7]); { u32x4 w_ = {t0_, t1_, t2_, t3_}; pa2 = __builtin_bit_cast(bf16x8, w_); } } SBAR(); \
      if (DO_QK) kf0 = *(const __attribute__((address_space(3))) bf16x8*)(kb_ + 6144); if (DO_QK) P0 = __builtin_amdgcn_mfma_f32_32x32x16_bf16(kf1, qr[2], P0, 0, 0, 0); if (DO_EXP) { X1[10] = __builtin_amdgcn_exp2f(X1[10]); } if (DO_EXP) { X1[11] = __builtin_amdgcn_exp2f(X1[11]); } SBAR(); \
      if (DO_QK) kf1 = *(const __attribute__((address_space(3))) bf16x8*)(kb_ + 6656); if (DO_QK) P1 = __builtin_amdgcn_mfma_f32_32x32x16_bf16(kf2, qr[2], P1, 0, 0, 0); if (DO_EXP) { X1[12] = __builtin_amdgcn_exp2f(X1[12]); } SBAR(); \
      if (DO_QK) P0 = __builtin_amdgcn_mfma_f32_32x32x16_bf16(kf0, qr[3], P0, 0, 0, 0); if (DO_EXP) { X1[13] = __builtin_amdgcn_exp2f(X1[13]); } SBAR(); \
      if (DO_QK) P1 = __builtin_amdgcn_mfma_f32_32x32x16_bf16(kf1, qr[3], P1, 0, 0, 0); if (DO_EXP) { X1[14] = __builtin_amdgcn_exp2f(X1[14]); } if (DO_EXP) { X1[15] = __builtin_amdgcn_exp2f(X1[15]); } SBAR(); \
    } \
    dq1 -= 64.f; ATT_ROT3(sk_cur); ATT_ROT3(sv_cur); ATT_ROT3(sk_dma); ATT_ROT3(sv_dma); } while (0)

struct UnitDesc { int u, h, qb, nc, ci, sid, t_lo, t_hi; float slope; };
constexpr int ITEM_FROM_PRE = 8192 - 1024;
__device__ __forceinline__ float att_window(float Bn, float Cn, float slope) {
    const float a1 = 2.f * Bn + 18.2f, a2 = Bn + Cn + 63.f * slope + __logf(1.f / (64.f * slope)) + 18.2f;
    return (ATT_EXACT_ZERO ? 104.f + 2.f * Bn : fminf(a1, a2)) / slope;
}
__device__ __forceinline__ UnitDesc decode_unit(int idx, float Bn, float Cn, const __attribute__((address_space(3))) unsigned short* pre, const __attribute__((address_space(3))) unsigned short* sidx) {
    UnitDesc d;
    const unsigned it_ = (unsigned)__builtin_amdgcn_readfirstlane((int)((const __attribute__((address_space(3))) unsigned*)((const __attribute__((address_space(3))) unsigned char*)pre + ITEM_FROM_PRE))[idx]);
    d.u = (int)(it_ & 511u); d.ci = (int)((it_ >> 10) & 3u); d.nc = (int)((it_ >> 12) & 3u); d.sid = __builtin_amdgcn_readfirstlane((int)sidx[d.u]);
    const int k = d.u & 127; d.h = 3 - (d.u >> 7); d.qb = (k & 1) ? 63 - (k >> 1) : 64 + (k >> 1);
    d.slope = exp2f(-2.f * (float)(d.h + 1));
    const float Rf = att_window(Bn, Cn, d.slope);
    const int R = __builtin_amdgcn_readfirstlane(Rf < 20000.f ? (int)Rf + 1 : 20000);
    const int q0 = d.qb * 128; const int klo = q0 - R < 0 ? 0 : q0 - R, khi = q0 + 127 + R > M - 1 ? M - 1 : q0 + 127 + R;
    const int tlo = klo >> 6, nt = (khi >> 6) - tlo + 1, base = nt / d.nc, rem = nt - base * d.nc;
    d.t_lo = tlo + d.ci * base + (d.ci < rem ? d.ci : rem); d.t_hi = d.t_lo + base + (d.ci < rem ? 1 : 0) - 1;
    return d;
}
__device__ __forceinline__ void attn_unit(int idx, float Bn, float Cn, float lam, const __attribute__((address_space(3))) unsigned short* pre, const __attribute__((address_space(3))) unsigned short* sidx,
                                          const unsigned short* Q, const unsigned char* Kimg, const unsigned char* Vimg, unsigned short* MIX, const float* hn, char* shm,
                                          float* slabs, unsigned* cnts, volatile __attribute__((address_space(3))) unsigned* bcast, unsigned& nx, gu32* qctr) {
    const int tid = threadIdx.x, lane = tid & 63, r32 = lane & 31, hi = lane >> 5; const int wid = __builtin_amdgcn_readfirstlane(tid >> 6), rg = wid >> 1, mp = wid & 1;
    const UnitDesc D = decode_unit(idx, Bn, Cn, pre, sidx);
    const int h = D.h, t_lo = D.t_lo, t_hi = D.t_hi; const float slope2 = D.slope * LOG2E;
    const float shift2 = fmaxf(0.f, Bn * LOG2E - 24.f);
    const int q0 = D.qb * 128, NT = t_hi - t_lo + 1;
    const unsigned lds0 = (unsigned)(uintptr_t)shm;
    const unsigned char* ksrc = Kimg + (size_t)h * 256 * SLOT + wid * 2048;
    const unsigned char* vsrc = Vimg + (size_t)h * 256 * SLOT + wid * 2048;
    const unsigned lane16 = (unsigned)lane * 16u;
    const unsigned kdst = lds0 + LDS_K + wid * 2048, vdst = lds0 + LDS_V + wid * 2048;
    const unsigned short* Qw = Q + (size_t)(q0 + rg * 32 + r32) * AW + h * 128 + mp * 64 + hi * 8;
    bf16x8 qr[4];
#pragma unroll
    for (int d0 = 0; d0 < 4; ++d0) qr[d0] = *(const bf16x8*)(Qw + d0 * 16);
    int tj = t_lo;
    ATT_DMA2(ksrc, tj, kdst); ATT_DMA2(ksrc, tj + 1, kdst + SLOT); ATT_DMA2(vsrc, tj, vdst); ATT_DMA2(ksrc, tj + 2, kdst + 2 * SLOT); ATT_DMA2(ksrc, tj + 3, kdst + 3 * SLOT); ATT_DMA2(vsrc, tj + 1, vdst + SLOT);
    const lds_cptr shm3 = (lds_cptr)shm;
    const lds_cptr kp0 = shm3 + LDS_K + (8 * mp + hi) * 1024 + r32 * 16;
    const lds_cptr vp0 = shm3 + LDS_V + v_rd_base(lane);
    const float dq0 = (float)(q0 + rg * 32 + r32 - t_lo * 64 - 4 * hi);
    const int qw0 = q0 + rg * 32;
    const float nslope2 = -slope2;
    f32x16 o[4]; o[0] = f32x16{}; o[1] = f32x16{}; o[2] = f32x16{}; o[3] = f32x16{};
    f32x4 lacc4 = f32x4{0.f, 0.f, 0.f, 0.f};
    bf16x8 lmask; { const int row_ = lane & 15, kg_ = lane >> 4; const bool on_ = (((row_ & 7) == 0) && ((kg_ & 1) == 0)) || (((row_ & 7) == 4) && ((kg_ & 1) == 1));
                    const short one_ = on_ ? (short)0x3F80 : (short)0; lmask = (bf16x8){one_, one_, one_, one_, one_, one_, one_, one_}; }
    f32x16 sA0, sA1, sB0, sB1; bf16x8 pa0, pa1, pa2, pa3 = bf16x8{};
    bias_general(sA0, sA1, dq0, nslope2, shift2);
    bias_general(sB0, sB1, dq0 - 64.f, nslope2, shift2);
    ATT_WAIT_BAR(8);
    qkt_acc(sA0, sA1, kp0, qr);
    qkt_acc(sB0, sB1, kp0 + SLOT, qr);
    softmax_first(sA0, sA1, pa0, pa1, pa2);
    float dq1 = dq0 - 64.f;
    int sk_cur = 2 * SLOT, sv_cur = 0, sk_dma = 0, sv_dma = 2 * SLOT;
    const bool lead_half = wid < 4;
    if (wid >= 4) __builtin_amdgcn_s_setprio(1);
    int j = 0;
    for (; j + 2 < NT; j += 2) { ATT_STEP(sA0, sA1, sB0, sB1, true, true, j); ATT_STEP(sB0, sB1, sA0, sA1, true, true, j + 1); }
    if (NT - j == 2) { ATT_STEP(sA0, sA1, sB0, sB1, true, true, j);
#pragma unroll
        for (int r = 8; r < 16; ++r) sA1[r] = sB1[r];
        ATT_STEP(sA0, sA1, sB0, sB1, false, false, j + 1); }
    else { ATT_STEP(sA0, sA1, sB0, sB1, false, false, j); }
    __builtin_amdgcn_s_setprio(0);
    if (threadIdx.x == 0) nx = __hip_atomic_fetch_add(qctr, 1u, __ATOMIC_RELAXED, __HIP_MEMORY_SCOPE_AGENT);
    float l_acc = lacc4[0];
    ATT_WAIT_BAR(0);
    int idx_e = idx; asm volatile("" : "+s"(idx_e));
    int tid_e = threadIdx.x; asm volatile("" : "+v"(tid_e));
    const int lane_e = tid_e & 63, r32_e = lane_e & 31, hi_e = lane_e >> 5, wid_e = __builtin_amdgcn_readfirstlane(tid_e >> 6), rg_e = wid_e >> 1, mp_e = wid_e & 1;
    const UnitDesc E = decode_unit(idx_e, Bn, Cn, pre, sidx);
    const int nc = E.nc, ci = E.ci, h_e = E.h, q0_e = E.qb * 128;
    float* slab_u = slabs + (size_t)E.sid * 3 * SLAB_FLOATS; unsigned* cnt_u = cnts + E.u;
    if (nc > 1) {
        float* sl = slab_u + (size_t)ci * SLAB_FLOATS + wid_e * 4160;
#pragma unroll
        for (int d0 = 0; d0 < 4; ++d0)
#pragma unroll
            for (int i = 0; i < 4; ++i) { const f32x4 v_ = (f32x4){o[d0][4 * i], o[d0][4 * i + 1], o[d0][4 * i + 2], o[d0][4 * i + 3]};
                asm volatile("global_store_dwordx4 %0, %1, off sc1\n\ts_nop 1" :: "v"(sl + ((d0 * 4 + i) * 64 + lane_e) * 4), "v"(v_) : "memory"); }
        asm volatile("global_store_dword %0, %1, off sc1\n\ts_nop 1" :: "v"(sl + 4096 + lane_e), "v"(l_acc) : "memory");
        asm volatile("s_waitcnt vmcnt(0)" ::: "memory");
        __syncthreads();
        if (tid_e == 0) bcast[0] = __hip_atomic_fetch_add(cnt_u, 1u, __ATOMIC_RELAXED, __HIP_MEMORY_SCOPE_AGENT);
        __syncthreads();
        const unsigned old = bcast[0];
        __syncthreads();
        if ((int)old != nc - 1) return;
        if (tid_e == 0) { __builtin_amdgcn_fence(__ATOMIC_ACQUIRE, "agent"); asm volatile("s_waitcnt vmcnt(0)" ::: "memory"); }
        __syncthreads();
        o[0] = f32x16{}; o[1] = f32x16{}; o[2] = f32x16{}; o[3] = f32x16{}; l_acc = 0.f;
        for (int cc = 0; cc < nc; ++cc) { const float* rs = slab_u + (size_t)cc * SLAB_FLOATS + wid_e * 4160;
            f32x4 sv[16];
#pragma unroll
            for (int k = 0; k < 16; ++k) sv[k] = *(const f32x4*)(rs + (k * 64 + lane_e) * 4);
            const float sl_l = rs[4096 + lane_e];
            asm volatile("" :: "v"(sv[0]), "v"(sv[1]), "v"(sv[2]), "v"(sv[3]), "v"(sv[4]), "v"(sv[5]), "v"(sv[6]), "v"(sv[7]), "v"(sv[8]), "v"(sv[9]), "v"(sv[10]), "v"(sv[11]), "v"(sv[12]), "v"(sv[13]), "v"(sv[14]), "v"(sv[15]));
#pragma unroll
            for (int d0 = 0; d0 < 4; ++d0)
#pragma unroll
                for (int i = 0; i < 4; ++i) { const f32x4 v = sv[d0 * 4 + i]; o[d0][4 * i] += v[0]; o[d0][4 * i + 1] += v[1]; o[d0][4 * i + 2] += v[2]; o[d0][4 * i + 3] += v[3]; }
            l_acc += sl_l; }
    }
    float* wsf = (float*)(shm + LDS_WS) + wid_e * 64;
    if (hi_e == 0) wsf[r32_e] = l_acc;
    asm volatile("s_waitcnt lgkmcnt(0)" ::: "memory");
    float rli[16];
#pragma unroll
    for (int r = 0; r < 16; ++r) rli[r] = __builtin_amdgcn_rcpf(wsf[crow(r, hi_e)]);
    float* X = (float*)shm + rg_e * 32 * XSTRIDE;
    if (mp_e == 1) {
#pragma unroll
        for (int r = 0; r < 16; ++r)
#pragma unroll
            for (int d0 = 0; d0 < 4; ++d0) X[crow(r, hi_e) * XSTRIDE + d0 * 32 + r32_e] = lam * o[d0][r] * rli[r];
    }
    ATT_WAIT_BAR(0);
    if (mp_e == 0) {
#pragma unroll
        for (int r = 0; r < 16; ++r)
#pragma unroll
            for (int d0 = 0; d0 < 4; ++d0) { float* xp = X + crow(r, hi_e) * XSTRIDE + d0 * 32 + r32_e; *xp = o[d0][r] * rli[r] - *xp; }
        asm volatile("s_waitcnt lgkmcnt(0)" ::: "memory");
        const float* xr = X + r32_e * XSTRIDE + hi_e * 64;
        f32x4 v[16]; float ss = 0.f;
#pragma unroll
        for (int i = 0; i < 16; ++i) { v[i] = *(const f32x4*)(xr + 4 * i); ss += (v[i][0] * v[i][0] + v[i][1] * v[i][1]) + (v[i][2] * v[i][2] + v[i][3] * v[i][3]); }
        { auto rr = __builtin_amdgcn_permlane32_swap(__float_as_uint(ss), __float_as_uint(ss), false, false); ss = __uint_as_float(rr[0]) + __uint_as_float(rr[1]); }
        const float rn = rsqrtf(ss * (1.f / 128.f) + EPS) * (1.f - LAM_INIT);
        unsigned short* orow = MIX + (size_t)(q0_e + rg_e * 32 + r32_e) * DM + h_e * 128 + hi_e * 64;
        const __attribute__((address_space(3))) f32x4* g = (const __attribute__((address_space(3))) f32x4*)((lds_cptr)shm + LDS_HN + hi_e * 256);
#pragma unroll
        for (int i = 0; i < 8; ++i) { const f32x4 g0 = g[2 * i], g1 = g[2 * i + 1]; const f32x4 a = v[2 * i] * rn * g0, b = v[2 * i + 1] * rn * g1;
            u32x4 w; w.x = cvtpk(a[0], a[1]); w.y = cvtpk(a[2], a[3]); w.z = cvtpk(b[0], b[1]); w.w = cvtpk(b[2], b[3]); *(u32x4*)(orow + 8 * i) = w; }
    }
    ATT_WAIT_BAR(0);
}
}

constexpr int N_LAUNCHES = MK_N_LAUNCHES, PER_PHASE = 7;
constexpr int N_ATT_UNITS = NH * (M / 128), N_CONV_UNITS = M / CONV_ROWS;

__global__ void __launch_bounds__(NWAVES * 64, 2) fwd(Args args) {
    extern __shared__ __attribute__((aligned(16))) unsigned char lds_raw[];
    LAS unsigned char* lds = (LAS unsigned char*)lds_raw;
    volatile LAS unsigned* MISC = (volatile LAS unsigned*)(lds + MISC_OFF);
    const int tid = threadIdx.x, lane = tid & 63, wave = __builtin_amdgcn_readfirstlane(tid >> 6);
    const int G = gridDim.x; const int bx = blockIdx.x; const int vcu = (G % 8 == 0) ? (bx % 8) * (G / 8) + bx / 8 : bx;
    unsigned char* ws = args.ws;
    gu32* ctl = (gu32*)(ws + WS_CTL);
    for (int u = tid; u < (LDS_BYTES - LDSCTL_OFF) / 4; u += NWAVES * 64) ((LAS unsigned*)(lds + LDSCTL_OFF))[u] = 0u;
    __syncthreads();
    XcdBarrier bar; bar.bar = (unsigned*)(ctl + CW_BAR); bar.x = 0; bar.st = nullptr;
    if (N_LAUNCHES != PER_PHASE) bar = xcd_barrier_post((unsigned*)(ctl + CW_BAR), MISC + 8);
#define GRID_BAR() do { if (N_LAUNCHES != PER_PHASE) xcd_barrier(bar); } while (0)
    const int lo = args.ph_lo, hi = args.ph_hi;
#define IN(k) (lo <= (k) && (k) < hi)
#define BOTH(k) (IN(k) && IN((k) + 1))
    bf16* XN = (bf16*)(ws + WS_XN); bf16* Qb = (bf16*)(ws + WS_Q); unsigned char* Kimg = ws + WS_KIMG; unsigned char* Vimg = ws + WS_VIMG; bf16* Ub = (bf16*)(ws + WS_U);
    bf16* MIX = (bf16*)(ws + WS_MIX); bf16* HM = (bf16*)(ws + WS_HM); bf16* PB = (bf16*)(ws + WS_PB); bf16* PR = (bf16*)(ws + WS_PROJ);
    float* SS1 = (float*)(ws + WS_SS1); float* SS2 = (float*)(ws + WS_SS2);

    if (IN(0)) { p0_prologue(args, lds, vcu, G, wave, lane); if (BOTH(0)) GRID_BAR(); }
    int vc = bx; bool xl = false;
    if (N_LAUNCHES == 1 && IN(0)) { xl = __builtin_amdgcn_readfirstlane((int)MISC[11]) != 0; if (xl) vc = (int)bar.x + 8 * __builtin_amdgcn_readfirstlane((int)MISC[10]); }
#define XCD_BAR() do { if (N_LAUNCHES != PER_PHASE) { if (xl) xcd_local_barrier(bar); else xcd_barrier(bar); } } while (0)

    constexpr int NT1 = (M / 256) * (NIN / 256);
    const int first_idle = NT1 - ((NT1 + G - 1) / G - 1) * G, w_p1 = (N_LAUNCHES == 1) ? ((G - first_idle) < N_W_UNITS ? (G - first_idle) : N_W_UNITS) : 0, w_p2 = N_W_UNITS - w_p1;
    if (IN(1)) {
        { pg8::Gemm g{XN, (const bf16*)(ws + WS_WIN), M, NIN, DM}; pg8::StaticOrder S; S.init(M, NIN, G, bx);
          LAS float* rtab = (LAS float*)(lds + LDSCTL_OFF + 12288); int rpm = -1;
          LAS float* gtab = (LAS float*)(lds + LDSCTL_OFF + 13824);
          if (tid >= 256 && tid < 384) gtab[tid - 256] = tid < 320 ? args.in[4][tid - 256] : args.in[5][tid - 320];
          { pg8::Unit u0; if (S.next(0, u0)) { rpm = u0.pm; if (tid < 256) rtab[tid] = rsqrtf(((const float*)(ws + WS_SS0))[rpm * 256 + tid] * (1.f / DM) + EPS); } __syncthreads(); }
          pg8::EpiIn E{Qb, Kimg, Vimg, Ub, args.in[4], args.in[5], (unsigned*)(ctl + CW_QMAX), (const float*)(ws + WS_SS0), rtab, rpm, gtab, (LAS unsigned*)(lds + LDSCTL_OFF + 14400)};
          pg8::gemm_phase<pg8::EpiIn, pg8::StaticOrder, PG8_ALIGN, PG8_SP2>(lds + RING_OFF, g, S, E);
          __syncthreads();
          if (tid < 3) { const unsigned v = ((LAS unsigned*)(lds + LDSCTL_OFF + 14400))[tid]; if (v) atomicMax((unsigned*)(ctl + CW_QMAX) + tid, v); } }
        if (w_p1 > 0 && bx >= first_idle && bx - first_idle < w_p1) weight_unit(bx - first_idle, args, lds, wave, lane);
        if (BOTH(1)) GRID_BAR();
    }

    if (IN(2)) {
        const unsigned mx3 = __hip_atomic_load((unsigned*)(ctl + CW_QMAX) + (lane < 3 ? lane : 0), __ATOMIC_RELAXED, __HIP_MEMORY_SCOPE_AGENT);
        const float qmax = __uint_as_float(__builtin_amdgcn_readlane(mx3, 0)), kmax = __uint_as_float(__builtin_amdgcn_readlane(mx3, 1)), kbar = __uint_as_float(__builtin_amdgcn_readlane(mx3, 2));
        const float Bn = qmax * kmax * (1.02f / LOG2E);
        const float Cn = qmax * kbar * (1.02f / LOG2E) + 0.05f;
        const float d1 = wave_sum(args.in[6][lane] * args.in[7][lane]), d2 = wave_sum(args.in[8][lane] * args.in[9][lane]);
        const float lam = __expf(d1) - __expf(d2) + LAM_INIT;
        LAS unsigned short* pre = (LAS unsigned short*)(lds + LDSCTL_OFF + 1024);
        LAS unsigned short* sidx = (LAS unsigned short*)(lds + LDSCTL_OFF + 2112);
        LAS unsigned* wtot = (LAS unsigned*)(lds + LDSCTL_OFF + 3200);
        if (tid < 128) ((LAS float*)(lds + att::LDS_HN))[tid] = args.in[10][tid];
        { const int u = tid, h = 3 - (u >> 7), k = u & 127, qb = (k & 1) ? 63 - (k >> 1) : 64 + (k >> 1);
          const float slope = exp2f(-2.f * (float)(h + 1));
          const float Rf = att::att_window(Bn, Cn, slope);
          const int R = Rf < 20000.f ? (int)Rf + 1 : 20000;
          const int q0 = qb * 128; const int klo = q0 - R < 0 ? 0 : q0 - R, khi = q0 + 127 + R > M - 1 ? M - 1 : q0 + 127 + R;
          const int my_nt = (khi >> 6) - (klo >> 6) + 1, want = my_nt > 100 ? 1 : 0;
          int v = want;
#pragma unroll
          for (int o = 1; o < 64; o <<= 1) { const int t = __shfl_up(v, o); if (lane >= o) v += t; }
          if (lane == 63) wtot[wave] = (unsigned)v;
          __syncthreads();
          int off = 0;
          for (int w = 0; w < wave; ++w) off += (int)wtot[w];
          const int sid = off + v - want;
          const int my_nc = (want && sid < MAX_SPLIT_UNITS) ? ((my_nt + 63) / 64 < 3 ? (my_nt + 63) / 64 : 3) : 1;
          sidx[u] = (unsigned short)sid;
          v = my_nc;
#pragma unroll
          for (int o = 1; o < 64; o <<= 1) { const int t = __shfl_up(v, o); if (lane >= o) v += t; }
          if (lane == 63) wtot[8 + wave] = (unsigned)v;
          __syncthreads();
          off = 0;
          for (int w = 0; w < wave; ++w) off += (int)wtot[8 + w];
          pre[u] = (unsigned short)(off + v - my_nc);
          if (u == 511) pre[512] = (unsigned short)(off + v);
          { LAS unsigned* item = (LAS unsigned*)(lds + LDSCTL_OFF + 8192);
            for (int ci = 0; ci < my_nc; ++ci) item[off + v - my_nc + ci] = (unsigned)u | ((unsigned)ci << 10) | ((unsigned)my_nc << 12); }
          __syncthreads(); }
        const int n_att = (int)pre[512];
        unsigned* slabs_cnt = (unsigned*)(ctl + CW_UCNT);
        bool conv_w_staged = false;
        unsigned nx = 0;
        if (tid == 0) nx = __hip_atomic_fetch_add(ctl + CW_QUEUE, 1u, __ATOMIC_RELAXED, __HIP_MEMORY_SCOPE_AGENT);
        for (;;) {
            if (tid == 0) MISC[16] = nx;
            __syncthreads();
            const int idx = __builtin_amdgcn_readfirstlane((int)MISC[16]);
            __syncthreads();
            if (idx >= n_att + w_p2 + N_CONV_UNITS) break;
            if (idx < n_att) {
                att::attn_unit(idx, Bn, Cn, lam, pre, sidx, Qb, Kimg, Vimg, MIX, args.in[10], (char*)lds_raw, (float*)(ws + WS_SLAB), slabs_cnt, MISC + 17, nx, ctl + CW_QUEUE);
            } else if (tid == 0) nx = __hip_atomic_fetch_add(ctl + CW_QUEUE, 1u, __ATOMIC_RELAXED, __HIP_MEMORY_SCOPE_AGENT);
            if (idx < n_att) {
            } else if (idx < n_att + w_p2) {
                weight_unit(w_p1 + idx - n_att, args, lds, wave, lane);
            } else {
                conv_unit(idx - n_att - w_p2, Ub, ws + WS_CW16, args.in[12], args.in[13], args.in[14], MIX, lds, tid, wave, lane, conv_w_staged);
            }
        }
        if (BOTH(2)) GRID_BAR();
    }

    if (IN(3)) {
        pg8::Gemm g{MIX, (const bf16*)(ws + WS_WOUT), M, DM, DM}; pg8::StaticOrder S; S.init(M, DM, G, vc);
        pg8::EpiRes<false> E{nullptr, XN, SS1};
        pg8::gemm_phase<pg8::EpiRes<false>, pg8::StaticOrder, PG8_ALIGN, PG8_SP2>(lds + RING_OFF, g, S, E);
        if (BOTH(3)) XCD_BAR();
    }
    if (IN(4)) {
        { pg8::Gemm g{XN, (const bf16*)(ws + WS_WGU), M, 2 * FF, DM}; pg8::StaticOrder S; S.init(M, 2 * FF, G, vc);
          LAS float* rtab = (LAS float*)(lds + LDSCTL_OFF + 12288); int rpm = -1;
          { pg8::Unit u0; if (S.next(0, u0)) { rpm = u0.pm; if (tid < 256) { const f32x4* sp = (const f32x4*)(SS1 + (size_t)(rpm * 256 + tid) * 16); const f32x4 a = sp[0], b = sp[1], c = sp[2], d = sp[3];
                rtab[tid] = rsqrtf((((a[0] + a[1]) + (a[2] + a[3])) + ((b[0] + b[1]) + (b[2] + b[3])) + ((c[0] + c[1]) + (c[2] + c[3])) + ((d[0] + d[1]) + (d[2] + d[3]))) * (1.f / DM) + EPS); } } __syncthreads(); }
          pg8::EpiGU E{HM, SS1, rtab, rpm};
          pg8::gemm_phase<pg8::EpiGU, pg8::StaticOrder, PG8_ALIGN, PG8_SP2>(lds + RING_OFF, g, S, E); }
        { int kproj = PD; asm volatile("" : "+s"(kproj));
          pg8::Gemm g{PB, (const bf16*)(ws + WS_WPP), M, DM, kproj}; pg8::HelperOrder S{G, vc};
          pg8::EpiBf16 E{PR, DM};
          pg8::gemm_phase<pg8::EpiBf16, pg8::HelperOrder, PG8_ALIGN, PG8_SP2>(lds + RING_OFF, g, S, E); }
        if (BOTH(4)) XCD_BAR();
    }
    if (IN(5)) {
        pg8::Gemm g{HM, (const bf16*)(ws + WS_WDN), M, DM, FF}; pg8::StaticOrder S; S.init(M, DM, G, vc);
        pg8::EpiRes<false> E{nullptr, XN, SS2};
        pg8::gemm_phase<pg8::EpiRes<false>, pg8::StaticOrder, PG8_ALIGN, PG8_SP2>(lds + RING_OFF, g, S, E);
        if (BOTH(5)) XCD_BAR();
    }
    if (IN(6)) {
        pg8::Gemm g{XN, (const bf16*)(ws + WS_WPG), M, DM, DM}; pg8::StaticOrder S; S.init(M, DM, G, vc);
        LAS float* rtab = (LAS float*)(lds + LDSCTL_OFF + 12288); int rpm = -1;
        { pg8::Unit u0; if (S.next(0, u0)) { rpm = u0.pm; if (tid < 256) { const f32x4* sp = (const f32x4*)(SS2 + (size_t)(rpm * 256 + tid) * 16); const f32x4 a = sp[0], b = sp[1], c = sp[2], d = sp[3];
              rtab[tid] = rsqrtf((((a[0] + a[1]) + (a[2] + a[3])) + ((b[0] + b[1]) + (b[2] + b[3])) + ((c[0] + c[1]) + (c[2] + c[3])) + ((d[0] + d[1]) + (d[2] + d[3]))) * (1.f / DM) + EPS); } } __syncthreads(); }
        pg8::EpiPG E{args.out, XN, PR, SS2, rtab, rpm};
        pg8::gemm_phase<pg8::EpiPG, pg8::StaticOrder, PG8_ALIGN, PG8_SP2>(lds + RING_OFF, g, S, E);
    }
#undef IN
#undef BOTH
#undef GRID_BAR
#undef XCD_BAR
}

extern "C" void kernel_launch(void* const* d_in, const int* in_sizes, int n_in, void* d_out, int out_size, void* d_ws, size_t ws_size, hipStream_t stream) {
    static int grid = 0;
    if (grid == 0) {
        if (n_in != 23 || in_sizes[0] != M * DM || out_size != M * DM || ws_size < WS_END) { fprintf(stderr, "kernel_launch: unexpected shapes (n_in %d, out %d, ws %zu); nothing launched\n", n_in, out_size, ws_size); grid = -1; return; }
        int dev = 0, cus = 0, per_cu = 0;
        if (hipGetDevice(&dev) != hipSuccess || hipDeviceGetAttribute(&cus, hipDeviceAttributeMultiprocessorCount, dev) != hipSuccess) { grid = -1; return; }
        if (hipFuncSetAttribute((const void*)fwd, hipFuncAttributeMaxDynamicSharedMemorySize, LDS_BYTES) != hipSuccess) { fprintf(stderr, "kernel_launch: hipFuncSetAttribute failed\n"); grid = -1; return; }
        const hipError_t oe = hipOccupancyMaxActiveBlocksPerMultiprocessor(&per_cu, (const void*)fwd, NWAVES * 64, LDS_BYTES);
        (void)hipGetLastError();
        if (oe == hipSuccess && per_cu < 1) { fprintf(stderr, "kernel_launch: the occupancy query admits no workgroup of this kernel per CU; nothing launched\n"); grid = -1; return; }
        grid = cus;
    }
    if (grid < 0) return;
    if (hipMemsetAsync((char*)d_ws + WS_CTL, 0, CTL_ZERO_BYTES, stream) != hipSuccess) { fprintf(stderr, "kernel_launch: memset failed\n"); return; }
    Args a{};
    for (int i = 0; i < 23; ++i) a.in[i] = (const float*)d_in[i];
    a.out = (float*)d_out; a.ws = (unsigned char*)d_ws;
    for (int li = 0; li < N_LAUNCHES; ++li) {
        a.ph_lo = (N_LAUNCHES == PER_PHASE) ? li : 0; a.ph_hi = (N_LAUNCHES == PER_PHASE) ? li + 1 : PER_PHASE; a.li = li;
        hipLaunchKernelGGL(fwd, dim3(grid), dim3(NWAVES * 64), LDS_BYTES, stream, a);
        const hipError_t le = hipPeekAtLastError();
        if (le != hipSuccess) { fprintf(stderr, "kernel_launch: launch %d failed: %s\n", li, hipGetErrorName(le)); break; }
    }
}
```

```cpp
#include <hip/hip_runtime.h>
#include <cstdio>
#include <cstdint>

#ifndef ATT_EXACT_ZERO
#define ATT_EXACT_ZERO 0
#endif
#ifndef MK_N_LAUNCHES
#define MK_N_LAUNCHES 1
#endif

constexpr int M = 16384, DM = 1024, NIN = 2560, AW = 512, CW = 512, NH = 4, DH = 64, VH = 128, KC = 31, FF = 2816, PD = 256;
constexpr float EPS = 1e-6f;
constexpr float LOG2E = 1.4426950408889634f;
constexpr float QSCALE = 0.125f * LOG2E;
constexpr float LAM_INIT = 0.2f;

__host__ __device__ __forceinline__ int v_st(int k, int c) { return ((c >> 5) * 4 + (k >> 4)) * 1024 + (k & 15) * 64 + (c & 31) * 2; }
__host__ __device__ __forceinline__ int k_st(int k, int c) { return (c >> 3) * 1024 + k * 16 + (c & 7) * 2; }
__device__ __forceinline__ float fsigmoid(float x) { return __builtin_amdgcn_rcpf(1.f + __builtin_amdgcn_exp2f(-LOG2E * x)); }

namespace pg8 {
#define PG8_LAS __attribute__((address_space(3)))
typedef unsigned short bf16_t;
typedef short bf16x8 __attribute__((ext_vector_type(8)));
typedef float f32x4 __attribute__((ext_vector_type(4)));
typedef unsigned u32x4 __attribute__((ext_vector_type(4)));
constexpr int BM = 256, BK = 64, HALF = 128, HTB = HALF * BK * 2  , STAGE_BYTES = 8 * HTB, NXCD = 8, WGM = 8;

__host__ __device__ __forceinline__ int lds_byte(int r, int c) { const int st = (r >> 4) * 2 + (c >> 5), rr = r & 15, cc = c & 31, ob = rr * 64 + cc * 2; return st * 1024 + (ob ^ (((ob >> 9) & 1) << 5)); }
__host__ __device__ __forceinline__ void stage_rc(int b, int& R, int& C) { const int st = b / 1024, sb = b % 1024, swz = sb ^ (((sb >> 9) & 1) << 5); R = (st >> 1) * 16 + swz / 64; C = (st & 1) * 32 + (swz % 64) / 2; }
__host__ __device__ __forceinline__ int perm32(int rho) { const int n = rho >> 4, i = rho & 15; return 8 * (i >> 2) + 4 * n + (i & 3); }

struct Unit { int pm, pn; };
struct Gemm { const bf16_t* A; const bf16_t* Bt; int M, N, K; };

struct StaticOrder {
    int nM, nN, nwg, G, c;
    __host__ __device__ void init(int M, int N, int G_, int c_) { nM = M / BM; nN = N / BM; nwg = nM * nN; G = G_; c = c_; }
    __host__ __device__ bool next(int i, Unit& u) const {
        const long L = (long)i * G + c; if (L >= nwg) return false;
        int wgid = (int)L; { const int q = nwg / NXCD, r = nwg % NXCD, xcd = wgid % NXCD, off = wgid / NXCD; wgid = (xcd < r ? xcd * (q + 1) : r * (q + 1) + (xcd - r) * q) + off; }
        const int nig = WGM * nN, gid = wgid / nig, fm = gid * WGM, gsz = (nM - fm) < WGM ? (nM - fm) : WGM;
        u.pm = fm + ((wgid % nig) % gsz); u.pn = (wgid % nig) / gsz; return true;
    }
    __device__ __forceinline__ void a_ready(const Unit&) const {}
    __device__ __forceinline__ void done(const Unit&) const {}
};


__device__ __forceinline__ float sum_fq(float v) {
    { auto r = __builtin_amdgcn_permlane32_swap(__float_as_uint(v), __float_as_uint(v), false, false); v = __uint_as_float(r[0]) + __uint_as_float(r[1]); }
    { auto r = __builtin_amdgcn_permlane16_swap(__float_as_uint(v), __float_as_uint(v), false, false); v = __uint_as_float(r[0]) + __uint_as_float(r[1]); }
    return v;
}
#define PG8_DPP(v, ctrl) __uint_as_float((unsigned)__builtin_amdgcn_update_dpp(0, (int)__float_as_uint(v), ctrl, 0xF, 0xF, true))
__device__ __forceinline__ float row16_sum(float v) { v += PG8_DPP(v, 0xB1); v += PG8_DPP(v, 0x4E); v += PG8_DPP(v, 0x141); v += PG8_DPP(v, 0x140); return v; }
__device__ __forceinline__ float row16_max(float v) { v = fmaxf(v, PG8_DPP(v, 0xB1)); v = fmaxf(v, PG8_DPP(v, 0x4E)); v = fmaxf(v, PG8_DPP(v, 0x141)); v = fmaxf(v, PG8_DPP(v, 0x140)); return v; }
__device__ __forceinline__ unsigned cvt_pk_bf16(float lo, float hi) { unsigned r; asm volatile("v_cvt_pk_bf16_f32 %0, %1, %2" : "=v"(r) : "v"(lo), "v"(hi)); return r; }
typedef _Float16 half2_t __attribute__((ext_vector_type(2)));
__device__ __forceinline__ unsigned pkh(float lo, float hi) { return __builtin_bit_cast(unsigned, __builtin_amdgcn_cvt_pkrtz(lo, hi)); }
__device__ __forceinline__ u32x4 pack8_f16(const f32x4 a, const f32x4 b) { u32x4 w; w.x = pkh(a[0], a[1]); w.y = pkh(a[2], a[3]); w.z = pkh(b[0], b[1]); w.w = pkh(b[2], b[3]); return w; }
__device__ __forceinline__ u32x4 pack8(const f32x4 a, const f32x4 b) { u32x4 w; w.x = cvt_pk_bf16(a[0], a[1]); w.y = cvt_pk_bf16(a[2], a[3]); w.z = cvt_pk_bf16(b[0], b[1]); w.w = cvt_pk_bf16(b[2], b[3]); return w; }

struct EpiBf16 {
    static constexpr bool PERM = true, AFTER_DRAIN = false;
    bf16_t* O; int ldc;
    __device__ __forceinline__ void operator()(const f32x4 (&acc)[2][2][4][2], const Unit& u, int wr, int wc, int fr, int fq) const {
        const int row0 = u.pm * BM + wr * 64 + fr, col0 = u.pn * BM + wc * 32 + 8 * fq;
#pragma unroll
        for (int ai = 0; ai < 2; ++ai)
#pragma unroll
            for (int m = 0; m < 4; ++m) { bf16_t* rowp = O + (size_t)(row0 + ai * HALF + m * 16) * ldc + col0;
#pragma unroll
                for (int bj = 0; bj < 2; ++bj) *(u32x4*)(rowp + bj * HALF) = pack8(acc[ai][bj][m][0], acc[ai][bj][m][1]); }
    }
};

struct EpiIn {
    static constexpr bool PERM = true, AFTER_DRAIN = false;
    bf16_t* Q; unsigned char* Kimg; unsigned char* Vimg; bf16_t* U; const float* qn; const float* kn; unsigned* nmax; const float* SS0; const PG8_LAS float* rtab; int rtab_pm; const PG8_LAS float* gtab; PG8_LAS unsigned* nmax_lds;
    __device__ __forceinline__ void operator()(const f32x4 (&acc)[2][2][4][2], const Unit& u, int wr, int wc, int fr, int fq) const {
        const int row0 = u.pm * BM + wr * 64 + fr;
        float r0s[2][4];
        if (u.pm == rtab_pm) {
#pragma unroll
            for (int ai = 0; ai < 2; ++ai)
#pragma unroll
                for (int m = 0; m < 4; ++m) r0s[ai][m] = rtab[wr * 64 + fr + ai * HALF + m * 16];
        } else {
#pragma unroll
            for (int ai = 0; ai < 2; ++ai)
#pragma unroll
                for (int m = 0; m < 4; ++m) r0s[ai][m] = SS0[row0 + ai * HALF + m * 16];
#pragma unroll
            for (int ai = 0; ai < 2; ++ai)
#pragma unroll
                for (int m = 0; m < 4; ++m) r0s[ai][m] = rsqrtf(r0s[ai][m] * (1.f / DM) + EPS);
        }
        if (u.pn < 4) {
            float nn_max = 0.f;
            const bool isq = u.pn < 2; const PG8_LAS float* gn = gtab + (isq ? 0 : 64); const float sc = isq ? QSCALE : 1.f;
            const int gidx = (u.pn & 1) * 4 + wc;
            f32x4 g[2][2];
#pragma unroll
            for (int bj = 0; bj < 2; ++bj)
#pragma unroll
                for (int n = 0; n < 2; ++n) g[bj][n] = *(const PG8_LAS f32x4*)(gn + 32 * bj + 8 * fq + 4 * n);
            float kbar2_max = 0.f;
#pragma unroll
            for (int ai = 0; ai < 2; ++ai) {
                f32x4 cs[2][2];
#pragma unroll
                for (int bj = 0; bj < 2; ++bj) { cs[bj][0] = (f32x4){0.f, 0.f, 0.f, 0.f}; cs[bj][1] = (f32x4){0.f, 0.f, 0.f, 0.f}; }
#pragma unroll
                for (int m = 0; m < 4; ++m) {
                    float ss = 0.f;
#pragma unroll
                    for (int bj = 0; bj < 2; ++bj)
#pragma unroll
                        for (int n = 0; n < 2; ++n) { const f32x4 x = acc[ai][bj][m][n]; ss += (x[0] * x[0] + x[1] * x[1]) + (x[2] * x[2] + x[3] * x[3]); }
                    ss = sum_fq(ss);
                    const int row = row0 + ai * HALF + m * 16; float nn = 0.f;
                    const float r0 = r0s[ai][m];
                    const float r = rsqrtf(ss * (r0 * r0) * (1.f / 64.f) + EPS) * (r0 * sc);
#pragma unroll
                    for (int bj = 0; bj < 2; ++bj) {
                        const f32x4 v0 = acc[ai][bj][m][0] * r * g[bj][0], v1 = acc[ai][bj][m][1] * r * g[bj][1];
                        nn += (v0[0] * v0[0] + v0[1] * v0[1]) + (v0[2] * v0[2] + v0[3] * v0[3]) + (v1[0] * v1[0] + v1[1] * v1[1]) + (v1[2] * v1[2] + v1[3] * v1[3]);
                        if (!isq) { cs[bj][0] += v0; cs[bj][1] += v1; }
                        const u32x4 w = pack8(v0, v1);
                        if (isq) *(u32x4*)(Q + (size_t)row * AW + gidx * 64 + 32 * bj + 8 * fq) = w;
                        else *(u32x4*)(Kimg + (size_t)((gidx >> 1) * 256 + (row >> 6)) * 16384 + k_st(row & 63, (gidx & 1) * 64 + 32 * bj + 8 * fq)) = w;
                    }
                    nn = sum_fq(nn); nn_max = fmaxf(nn_max, nn);
                }
                if (!isq) {
                    float kb = 0.f;
#pragma unroll
                    for (int bj = 0; bj < 2; ++bj)
#pragma unroll
                        for (int n = 0; n < 2; ++n)
#pragma unroll
                            for (int e = 0; e < 4; ++e) { const float c = row16_sum(cs[bj][n][e]); kb += c * c; }
                    kb = sum_fq(kb);
                    kbar2_max = fmaxf(kbar2_max, kb * (1.f / 4096.f));
                }
            }
            nn_max = row16_max(nn_max);
            if ((threadIdx.x & 63) == 0) (void)__hip_atomic_fetch_max(nmax_lds + (isq ? 0 : 1), __float_as_uint(sqrtf(nn_max)), __ATOMIC_RELAXED, __HIP_MEMORY_SCOPE_WORKGROUP);
            if (!isq && (threadIdx.x & 63) == 0) (void)__hip_atomic_fetch_max(nmax_lds + 2, __float_as_uint(sqrtf(kbar2_max)), __ATOMIC_RELAXED, __HIP_MEMORY_SCOPE_WORKGROUP);
        } else if (u.pn < 6) {
#pragma unroll
            for (int ai = 0; ai < 2; ++ai)
#pragma unroll
                for (int m = 0; m < 4; ++m) { const int row = row0 + ai * HALF + m * 16; const float r0 = r0s[ai][m];
#pragma unroll
                    for (int bj = 0; bj < 2; ++bj) { const int h = (u.pn - 4) * 2 + bj;
                        *(u32x4*)(Vimg + (size_t)(h * 256 + (row >> 6)) * 16384 + v_st(row & 63, wc * 32 + 8 * fq)) = pack8(acc[ai][bj][m][0] * r0, acc[ai][bj][m][1] * r0); } }
        } else {
            const int ch0 = (u.pn - 6) * 128 + wc * 32 + 8 * fq;
#pragma unroll
            for (int ai = 0; ai < 2; ++ai)
#pragma unroll
                for (int m = 0; m < 4; ++m) { const int row = row0 + ai * HALF + m * 16; f32x4 v[2]; const float r0 = r0s[ai][m];
                    const float r2 = -LOG2E * r0, ir0 = __builtin_amdgcn_rcpf(r0);
#pragma unroll
                    for (int n = 0; n < 2; ++n) { const f32x4 a = acc[ai][0][m][n], gt = acc[ai][1][m][n];
                        const f32x4 t = gt * r2; const f32x4 ex = (f32x4){__builtin_amdgcn_exp2f(t[0]), __builtin_amdgcn_exp2f(t[1]), __builtin_amdgcn_exp2f(t[2]), __builtin_amdgcn_exp2f(t[3])};
                        const f32x4 den = ex * ir0 + ir0; v[n] = a * (f32x4){__builtin_amdgcn_rcpf(den[0]), __builtin_amdgcn_rcpf(den[1]), __builtin_amdgcn_rcpf(den[2]), __builtin_amdgcn_rcpf(den[3])}; }
                    *(u32x4*)(U + (size_t)row * CW + ch0) = pack8_f16(v[0], v[1]); }
        }
    }
};

template <bool F32BASE> struct EpiRes {
    static constexpr bool PERM = true, AFTER_DRAIN = false;
    const float* base; bf16_t* Xb; float* SS;
    __device__ __forceinline__ void operator()(const f32x4 (&acc)[2][2][4][2], const Unit& u, int wr, int wc, int fr, int fq) const {
        static_assert(!F32BASE, "the residual base is the bf16 stream");
        const int row0 = u.pm * BM + wr * 64 + fr, col0 = u.pn * BM + wc * 32 + 8 * fq;
        u32x4 bva[2][4][2];
#pragma unroll
        for (int ai = 0; ai < 2; ++ai)
#pragma unroll
            for (int m = 0; m < 4; ++m)
#pragma unroll
                for (int bj = 0; bj < 2; ++bj) bva[ai][m][bj] = *(const u32x4*)(Xb + (size_t)(row0 + ai * HALF + m * 16) * DM + col0 + bj * HALF);
        asm volatile("" :: "v"(bva[0][0][0]), "v"(bva[0][1][0]), "v"(bva[0][2][0]), "v"(bva[0][3][0]), "v"(bva[1][0][0]), "v"(bva[1][1][0]), "v"(bva[1][2][0]), "v"(bva[1][3][0]), "v"(bva[0][0][1]), "v"(bva[0][1][1]), "v"(bva[0][2][1]), "v"(bva[0][3][1]), "v"(bva[1][0][1]), "v"(bva[1][1][1]), "v"(bva[1][2][1]), "v"(bva[1][3][1]));
#pragma unroll
        for (int ai = 0; ai < 2; ++ai) {
#pragma unroll
            for (int m = 0; m < 4; ++m) { const int row = row0 + ai * HALF + m * 16; float ss = 0.f;
#pragma unroll
                for (int bj = 0; bj < 2; ++bj) { const size_t off = (size_t)row * DM + col0 + bj * HALF; const u32x4 b = bva[ai][m][bj];
                    f32x4 x0 = (f32x4){__builtin_bit_cast(float, b.x << 16), __builtin_bit_cast(float, b.x & 0xffff0000u), __builtin_bit_cast(float, b.y << 16), __builtin_bit_cast(float, b.y & 0xffff0000u)};
                    f32x4 x1 = (f32x4){__builtin_bit_cast(float, b.z << 16), __builtin_bit_cast(float, b.z & 0xffff0000u), __builtin_bit_cast(float, b.w << 16), __builtin_bit_cast(float, b.w & 0xffff0000u)};
                    x0 += acc[ai][bj][m][0]; x1 += acc[ai][bj][m][1];
                    ss += (x0[0] * x0[0] + x0[1] * x0[1]) + (x0[2] * x0[2] + x0[3] * x0[3]) + (x1[0] * x1[0] + x1[1] * x1[1]) + (x1[2] * x1[2] + x1[3] * x1[3]);
                    *(u32x4*)(Xb + off) = pack8(x0, x1); }
                ss = sum_fq(ss);
                if (fq == 0) SS[(size_t)row * 16 + u.pn * 4 + wc] = ss; }
        }
    }
};
__device__ __forceinline__ void row_rstd8(const float* SS, int row0, int fq, float (&rs)[2][4]) {
#pragma unroll
    for (int ai = 0; ai < 2; ++ai)
#pragma unroll
        for (int m = 0; m < 4; ++m) { const f32x4 t = *(const f32x4*)(SS + (size_t)(row0 + ai * HALF + m * 16) * 16 + 4 * fq); rs[ai][m] = (t[0] + t[1]) + (t[2] + t[3]); }
#pragma unroll
    for (int ai = 0; ai < 2; ++ai)
#pragma unroll
        for (int m = 0; m < 4; ++m) { float v = sum_fq(rs[ai][m]); rs[ai][m] = rsqrtf(v * (1.f / DM) + EPS); }
}
struct EpiGU {
    static constexpr bool PERM = true, AFTER_DRAIN = false;
    bf16_t* HM; const float* SS; const PG8_LAS float* rtab; int rtab_pm;
    __device__ __forceinline__ void operator()(const f32x4 (&acc)[2][2][4][2], const Unit& u, int wr, int wc, int fr, int fq) const {
        const int row0 = u.pm * BM + wr * 64 + fr, col0 = u.pn * HALF + wc * 32 + 8 * fq;
        float rs[2][4];
        if (u.pm == rtab_pm) {
#pragma unroll
            for (int ai = 0; ai < 2; ++ai)
#pragma unroll
                for (int m = 0; m < 4; ++m) rs[ai][m] = rtab[wr * 64 + fr + ai * HALF + m * 16];
        } else row_rstd8(SS, row0, fq, rs);
#pragma unroll
        for (int ai = 0; ai < 2; ++ai)
#pragma unroll
            for (int m = 0; m < 4; ++m) { const int row = row0 + ai * HALF + m * 16; const float r = rs[ai][m]; f32x4 v[2];
                const float r2 = -LOG2E * r, ir2 = __builtin_amdgcn_rcpf(r * r);
#pragma unroll
                for (int n = 0; n < 2; ++n) { const f32x4 gt = acc[ai][0][m][n], up = acc[ai][1][m][n];
                    const f32x4 t = gt * r2, gu = gt * up; f32x4 ex = (f32x4){__builtin_amdgcn_exp2f(t[0]), __builtin_amdgcn_exp2f(t[1]), __builtin_amdgcn_exp2f(t[2]), __builtin_amdgcn_exp2f(t[3])};
                    const f32x4 den = ex * ir2 + ir2; const f32x4 rc = (f32x4){__builtin_amdgcn_rcpf(den[0]), __builtin_amdgcn_rcpf(den[1]), __builtin_amdgcn_rcpf(den[2]), __builtin_amdgcn_rcpf(den[3])};
                    v[n] = gu * rc; }
                *(u32x4*)(HM + (size_t)row * FF + col0) = pack8(v[0], v[1]); }
    }
};
struct EpiPG {
    static constexpr bool PERM = true, AFTER_DRAIN = false;
    float* out; const bf16_t* Xb; const bf16_t* PR; const float* SS; const PG8_LAS float* rtab; int rtab_pm;
    __device__ __forceinline__ void operator()(const f32x4 (&acc)[2][2][4][2], const Unit& u, int wr, int wc, int fr, int fq) const {
        const int row0 = u.pm * BM + wr * 64 + fr, col0 = u.pn * BM + wc * 32 + 8 * fq;
        float rs[2][4];
        if (u.pm == rtab_pm) {
#pragma unroll
            for (int ai = 0; ai < 2; ++ai)
#pragma unroll
                for (int m = 0; m < 4; ++m) rs[ai][m] = rtab[wr * 64 + fr + ai * HALF + m * 16];
        } else row_rstd8(SS, row0, fq, rs);
#pragma unroll
        for (int ai = 0; ai < 2; ++ai) {
            u32x4 prv[4][2], xbv[4][2];
#pragma unroll
            for (int m = 0; m < 4; ++m)
#pragma unroll
                for (int bj = 0; bj < 2; ++bj) { const size_t off = (size_t)(row0 + ai * HALF + m * 16) * DM + col0 + bj * HALF; prv[m][bj] = *(const u32x4*)(PR + off); xbv[m][bj] = *(const u32x4*)(Xb + off); }
#pragma unroll
            for (int m = 0; m < 4; ++m) { const int row = row0 + ai * HALF + m * 16; const float r = rs[ai][m];
#pragma unroll
                for (int bj = 0; bj < 2; ++bj) { const size_t off = (size_t)row * DM + col0 + bj * HALF;
                    const u32x4 pr = prv[m][bj], xb = xbv[m][bj];
                    const float rl = -LOG2E * r;
                    const f32x4 t0 = acc[ai][bj][m][0] * rl, t1 = acc[ai][bj][m][1] * rl;
                    const f32x4 d0 = (f32x4){__builtin_amdgcn_exp2f(t0[0]), __builtin_amdgcn_exp2f(t0[1]), __builtin_amdgcn_exp2f(t0[2]), __builtin_amdgcn_exp2f(t0[3])} + 1.f;
                    const f32x4 d1 = (f32x4){__builtin_amdgcn_exp2f(t1[0]), __builtin_amdgcn_exp2f(t1[1]), __builtin_amdgcn_exp2f(t1[2]), __builtin_amdgcn_exp2f(t1[3])} + 1.f;
                    const f32x4 s0 = (f32x4){__builtin_amdgcn_rcpf(d0[0]), __builtin_amdgcn_rcpf(d0[1]), __builtin_amdgcn_rcpf(d0[2]), __builtin_amdgcn_rcpf(d0[3])}, s1 = (f32x4){__builtin_amdgcn_rcpf(d1[0]), __builtin_amdgcn_rcpf(d1[1]), __builtin_amdgcn_rcpf(d1[2]), __builtin_amdgcn_rcpf(d1[3])};
                    const f32x4 x0 = (f32x4){__builtin_bit_cast(float, xb.x << 16), __builtin_bit_cast(float, xb.x & 0xffff0000u), __builtin_bit_cast(float, xb.y << 16), __builtin_bit_cast(float, xb.y & 0xffff0000u)};
                    const f32x4 x1 = (f32x4){__builtin_bit_cast(float, xb.z << 16), __builtin_bit_cast(float, xb.z & 0xffff0000u), __builtin_bit_cast(float, xb.w << 16), __builtin_bit_cast(float, xb.w & 0xffff0000u)};
                    const f32x4 p0 = (f32x4){__builtin_bit_cast(float, pr.x << 16), __builtin_bit_cast(float, pr.x & 0xffff0000u), __builtin_bit_cast(float, pr.y << 16), __builtin_bit_cast(float, pr.y & 0xffff0000u)};
                    const f32x4 p1 = (f32x4){__builtin_bit_cast(float, pr.z << 16), __builtin_bit_cast(float, pr.z & 0xffff0000u), __builtin_bit_cast(float, pr.w << 16), __builtin_bit_cast(float, pr.w & 0xffff0000u)};
                    const f32x4 o0 = s0 * p0 + x0, o1 = s1 * p1 + x1;
                    __builtin_nontemporal_store(o0, (f32x4*)(out + off)); __builtin_nontemporal_store(o1, (f32x4*)(out + off + 4)); } }
        }
    }
};
struct HelperOrder {
    int G, c;
    __device__ __forceinline__ bool next(int i, Unit& u) const {
        const int h0 = G >> 1; if (c < h0) return false;
        if ((G & 15) == 0) {
            const int x = c & 7, rank = c >> 3, nr = G >> 3, r0 = nr >> 1, lu = (rank - r0) + (nr - r0) * i; if (lu >= 32) return false; u.pm = 8 * x + (lu >> 2); u.pn = lu & 3; return true; }
        const int L = (c - h0) + (G - h0) * i; if (L >= 256) return false; u.pm = L >> 2; u.pn = L & 3; return true; }
    __device__ __forceinline__ void a_ready(const Unit&) const {}
    __device__ __forceinline__ void done(const Unit&) const {}
};

template <class Epi, class Sched, bool ALIGN_EPI = false, bool SP2 = false>
__device__ __forceinline__ void gemm_phase(PG8_LAS unsigned char* lds, const Gemm g, const Sched& S, const Epi& E) {
    const int tid = threadIdx.x, wid = __builtin_amdgcn_readfirstlane(tid >> 6), lane = tid & 63, wr = wid >> 2, wc = wid & 3, fr = lane & 15, fq = lane >> 4;
    const int K = g.K, nt = K / BK;
    unsigned voffA[2], voffB[2];
#pragma unroll
    for (int i = 0; i < 2; ++i) { int R, C; stage_rc(tid * 16 + i * 8192, R, C); const int Rb = Epi::PERM ? ((R & ~31) + perm32(R & 31)) : R;
        voffA[i] = (unsigned)(R * K + C) * 2u; voffB[i] = (unsigned)(Rb * K + C) * 2u; }
    const size_t kstep = (size_t)(BK * 2);
    const size_t hstep = (size_t)HALF * K * 2;
    const size_t tstep = 2 * hstep;
    const unsigned ldsw = (unsigned)wid * 1024u;
    const int aoff = lds_byte(wr * 64 + fr, fq * 8), boff = lds_byte(wc * 32 + fr, fq * 8);
#define PG8_SA(b, h) (((b) * 2 + (h)) * HTB)
#define PG8_SB(b, h) ((4 + (b) * 2 + (h)) * HTB)
#define PG8_STAGE(bufoff, gbase, voff) do { _Pragma("unroll") for (int _i = 0; _i < 2; ++_i) \
        __builtin_amdgcn_global_load_lds((const unsigned*)((const char*)(gbase) + (voff)[_i]), (PG8_LAS unsigned*)(lds + (bufoff) + ldsw + _i * 8192), 16, 0, 0); } while (0)
#define PG8_LDA(dst, b, h) do { _Pragma("unroll") for (int m = 0; m < 4; ++m) _Pragma("unroll") for (int k = 0; k < 2; ++k) dst[m][k] = *(const PG8_LAS bf16x8*)(lds + PG8_SA(b, h) + aoff + m * 2048 + k * 1024); } while (0)
#define PG8_LDB(dst, b, h) do { _Pragma("unroll") for (int n = 0; n < 2; ++n) _Pragma("unroll") for (int k = 0; k < 2; ++k) dst[n][k] = *(const PG8_LAS bf16x8*)(lds + PG8_SB(b, h) + boff + n * 2048 + k * 1024); } while (0)
#define PG8_MMA(ai, bj, At, Bt) do { __builtin_amdgcn_s_setprio(1); _Pragma("unroll") for (int m = 0; m < 4; ++m) _Pragma("unroll") for (int n = 0; n < 2; ++n) _Pragma("unroll") for (int k = 0; k < 2; ++k) \
        acc[ai][bj][m][n] = __builtin_amdgcn_mfma_f32_16x16x32_bf16(Bt[n][k], At[m][k], acc[ai][bj][m][n], 0, 0, 0); __builtin_amdgcn_s_setprio(0); } while (0)
#define PG8_WAIT_V(n) asm volatile("s_waitcnt vmcnt(" #n ")" ::: "memory")
#define PG8_WAIT_L(n) asm volatile("s_waitcnt lgkmcnt(" #n ")" ::: "memory")
#define PG8_BAR __builtin_amdgcn_s_barrier()
#define PG8_SCHED __builtin_amdgcn_sched_barrier(0)
    Unit cur, nxt; int ui = 0;
    if (!S.next(0, cur)) return;
    f32x4 acc[2][2][4][2];
#pragma unroll
    for (int a = 0; a < 2; ++a)
#pragma unroll
        for (int b = 0; b < 2; ++b)
#pragma unroll
            for (int m = 0; m < 4; ++m)
#pragma unroll
                for (int n = 0; n < 2; ++n) acc[a][b][m][n] = (f32x4){0.f, 0.f, 0.f, 0.f};
    bf16x8 At[4][2], B0[2][2], B1[2][2];
    const char* cA = (const char*)g.A + (size_t)cur.pm * tstep; const char* cB = (const char*)g.Bt + (size_t)cur.pn * tstep;
    S.a_ready(cur);
    if constexpr (SP2) {
        PG8_STAGE(PG8_SB(0, 0), cB, voffB); PG8_STAGE(PG8_SB(0, 1), cB + hstep, voffB); PG8_STAGE(PG8_SA(0, 0), cA, voffA); PG8_STAGE(PG8_SA(0, 1), cA + hstep, voffA);
        if (wr == 1) PG8_BAR;
        PG8_WAIT_V(2); PG8_BAR;
        PG8_STAGE(PG8_SB(1, 0), cB + kstep, voffB); PG8_STAGE(PG8_SA(1, 0), cA + kstep, voffA); PG8_STAGE(PG8_SB(1, 1), cB + hstep + kstep, voffB);
        PG8_WAIT_V(6); PG8_BAR;
    } else {
        PG8_STAGE(PG8_SB(0, 0), cB, voffB); PG8_STAGE(PG8_SA(0, 0), cA, voffA); PG8_STAGE(PG8_SB(0, 1), cB + hstep, voffB); PG8_STAGE(PG8_SA(0, 1), cA + hstep, voffA);
        if (wr == 1) PG8_BAR;
        PG8_WAIT_V(4); PG8_BAR;
        PG8_STAGE(PG8_SB(1, 0), cB + kstep, voffB); PG8_STAGE(PG8_SA(1, 0), cA + kstep, voffA); PG8_STAGE(PG8_SB(1, 1), cB + hstep + kstep, voffB);
        PG8_WAIT_V(6); PG8_BAR;
    }
    for (;;) {
        const bool has_next = S.next(ui + 1, nxt);
        const char* nA = has_next ? (const char*)g.A + (size_t)nxt.pm * tstep : cA; const char* nB = has_next ? (const char*)g.Bt + (size_t)nxt.pn * tstep : cB;
        for (int t = 0; t < nt; t += 2) {
            const bool last = (t == nt - 2);
            const char* a1 = cA + (size_t)(t + 1) * kstep;
            const char* a2 = last ? nA : cA + (size_t)(t + 2) * kstep; const char* b2 = last ? nB : cB + (size_t)(t + 2) * kstep;
            const char* a3 = a2 + kstep; const char* b3 = b2 + kstep;
            if (last && has_next) S.a_ready(nxt);
            if constexpr (SP2) {
            PG8_LDB(B0, 0, 0); PG8_LDB(B1, 0, 1); PG8_SCHED; PG8_LDA(At, 0, 0); PG8_STAGE(PG8_SA(1, 1), a1 + hstep, voffA);
            PG8_WAIT_V(8); PG8_WAIT_L(0); PG8_BAR; PG8_MMA(0, 0, At, B0); PG8_MMA(0, 1, At, B1); PG8_BAR; PG8_SCHED;
            PG8_LDA(At, 0, 1); PG8_STAGE(PG8_SB(0, 0), b2, voffB); PG8_STAGE(PG8_SB(0, 1), b2 + hstep, voffB); PG8_STAGE(PG8_SA(0, 0), a2, voffA);
            PG8_WAIT_V(8); PG8_WAIT_L(0); PG8_BAR; PG8_MMA(1, 0, At, B0); PG8_MMA(1, 1, At, B1); PG8_BAR; PG8_SCHED;
            PG8_LDB(B0, 1, 0); PG8_LDB(B1, 1, 1); PG8_SCHED; PG8_LDA(At, 1, 0); PG8_STAGE(PG8_SA(0, 1), a2 + hstep, voffA);
            PG8_WAIT_V(8); PG8_WAIT_L(0); PG8_BAR; PG8_MMA(0, 0, At, B0); PG8_MMA(0, 1, At, B1); PG8_BAR; PG8_SCHED;
            PG8_LDA(At, 1, 1); PG8_STAGE(PG8_SB(1, 0), b3, voffB); PG8_STAGE(PG8_SB(1, 1), b3 + hstep, voffB); PG8_STAGE(PG8_SA(1, 0), a3, voffA);
            PG8_WAIT_V(8); PG8_WAIT_L(0); PG8_BAR; PG8_MMA(1, 0, At, B0); PG8_MMA(1, 1, At, B1); PG8_BAR; PG8_SCHED;
            } else {
            PG8_LDB(B0, 0, 0); PG8_SCHED; PG8_LDA(At, 0, 0); PG8_STAGE(PG8_SA(1, 1), a1 + hstep, voffA);
            PG8_WAIT_L(8); PG8_BAR; PG8_WAIT_L(0); PG8_MMA(0, 0, At, B0); PG8_BAR; PG8_SCHED;
            PG8_LDB(B1, 0, 1); PG8_STAGE(PG8_SB(0, 0), b2, voffB);
            PG8_BAR; PG8_WAIT_L(0); PG8_MMA(0, 1, At, B1); PG8_BAR;
            PG8_LDA(At, 0, 1); PG8_STAGE(PG8_SA(0, 0), a2, voffA);
            PG8_BAR; PG8_WAIT_L(0); PG8_MMA(1, 0, At, B0); PG8_BAR; PG8_SCHED;
            PG8_STAGE(PG8_SB(0, 1), b2 + hstep, voffB);
            PG8_WAIT_V(6); PG8_BAR; PG8_MMA(1, 1, At, B1); PG8_BAR;
            PG8_LDB(B0, 1, 0); PG8_SCHED; PG8_LDA(At, 1, 0); PG8_STAGE(PG8_SA(0, 1), a2 + hstep, voffA);
            PG8_WAIT_L(8); PG8_BAR; PG8_WAIT_L(0); PG8_MMA(0, 0, At, B0); PG8_BAR; PG8_SCHED;
            PG8_LDB(B1, 1, 1); PG8_STAGE(PG8_SB(1, 0), b3, voffB);
            PG8_BAR; PG8_WAIT_L(0); PG8_MMA(0, 1, At, B1); PG8_BAR;
            PG8_LDA(At, 1, 1); PG8_STAGE(PG8_SA(1, 0), a3, voffA);
            PG8_BAR; PG8_WAIT_L(0); PG8_MMA(1, 0, At, B0); PG8_BAR; PG8_SCHED;
            PG8_STAGE(PG8_SB(1, 1), b3 + hstep, voffB);
            PG8_WAIT_V(6); PG8_BAR; PG8_MMA(1, 1, At, B1); PG8_BAR;
            }
        }
        if constexpr (ALIGN_EPI) { if (wr == 0) PG8_BAR; }
        if constexpr (!Epi::AFTER_DRAIN) { E(acc, cur, wr, wc, fr, fq); S.done(cur); }
        if (!has_next) break;
#pragma unroll
        for (int a = 0; a < 2; ++a)
#pragma unroll
            for (int b = 0; b < 2; ++b)
#pragma unroll
                for (int m = 0; m < 4; ++m)
#pragma unroll
                    for (int n = 0; n < 2; ++n) acc[a][b][m][n] = (f32x4){0.f, 0.f, 0.f, 0.f};
        cur = nxt; cA = nA; cB = nB; ++ui;
        if constexpr (ALIGN_EPI) { if (wr == 1) PG8_BAR; }
    }
    PG8_WAIT_V(0);
    if constexpr (!ALIGN_EPI) { if (wr == 0) PG8_BAR; }
    PG8_BAR;
    if constexpr (Epi::AFTER_DRAIN) { E.fused(acc, cur, wr, wc, fr, fq, lds, wid, lane); S.done(cur); }
#undef PG8_SA
#undef PG8_SB
#undef PG8_STAGE
#undef PG8_LDA
#undef PG8_LDB
#undef PG8_MMA
#undef PG8_WAIT_V
#undef PG8_WAIT_L
#undef PG8_BAR
#undef PG8_SCHED
}
}

#ifndef PG8_SP2
#define PG8_SP2 true
#endif
#ifndef PG8_ALIGN
#define PG8_ALIGN true
#endif
#define GAS __attribute__((address_space(1)))
#define LAS __attribute__((address_space(3)))
typedef unsigned short bf16;
typedef unsigned v4u __attribute__((ext_vector_type(4)));
typedef float f32x4 __attribute__((ext_vector_type(4)));
typedef short bf16x8 __attribute__((ext_vector_type(8)));
typedef GAS unsigned gu32;
typedef GAS unsigned long long gu64;
#define RLX_AGENT __ATOMIC_RELAXED, __HIP_MEMORY_SCOPE_AGENT
#define LDS_WAIT() asm volatile("s_waitcnt lgkmcnt(0)" ::: "memory")
#define VM_WAIT() asm volatile("s_waitcnt vmcnt(0)" ::: "memory")
__device__ __forceinline__ unsigned long long rt() { return __builtin_amdgcn_s_memrealtime(); }
__device__ __forceinline__ unsigned f2bf(float f) { unsigned u = __builtin_bit_cast(unsigned, f); return (u + 0x7fffu + ((u >> 16) & 1u)) >> 16; }
__device__ __forceinline__ unsigned ticket_add(gu32* p) { int z = 0; asm volatile("" : "+v"(z)); return __hip_atomic_fetch_add(p + z, 1u, __ATOMIC_RELAXED, __HIP_MEMORY_SCOPE_AGENT); }
__device__ __forceinline__ unsigned pk2(float lo, float hi) { return pg8::cvt_pk_bf16(lo, hi); }

#define XB_TMO      128
#define XB_XCNT(j)  (256  + 64 * (j))
#define XB_XSUB(j)  (1280 + 64 * (j))
#define XB_XGEN(j)  (2304 + 64 * (j))
#define XB_TOP      3328
#define XB_TOPGEN   3392
#define XB_LSUB(j)  (3456 + 64 * (j))
#define XB_LGEN(j)  (4480 + 64 * (j))
#define XCD_BAR_WORDS 5504
#define XB_SPIN_CAP (1u << 18)

__device__ __forceinline__ unsigned xb_ld(unsigned* p)              { return __hip_atomic_load(p, __ATOMIC_RELAXED, __HIP_MEMORY_SCOPE_AGENT); }
__device__ __forceinline__ unsigned xb_add(unsigned* p, unsigned v) { return __hip_atomic_fetch_add(p, v, __ATOMIC_RELAXED, __HIP_MEMORY_SCOPE_AGENT); }
__device__ __forceinline__ unsigned xb_xcc_id() { return (unsigned)__builtin_amdgcn_s_getreg((3 << 11) | 20) & 0xFu; }
#define XB_SPIN(cond, bar) do { unsigned _sp = 0; while (cond) { __builtin_amdgcn_s_sleep(1); \
    if ((++_sp & 255u) == 0u) { if (xb_ld(&(bar)[XB_TMO])) break; if (_sp > XB_SPIN_CAP) { atomicAdd(&(bar)[XB_TMO], 1u); break; } } } } while (0)

struct XcdBarrier {
    unsigned* bar; unsigned x;
    volatile LAS unsigned* st;
};

__device__ __forceinline__ XcdBarrier xcd_barrier_post(unsigned* bar, volatile LAS unsigned* st, unsigned& rank) {
    XcdBarrier b; b.bar = bar; b.x = xb_xcc_id(); b.st = st;
    if (threadIdx.x == 0) { int z = 0; asm volatile("" : "+v"(z)); rank = __hip_atomic_fetch_add(&bar[XB_XCNT(b.x)] + z, 1u, __ATOMIC_RELAXED, __HIP_MEMORY_SCOPE_AGENT); }
    return b;
}
__device__ __forceinline__ void xcd_barrier_complete(unsigned* bar, unsigned x, unsigned& nloc, unsigned& nx, unsigned& uniform) {
    const unsigned G = gridDim.x * gridDim.y * gridDim.z;
    unsigned sum, cnt, mine, odd, sp = 0u;
    for (;;) {
        sum = 0u; cnt = 0u; mine = 0u; odd = 0u;
#pragma unroll
        for (unsigned j = 0; j < 16; ++j) { const unsigned c = xb_ld(&bar[XB_XCNT(j)]); sum += c; cnt += (c > 0u) ? 1u : 0u; mine = (j == x) ? c : mine; odd |= (j < 8u) ? (c * 8u != G ? 1u : 0u) : (c != 0u ? 1u : 0u); }
        if (sum == G) { uniform = odd ? 0u : 1u; break; }
        __builtin_amdgcn_s_sleep(1);
        if ((++sp & 255u) == 0u) { if (xb_ld(&bar[XB_TMO])) { uniform = 0u; break; } if (sp > XB_SPIN_CAP) { atomicAdd(&bar[XB_TMO], 1u); uniform = 0u; break; } }
    }
    nloc = mine > 0u ? mine : 1u; nx = cnt > 0u ? cnt : 1u;
}

__device__ __forceinline__ bool xcd_census_eval(const unsigned (&c)[16], unsigned x, unsigned G, unsigned& nloc, unsigned& nx, unsigned& uniform) {
    unsigned sum = 0u, cnt = 0u, mine = 0u, odd = 0u;
#pragma unroll
    for (unsigned j = 0; j < 16; ++j) { const unsigned cj = c[j]; sum += cj; cnt += (cj > 0u) ? 1u : 0u; mine = (j == x) ? cj : mine; odd |= (j < 8u) ? (cj * 8u != G ? 1u : 0u) : (cj != 0u ? 1u : 0u); }
    if (sum != G) return false;
    uniform = odd ? 0u : 1u; nloc = mine > 0u ? mine : 1u; nx = cnt > 0u ? cnt : 1u; return true;
}

__device__ __forceinline__ void xcd_barrier(const XcdBarrier& b) {
    asm volatile("s_waitcnt vmcnt(0)" ::: "memory");
    __syncthreads();
    if (threadIdx.x == 0) {
        unsigned* bar = b.bar;
        __builtin_amdgcn_s_waitcnt(0);
        unsigned nloc = b.st[0], nx = b.st[1];
        unsigned old;
        if (nloc == 0u) {
            unsigned c[16], uni = 0u;
#pragma unroll
            for (unsigned j = 0; j < 16; ++j) c[j] = xb_ld(&bar[XB_XCNT(j)]);
            old = xb_add(&bar[XB_XSUB(b.x)], 1u);
            if (!xcd_census_eval(c, b.x, gridDim.x * gridDim.y * gridDim.z, nloc, nx, uni)) xcd_barrier_complete(bar, b.x, nloc, nx, uni);
            b.st[0] = nloc; b.st[1] = nx; b.st[3] = uni;
        } else old = xb_add(&bar[XB_XSUB(b.x)], 1u);
        const unsigned gen = old / nloc;
        if (old + 1u == (gen + 1u) * nloc) {
            __builtin_amdgcn_fence(__ATOMIC_RELEASE, "agent");
            asm volatile("s_waitcnt vmcnt(0)" ::: "memory");
            const unsigned og = xb_add(&bar[XB_TOP], 1u);
            const unsigned ttarget = (og / nx + 1u) * nx;
            if (og + 1u != ttarget) XB_SPIN(xb_ld(&bar[XB_TOP]) < ttarget, bar);
            __builtin_amdgcn_fence(__ATOMIC_ACQUIRE, "agent");
            xb_add(&bar[XB_XGEN(b.x)], 1u);
            asm volatile("s_waitcnt vmcnt(0)" ::: "memory");
        } else {
            XB_SPIN(xb_ld(&bar[XB_XGEN(b.x)]) == gen, bar);
            __builtin_amdgcn_fence(__ATOMIC_ACQUIRE, "agent");
            asm volatile("s_waitcnt vmcnt(0)" ::: "memory");
        }
    }
    __syncthreads();
}

__device__ __forceinline__ void xcd_local_barrier(const XcdBarrier& b) {
    asm volatile("s_waitcnt vmcnt(0)" ::: "memory");
    __syncthreads();
    if (threadIdx.x == 0) {
        unsigned* bar = b.bar;
        __builtin_amdgcn_s_waitcnt(0);
        const unsigned nloc = b.st[0];
        const unsigned old = xb_add(&bar[XB_LSUB(b.x)], 1u);
        const unsigned target = (old / nloc + 1u) * nloc;
        if (old + 1u != target) XB_SPIN(xb_ld(&bar[XB_LSUB(b.x)]) < target, bar);
        __builtin_amdgcn_fence(__ATOMIC_ACQUIRE, "agent");
        asm volatile("s_waitcnt vmcnt(0)" ::: "memory");
    }
    __syncthreads();
}


constexpr size_t MiB = 1u << 20;
constexpr size_t WS_CTL = 0, CTL_ZERO_BYTES = 1 * MiB;
constexpr size_t WS_WIN = 2 * MiB, WS_WOUT = 7 * MiB, WS_WGU = 9 * MiB, WS_WDN = 20 * MiB, WS_WPG = 26 * MiB, WS_WPP = 28 * MiB;
constexpr size_t WS_SS0 = 28 * MiB + 512 * 1024  , WS_SS1 = 29 * MiB, WS_SS2 = 30 * MiB;
constexpr size_t WS_CW16 = 31 * MiB;
constexpr size_t WS_XN = 32 * MiB;
constexpr size_t WS_Q = 64 * MiB, WS_KIMG = 80 * MiB, WS_VIMG = 96 * MiB, WS_U = 112 * MiB, WS_SLAB = 128 * MiB;
constexpr size_t WS_HM = 64 * MiB;
constexpr size_t WS_PB = 184 * MiB, WS_PROJ = 192 * MiB, WS_MIX = 224 * MiB, WS_END = 256 * MiB;
static_assert(WS_HM + (size_t)M * FF * 2 <= WS_PB && WS_SLAB + 56 * MiB <= WS_PB, "HM overlay");
constexpr int CW_TMO = 0, CW_CODE = 1, CW_QMAX = 32, CW_KMAX = 33, CW_KBAR = 34  , CW_QUEUE = 64, CW_UCNT = 1024  , CW_BAR = 4096;
constexpr int MAX_SPLIT_UNITS = 144;

constexpr int RING_OFF = 0, RING_BYTES = 131072;
constexpr int LDSCTL_OFF = RING_BYTES, MISC_OFF = LDSCTL_OFF + 320;
constexpr int LDS_BYTES = 147456;
constexpr int NWAVES = 8;

__device__ __forceinline__ float wave_sum(float v) {
    v += __uint_as_float((unsigned)__builtin_amdgcn_update_dpp(0, (int)__float_as_uint(v), 0xB1, 0xF, 0xF, true));
    v += __uint_as_float((unsigned)__builtin_amdgcn_update_dpp(0, (int)__float_as_uint(v), 0x4E, 0xF, 0xF, true));
    v += __uint_as_float((unsigned)__builtin_amdgcn_update_dpp(0, (int)__float_as_uint(v), 0x141, 0xF, 0xF, true));
    v += __uint_as_float((unsigned)__builtin_amdgcn_update_dpp(0, (int)__float_as_uint(v), 0x140, 0xF, 0xF, true));
    return pg8::sum_fq(v);
}
__device__ __forceinline__ float wave_max(float v) {
#pragma unroll
    for (int o = 1; o < 64; o <<= 1) v = fmaxf(v, __shfl_xor(v, o));
    return v;
}
__device__ __forceinline__ float bflo(unsigned w) { return __builtin_bit_cast(float, w << 16); }
__device__ __forceinline__ float bfhi(unsigned w) { return __builtin_bit_cast(float, w & 0xffff0000u); }

__device__ __forceinline__ void transpose_item(const float* W, int ldw, int K, bf16* WT, int k0, int n0, int dst0, LAS float* scr, int lane, const float* rowgain = nullptr) {
    float v[32];
#pragma unroll
    for (int i = 0; i < 32; ++i) { const int kk = 2 * i + (lane >> 5); v[i] = __builtin_nontemporal_load(&W[(size_t)(k0 + kk) * ldw + n0 + (lane & 31)]); }
    if (rowgain) {
#pragma unroll
        for (int i = 0; i < 32; ++i) v[i] *= rowgain[k0 + 2 * i + (lane >> 5)]; }
#pragma unroll
    for (int i = 0; i < 32; ++i) scr[(2 * i + (lane >> 5)) * 33 + (lane & 31)] = v[i];
    LDS_WAIT(); asm volatile("" ::: "memory");
    const int c = lane & 7;
#pragma unroll
    for (int j = 0; j < 4; ++j) { const int n = (lane >> 3) + 8 * j; const LAS float* s = scr + (8 * c) * 33 + n;
        v4u o; o.x = pk2(s[0 * 33], s[1 * 33]); o.y = pk2(s[2 * 33], s[3 * 33]); o.z = pk2(s[4 * 33], s[5 * 33]); o.w = pk2(s[6 * 33], s[7 * 33]);
        *(GAS v4u*)(WT + (size_t)(dst0 + n) * K + k0 + 8 * c) = o; }
    LDS_WAIT(); asm volatile("" ::: "memory");
}
__device__ __forceinline__ int in_dst_row(int s) {
    if (s < 1024) { const int part = s >> 9, sp = s & 511, tp = sp >> 8, sl = sp & 255, wc = sl >> 6, bj = (sl >> 5) & 1; return (part * 2 + tp) * 256 + 128 * bj + 32 * wc; }
    if (s < 1536) return s;
    if (s < 2048) { const int ch = s - 1536; return 1536 + 256 * (ch >> 7) + (ch & 127); }
    const int ch = s - 2048; return 1536 + 256 * (ch >> 7) + 128 + (ch & 127);
}
struct Args { const float* in[23]; float* out; unsigned char* ws; int ph_lo, ph_hi, li, pad; };

__device__ __forceinline__ void p0_prologue(const Args& a, LAS unsigned char* lds, int vcu, int G, int wave, int lane) {
    LAS float* scr = (LAS float*)(lds + RING_OFF + wave * 16384);
    const int gw = vcu * NWAVES + wave, NGW = G * NWAVES;
    unsigned char* ws = a.ws;
    constexpr int I_IN = 16 * 80, I_PP = 4 * 32;
    for (int it = gw; it < I_IN + I_PP; it += NGW) {
        if (it < I_IN) { const int kb = it / 80, nb = it % 80; transpose_item(a.in[3], NIN, DM, (bf16*)(ws + WS_WIN), 64 * kb, 32 * nb, in_dst_row(32 * nb), scr, lane, a.in[2]); }
        else { const int r = it - I_IN, kb = r / 32, nb = r % 32; transpose_item(a.in[22], DM, PD, (bf16*)(ws + WS_WPP), 64 * kb, 32 * nb, 32 * nb, scr, lane); }
    }
    for (int i = gw * 64 + lane; i < KC * 64; i += NGW * 64) {
        const f32x4 w0 = *(const f32x4*)(a.in[11] + 8 * i), w1 = *(const f32x4*)(a.in[11] + 8 * i + 4); v4u o;
        o.x = __builtin_bit_cast(unsigned, __builtin_amdgcn_cvt_pkrtz(w0.x, w0.y)); o.y = __builtin_bit_cast(unsigned, __builtin_amdgcn_cvt_pkrtz(w0.z, w0.w));
        o.z = __builtin_bit_cast(unsigned, __builtin_amdgcn_cvt_pkrtz(w1.x, w1.y)); o.w = __builtin_bit_cast(unsigned, __builtin_amdgcn_cvt_pkrtz(w1.z, w1.w));
        *(GAS v4u*)(ws + WS_CW16 + (size_t)i * 16) = o; }
    const float* x = a.in[0]; const float* p = a.in[1];
    bf16* XN = (bf16*)(ws + WS_XN); bf16* PB = (bf16*)(ws + WS_PB); float* SS0 = (float*)(ws + WS_SS0);
    const bool bal = (NGW == 2048) && (M == 16384); const bool item_wave = gw < I_IN + I_PP; const int w2 = gw - (I_IN + I_PP);
    const int nrows = !bal ? (M - gw + NGW - 1) / NGW : 7 + (item_wave ? ((gw % 22) < 15 ? 1 : 0) : (w2 + 640 < 1088 ? 2 : 1));
    for (int i = 0; i < nrows; ++i) {
        const int m = (!bal || i < 7) ? gw + NGW * i : (item_wave ? 15424 + (gw / 22) * 15 + gw % 22 : 14336 + w2 + 640 * (i - 7));
        const GAS f32x4* xr = (const GAS f32x4*)(x + (size_t)m * DM) + lane;
        f32x4 v[4]; float s = 0.f;
#pragma unroll
        for (int j = 0; j < 4; ++j) { v[j] = __builtin_nontemporal_load(&xr[64 * j]); s += (v[j].x * v[j].x + v[j].y * v[j].y) + (v[j].z * v[j].z + v[j].w * v[j].w); }
        GAS unsigned long long* o8 = (GAS unsigned long long*)(XN + (size_t)m * DM) + lane;
#pragma unroll
        for (int j = 0; j < 4; ++j) o8[64 * j] = (unsigned long long)pk2(v[j].x, v[j].y) | ((unsigned long long)pk2(v[j].z, v[j].w) << 32);
        const f32x4 pv = __builtin_nontemporal_load(&((const GAS f32x4*)(p + (size_t)m * PD))[lane]);
        ((GAS unsigned long long*)(PB + (size_t)m * PD))[lane] = (unsigned long long)pk2(pv.x, pv.y) | ((unsigned long long)pk2(pv.z, pv.w) << 32);
        s = wave_sum(s);
        if (lane == 0) SS0[m] = s;
    }
}
constexpr int WI_OUT = 16 * 32, WI_G = 16 * 88, WI_DN = 44 * 32, WI_PG = 16 * 32, W_ITEMS = WI_OUT + 2 * WI_G + WI_DN + WI_PG, N_W_UNITS = (W_ITEMS + 31) / 32;
__device__ __forceinline__ void weight_unit(int wu, const Args& a, LAS unsigned char* lds, int wave, int lane) {
    asm volatile("" : "+v"(lane));
    LAS float* scr = (LAS float*)(lds + RING_OFF + wave * 16384);
    unsigned char* ws = a.ws;
    for (int q = 0; q < 4; ++q) {
        int r = wu * 32 + wave * 4 + q; if (r >= W_ITEMS) break;
        if (r < WI_OUT) { const int kb = r / 32, nb = r % 32; transpose_item(a.in[15], DM, DM, (bf16*)(ws + WS_WOUT), 64 * kb, 32 * nb, 32 * nb, scr, lane); continue; } r -= WI_OUT;
        if (r < WI_G) { const int kb = r / 88, nb = r % 88, n0 = 32 * nb; transpose_item(a.in[17], FF, DM, (bf16*)(ws + WS_WGU), 64 * kb, n0, 256 * (n0 >> 7) + (n0 & 127), scr, lane, a.in[16]); continue; } r -= WI_G;
        if (r < WI_G) { const int kb = r / 88, nb = r % 88, n0 = 32 * nb; transpose_item(a.in[18], FF, DM, (bf16*)(ws + WS_WGU), 64 * kb, n0, 256 * (n0 >> 7) + 128 + (n0 & 127), scr, lane, a.in[16]); continue; } r -= WI_G;
        if (r < WI_DN) { const int kb = r / 32, nb = r % 32; transpose_item(a.in[19], DM, FF, (bf16*)(ws + WS_WDN), 64 * kb, 32 * nb, 32 * nb, scr, lane); continue; } r -= WI_DN;
        { const int kb = r / 32, nb = r % 32; transpose_item(a.in[21], DM, DM, (bf16*)(ws + WS_WPG), 64 * kb, 32 * nb, 32 * nb, scr, lane, a.in[20]); }
    }
    __syncthreads();
}

constexpr int CONV_ROWS = 32, CONV_RW = CONV_ROWS / NWAVES  , CONV_STAGE = CONV_ROWS + KC - 1  , CONV_W_LDS = 64 * 1024;
static_assert(CONV_RW == 4 && CONV_STAGE * 1024 <= CONV_W_LDS && CONV_W_LDS + KC * 1024 <= RING_BYTES, "conv unit LDS layout");
__device__ __forceinline__ void conv_unit(int cu, const bf16* U, const unsigned char* cw16, const float* cb, const float* lg, const float* lb, bf16* MIX, LAS unsigned char* lds, int tid, int wave, int lane, bool& w_staged, unsigned& nx, gu32* qctr) {
    asm volatile("" : "+v"(tid), "+v"(lane));
    const int r0 = cu * CONV_ROWS;
    const f32x4 b0 = *(const f32x4*)(cb + 8 * lane), b1 = *(const f32x4*)(cb + 8 * lane + 4);
    const f32x4 g0 = *(const f32x4*)(lg + 8 * lane), g1 = *(const f32x4*)(lg + 8 * lane + 4), c0 = *(const f32x4*)(lb + 8 * lane), c1 = *(const f32x4*)(lb + 8 * lane + 4);
    v4u wv[4] = {}; v4u uv[8];
    if (!w_staged) {
#pragma unroll
        for (int k = 0; k < 4; ++k) { const int i = tid + 512 * k; wv[k] = *(const GAS v4u*)(cw16 + (size_t)(i < KC * 64 ? i : 0) * 16); } }
#pragma unroll
    for (int k = 0; k < 8; ++k) { const int i = tid + 512 * k, rr = i >> 6, pc = i & 63, r = r0 - 15 + rr, rc = r < 0 ? 0 : (r > M - 1 ? M - 1 : r);
        uv[k] = *(const GAS v4u*)(U + (size_t)rc * CW + pc * 8); }
    if (!w_staged) {
#pragma unroll
        for (int k = 0; k < 4; ++k) { const int i = tid + 512 * k; if (i < KC * 64) *(LAS v4u*)(lds + CONV_W_LDS + i * 16) = wv[k]; }
        w_staged = true; }
#pragma unroll
    for (int k = 0; k < 8; ++k) { const int i = tid + 512 * k, rr = i >> 6, pc = i & 63, r = r0 - 15 + rr; const bool in = r >= 0 && r < M;
        v4u v = uv[k]; v.x = in ? v.x : 0u; v.y = in ? v.y : 0u; v.z = in ? v.z : 0u; v.w = in ? v.w : 0u;
        if (i < CONV_STAGE * 64) *(LAS v4u*)(lds + rr * 1024 + pc * 16) = v; }
    __builtin_amdgcn_s_waitcnt(0x0F70);
    if (tid == 0) nx = ticket_add(qctr);
    asm volatile("s_waitcnt lgkmcnt(0)\n\ts_barrier" ::: "memory");
    typedef _Float16 h2 __attribute__((ext_vector_type(2)));
    h2 hacc[CONV_RW][4];
    { const h2 i0 = __builtin_bit_cast(h2, __builtin_amdgcn_cvt_pkrtz(b0.x, b0.y)), i1 = __builtin_bit_cast(h2, __builtin_amdgcn_cvt_pkrtz(b0.z, b0.w)), i2 = __builtin_bit_cast(h2, __builtin_amdgcn_cvt_pkrtz(b1.x, b1.y)), i3 = __builtin_bit_cast(h2, __builtin_amdgcn_cvt_pkrtz(b1.z, b1.w));
#pragma unroll
      for (int j = 0; j < CONV_RW; ++j) { hacc[j][0] = i0; hacc[j][1] = i1; hacc[j][2] = i2; hacc[j][3] = i3; } }
    {
        typedef _Float16 h8 __attribute__((ext_vector_type(8)));
        const LAS unsigned char* ub = lds + (wave * CONV_RW) * 1024 + lane * 16; const LAS unsigned char* wb = lds + CONV_W_LDS + lane * 16;
        h8 uu[CONV_RW];
#pragma unroll
        for (int j = 0; j < CONV_RW - 1; ++j) uu[j] = *(const LAS h8*)(ub + j * 1024);
        h8 kw = *(const LAS h8*)(wb);
#pragma unroll
        for (int t = 0; t < KC; ++t) {
            uu[(t + CONV_RW - 1) & (CONV_RW - 1)] = *(const LAS h8*)(ub + (t + CONV_RW - 1) * 1024);
            const h8 kwn = *(const LAS h8*)(wb + (t + 1 < KC ? t + 1 : t) * 1024);
            const h2 k0 = __builtin_shufflevector(kw, kw, 0, 1), k1 = __builtin_shufflevector(kw, kw, 2, 3), k2 = __builtin_shufflevector(kw, kw, 4, 5), k3 = __builtin_shufflevector(kw, kw, 6, 7);
#pragma unroll
            for (int j = 0; j < CONV_RW; ++j) { const h8 u = uu[(t + j) & (CONV_RW - 1)];
                hacc[j][0] = __builtin_shufflevector(u, u, 0, 1) * k0 + hacc[j][0]; hacc[j][1] = __builtin_shufflevector(u, u, 2, 3) * k1 + hacc[j][1];
                hacc[j][2] = __builtin_shufflevector(u, u, 4, 5) * k2 + hacc[j][2]; hacc[j][3] = __builtin_shufflevector(u, u, 6, 7) * k3 + hacc[j][3]; }
            kw = kwn;
        }
    }
    float NLOG2E = -LOG2E; asm volatile("" : "+s"(NLOG2E));
#pragma unroll
    for (int j = 0; j < CONV_RW; ++j) {
        f32x4 a0 = {(float)hacc[j][0][0], (float)hacc[j][0][1], (float)hacc[j][1][0], (float)hacc[j][1][1]}, a1 = {(float)hacc[j][2][0], (float)hacc[j][2][1], (float)hacc[j][3][0], (float)hacc[j][3][1]};
        const f32x4 s4 = a0 + a1;
        const float mu = wave_sum((s4[0] + s4[1]) + (s4[2] + s4[3])) * (1.f / CW);
        a0 -= mu; a1 -= mu;
        const f32x4 q4 = a0 * a0 + a1 * a1;
        const float r = __builtin_amdgcn_rsqf(wave_sum((q4[0] + q4[1]) + (q4[2] + q4[3])) * (1.f / CW) + EPS);
        const f32x4 rg0 = g0 * r, rg1 = g1 * r;
        const f32x4 z0 = a0 * rg0 + c0, z1 = a1 * rg1 + c1;
        const f32x4 t0 = z0 * NLOG2E, t1 = z1 * NLOG2E;
        const f32x4 d0 = (f32x4){__builtin_amdgcn_exp2f(t0[0]), __builtin_amdgcn_exp2f(t0[1]), __builtin_amdgcn_exp2f(t0[2]), __builtin_amdgcn_exp2f(t0[3])} + 1.f;
        const f32x4 d1 = (f32x4){__builtin_amdgcn_exp2f(t1[0]), __builtin_amdgcn_exp2f(t1[1]), __builtin_amdgcn_exp2f(t1[2]), __builtin_amdgcn_exp2f(t1[3])} + 1.f;
        const f32x4 y0 = z0 * (f32x4){__builtin_amdgcn_rcpf(d0[0]), __builtin_amdgcn_rcpf(d0[1]), __builtin_amdgcn_rcpf(d0[2]), __builtin_amdgcn_rcpf(d0[3])};
        const f32x4 y1 = z1 * (f32x4){__builtin_amdgcn_rcpf(d1[0]), __builtin_amdgcn_rcpf(d1[1]), __builtin_amdgcn_rcpf(d1[2]), __builtin_amdgcn_rcpf(d1[3])};
        v4u o; o.x = pk2(y0[0], y0[1]); o.y = pk2(y0[2], y0[3]); o.z = pk2(y1[0], y1[1]); o.w = pk2(y1[2], y1[3]);
        *(GAS v4u*)(MIX + (size_t)(r0 + wave * CONV_RW + j) * DM + AW + 8 * lane) = o;
    }
    asm volatile("s_waitcnt lgkmcnt(0)\n\ts_barrier" ::: "memory");
}

namespace att {
typedef short bf16x8 __attribute__((ext_vector_type(8)));
typedef short s16x4 __attribute__((ext_vector_type(4)));
typedef float f32x16 __attribute__((ext_vector_type(16)));
typedef float f32x4 __attribute__((ext_vector_type(4)));
typedef unsigned u32x4 __attribute__((ext_vector_type(4)));
constexpr int LDS_HN = 8 * 16384 + 13312;
constexpr int SLOT = 16384, LDS_K = 0, LDS_V = 4 * SLOT, LDS_WS = 8 * SLOT + 4096  , XSTRIDE = 132, SLAB_FLOATS = 8 * 4160;
typedef __attribute__((address_space(3))) const char* lds_cptr;
typedef short v4i16_t __attribute__((ext_vector_type(4)));
__device__ __forceinline__ int crow(int r, int hi) { return (r & 3) + 8 * (r >> 2) + 4 * hi; }
__device__ __forceinline__ void glds2k(const unsigned char* sbase, unsigned voff, unsigned lds_dst) { unsigned keep; const unsigned lds_dst2 = lds_dst + 1024u, voff2 = voff + 1024u;
    asm volatile("s_mov_b32 %0, m0\n\ts_mov_b32 m0, %3\n\ts_nop 0\n\tglobal_load_lds_dwordx4 %1, %2\n\ts_nop 0\n\ts_mov_b32 m0, %4\n\ts_nop 0\n\tglobal_load_lds_dwordx4 %5, %2\n\ts_nop 0\n\ts_mov_b32 m0, %0"
                 : "=&s"(keep) : "v"(voff), "s"(sbase), "s"(lds_dst), "s"(lds_dst2), "v"(voff2) : "memory"); }
#define ATT_LDS_BAR() asm volatile("s_waitcnt lgkmcnt(0)\n\ts_barrier" ::: "memory")
#define ATT_WAIT_BAR(N) asm volatile("s_waitcnt vmcnt(" #N ") lgkmcnt(0)\n\ts_barrier" ::: "memory")
__device__ __forceinline__ unsigned cvtpk(float lo, float hi) { unsigned r; asm volatile("v_cvt_pk_bf16_f32 %0, %1, %2" : "=v"(r) : "v"(lo), "v"(hi)); return r; }
__device__ __forceinline__ int v_rd_base(int lane) { return ((lane >> 4) & 1) * 32 + (lane & 3) * 8 + (4 * (lane >> 5) + ((lane & 15) >> 2)) * 64; }
__device__ __forceinline__ s16x4 vtr(lds_cptr p) { return __builtin_bit_cast(s16x4, __builtin_amdgcn_ds_read_tr16_b64_v4i16((__attribute__((address_space(3))) v4i16_t*)p)); }
#define SBAR() __builtin_amdgcn_sched_barrier(0)
__device__ __forceinline__ void qkt_acc(f32x16& p0, f32x16& p1, lds_cptr kp, const bf16x8* qr) {
#pragma unroll
    for (int d0 = 0; d0 < 4; ++d0) {
        const bf16x8 b0 = *(const __attribute__((address_space(3))) bf16x8*)(kp + d0 * 2048);
        const bf16x8 b1 = *(const __attribute__((address_space(3))) bf16x8*)(kp + d0 * 2048 + 512);
        p0 = __builtin_amdgcn_mfma_f32_32x32x16_bf16(b0, qr[d0], p0, 0, 0, 0);
        p1 = __builtin_amdgcn_mfma_f32_32x32x16_bf16(b1, qr[d0], p1, 0, 0, 0);
    }
}
__device__ __forceinline__ void bias_general(f32x16& p0, f32x16& p1, float dq, float nslope2, float shift2) {
#pragma unroll
    for (int r = 0; r < 16; ++r) { const float c = (float)((r & 3) + 8 * (r >> 2)); p0[r] = __builtin_fmaf(nslope2, __builtin_fabsf(dq - c), -shift2); p1[r] = __builtin_fmaf(nslope2, __builtin_fabsf(dq - (c + 32.f)), -shift2); }
}
__device__ __forceinline__ void softmax_first(f32x16& p0, f32x16& p1, bf16x8& pa0, bf16x8& pa1, bf16x8& pa2) {
#pragma unroll
    for (int r = 0; r < 16; ++r) { p0[r] = __builtin_amdgcn_exp2f(p0[r]); p1[r] = __builtin_amdgcn_exp2f(p1[r]); }
    { u32x4 w = {cvtpk(p0[0], p0[1]), cvtpk(p0[2], p0[3]), cvtpk(p0[4], p0[5]), cvtpk(p0[6], p0[7])}; pa0 = __builtin_bit_cast(bf16x8, w); }
    { u32x4 w = {cvtpk(p0[8], p0[9]), cvtpk(p0[10], p0[11]), cvtpk(p0[12], p0[13]), cvtpk(p0[14], p0[15])}; pa1 = __builtin_bit_cast(bf16x8, w); }
    { u32x4 w = {cvtpk(p1[0], p1[1]), cvtpk(p1[2], p1[3]), cvtpk(p1[4], p1[5]), cvtpk(p1[6], p1[7])}; pa2 = __builtin_bit_cast(bf16x8, w); }
}
template <int KBITS> __device__ __forceinline__ float fmamk_s(float a, float c) { float r; asm("v_fmamk_f32 %0, %1, %2, %3" : "=v"(r) : "v"(a), "n"(KBITS), "v"(c)); return r; }
#define ATT_ROT3(x) do { (x) = ((x) + SLOT) & (4 * SLOT - 1); } while (0)
#define ATT_DMA2(src, tile, dstoff) do { int t_ = (tile); t_ = t_ < t_hi ? t_ : t_hi; glds2k((src) + (size_t)t_ * SLOT, lane16, (unsigned)(dstoff)); } while (0)
#define ATT_ISSUE_DMA() do { ATT_DMA2(ksrc, tj + 4, kdst + sk_dma); ATT_DMA2(vsrc, tj + 2, vdst + sv_dma); ++tj; } while (0)
#define ATT_STEP(P0, P1, X0, X1, DO_EXP, DO_QK, JJ) do { \
    if (lead_half || (JJ) == 0) { ATT_WAIT_BAR(4); } \
    ATT_ISSUE_DMA(); \
    { const lds_cptr vb_ = vp0 + sv_cur; const lds_cptr kb_ = kp0 + sk_cur; \
      s16x4 vl0, vh0, vl1, vh1, vl2, vh2; bf16x8 kf0, kf1, kf2; unsigned t0_, t1_, t2_, t3_; \
      const int k02_ = (tj + 1) * 64  ; const bool right_ = k02_ >= qw0 + 31, mixed_ = !right_ && (k02_ + 63 > qw0); \
      const float dq2_ = dq1 - 64.f, ss_ = right_ ? nslope2 : -nslope2, xl0_ = __builtin_fmaf(-ss_, dq2_, -shift2), xl1_ = __builtin_fmaf(ss_, 32.f, xl0_); \
      vl0 = vtr(vb_ + 0); vh0 = vtr(vb_ + 512); vl1 = vtr(vb_ + 4096); vh1 = vtr(vb_ + 4608); SBAR(); \
      vl2 = vtr(vb_ + 8192); vh2 = vtr(vb_ + 8704); o[0] = __builtin_amdgcn_mfma_f32_32x32x16_bf16(pa0, (bf16x8){vl0[0], vl0[1], vl0[2], vl0[3], vh0[0], vh0[1], vh0[2], vh0[3]}, o[0], 0, 0, 0); if (DO_EXP) { X0[0] = __builtin_amdgcn_exp2f(X0[0]); } t0_ = cvtpk(P1[8], P1[9]); t1_ = cvtpk(P1[10], P1[11]); SBAR(); \
      vl0 = vtr(vb_ + 12288); vh0 = vtr(vb_ + 12800); o[1] = __builtin_amdgcn_mfma_f32_32x32x16_bf16(pa0, (bf16x8){vl1[0], vl1[1], vl1[2], vl1[3], vh1[0], vh1[1], vh1[2], vh1[3]}, o[1], 0, 0, 0); if (DO_EXP) { X0[1] = __builtin_amdgcn_exp2f(X0[1]); } t2_ = cvtpk(P1[12], P1[13]); t3_ = cvtpk(P1[14], P1[15]); { u32x4 w_ = {t0_, t1_, t2_, t3_}; pa3 = __builtin_bit_cast(bf16x8, w_); } SBAR(); \
      vl1 = vtr(vb_ + 1024); vh1 = vtr(vb_ + 1536); o[2] = __builtin_amdgcn_mfma_f32_32x32x16_bf16(pa0, (bf16x8){vl2[0], vl2[1], vl2[2], vl2[3], vh2[0], vh2[1], vh2[2], vh2[3]}, o[2], 0, 0, 0); if (DO_EXP) { X0[2] = __builtin_amdgcn_exp2f(X0[2]); } if (DO_EXP) { X0[3] = __builtin_amdgcn_exp2f(X0[3]); } SBAR(); \
      vl2 = vtr(vb_ + 5120); vh2 = vtr(vb_ + 5632); o[3] = __builtin_amdgcn_mfma_f32_32x32x16_bf16(pa0, (bf16x8){vl0[0], vl0[1], vl0[2], vl0[3], vh0[0], vh0[1], vh0[2], vh0[3]}, o[3], 0, 0, 0); lacc4 = __builtin_amdgcn_mfma_f32_16x16x32_bf16(lmask, pa0, lacc4, 0, 0, 0); if (DO_EXP) { X0[4] = __builtin_amdgcn_exp2f(X0[4]); } if (DO_QK) { P0[0] = fmamk_s<0>(ss_, xl0_); } if (DO_QK) { P0[1] = fmamk_s<1065353216>(ss_, xl0_); } if (DO_QK) { P0[2] = fmamk_s<1073741824>(ss_, xl0_); } SBAR(); \
      vl0 = vtr(vb_ + 9216); vh0 = vtr(vb_ + 9728); o[0] = __builtin_amdgcn_mfma_f32_32x32x16_bf16(pa1, (bf16x8){vl1[0], vl1[1], vl1[2], vl1[3], vh1[0], vh1[1], vh1[2], vh1[3]}, o[0], 0, 0, 0); if (DO_EXP) { X0[5] = __builtin_amdgcn_exp2f(X0[5]); } if (DO_QK) { P0[3] = fmamk_s<1077936128>(ss_, xl0_); } if (DO_QK) { P0[4] = fmamk_s<1090519040>(ss_, xl0_); } SBAR(); \
      vl1 = vtr(vb_ + 13312); vh1 = vtr(vb_ + 13824); o[1] = __builtin_amdgcn_mfma_f32_32x32x16_bf16(pa1, (bf16x8){vl2[0], vl2[1], vl2[2], vl2[3], vh2[0], vh2[1], vh2[2], vh2[3]}, o[1], 0, 0, 0); if (DO_EXP) { X0[6] = __builtin_amdgcn_exp2f(X0[6]); } if (DO_EXP) { X0[7] = __builtin_amdgcn_exp2f(X0[7]); } if (DO_QK) { P0[5] = fmamk_s<1091567616>(ss_, xl0_); } if (DO_QK) { P0[6] = fmamk_s<1092616192>(ss_, xl0_); } if (DO_QK) { P0[7] = fmamk_s<1093664768>(ss_, xl0_); } SBAR(); \
      vl2 = vtr(vb_ + 2048); vh2 = vtr(vb_ + 2560); o[2] = __builtin_amdgcn_mfma_f32_32x32x16_bf16(pa1, (bf16x8){vl0[0], vl0[1], vl0[2], vl0[3], vh0[0], vh0[1], vh0[2], vh0[3]}, o[2], 0, 0, 0); if (DO_EXP) { X0[8] = __builtin_amdgcn_exp2f(X0[8]); } if (DO_EXP) { t0_ = cvtpk(X0[0], X0[1]); t1_ = cvtpk(X0[2], X0[3]); } if (DO_QK) { P0[8] = fmamk_s<1098907648>(ss_, xl0_); } if (DO_QK) { P0[9] = fmamk_s<1099431936>(ss_, xl0_); } SBAR(); \
      vl0 = vtr(vb_ + 6144); vh0 = vtr(vb_ + 6656); o[3] = __builtin_amdgcn_mfma_f32_32x32x16_bf16(pa1, (bf16x8){vl1[0], vl1[1], vl1[2], vl1[3], vh1[0], vh1[1], vh1[2], vh1[3]}, o[3], 0, 0, 0); lacc4 = __builtin_amdgcn_mfma_f32_16x16x32_bf16(lmask, pa1, lacc4, 0, 0, 0); if (DO_EXP) { X0[9] = __builtin_amdgcn_exp2f(X0[9]); } if (DO_EXP) { t2_ = cvtpk(X0[4], X0[5]); t3_ = cvtpk(X0[6], X0[7]); { u32x4 w_ = {t0_, t1_, t2_, t3_}; pa0 = __builtin_bit_cast(bf16x8, w_); } } if (DO_QK) { P0[10] = fmamk_s<1099956224>(ss_, xl0_); } if (DO_QK) { P0[11] = fmamk_s<1100480512>(ss_, xl0_); } if (DO_QK) { P0[12] = fmamk_s<1103101952>(ss_, xl0_); } SBAR(); \
      vl1 = vtr(vb_ + 10240); vh1 = vtr(vb_ + 10752); o[0] = __builtin_amdgcn_mfma_f32_32x32x16_bf16(pa2, (bf16x8){vl2[0], vl2[1], vl2[2], vl2[3], vh2[0], vh2[1], vh2[2], vh2[3]}, o[0], 0, 0, 0); if (DO_EXP) { X0[10] = __builtin_amdgcn_exp2f(X0[10]); } if (DO_EXP) { X0[11] = __builtin_amdgcn_exp2f(X0[11]); } if (DO_QK) { P0[13] = fmamk_s<1103626240>(ss_, xl0_); } if (DO_QK) { P0[14] = fmamk_s<1104150528>(ss_, xl0_); } SBAR(); \
      vl2 = vtr(vb_ + 14336); vh2 = vtr(vb_ + 14848); o[1] = __builtin_amdgcn_mfma_f32_32x32x16_bf16(pa2, (bf16x8){vl0[0], vl0[1], vl0[2], vl0[3], vh0[0], vh0[1], vh0[2], vh0[3]}, o[1], 0, 0, 0); if (DO_EXP) { X0[12] = __builtin_amdgcn_exp2f(X0[12]); } if (DO_QK) { P0[15] = fmamk_s<1104674816>(ss_, xl0_); } if (DO_QK) { P1[0] = fmamk_s<0>(ss_, xl1_); } if (DO_QK) { P1[1] = fmamk_s<1065353216>(ss_, xl1_); } SBAR(); \
      vl0 = vtr(vb_ + 3072); vh0 = vtr(vb_ + 3584); o[2] = __builtin_amdgcn_mfma_f32_32x32x16_bf16(pa2, (bf16x8){vl1[0], vl1[1], vl1[2], vl1[3], vh1[0], vh1[1], vh1[2], vh1[3]}, o[2], 0, 0, 0); if (DO_EXP) { X0[13] = __builtin_amdgcn_exp2f(X0[13]); } if (DO_QK) { P1[2] = fmamk_s<1073741824>(ss_, xl1_); } if (DO_QK) { P1[3] = fmamk_s<1077936128>(ss_, xl1_); } SBAR(); \
      vl1 = vtr(vb_ + 7168); vh1 = vtr(vb_ + 7680); o[3] = __builtin_amdgcn_mfma_f32_32x32x16_bf16(pa2, (bf16x8){vl2[0], vl2[1], vl2[2], vl2[3], vh2[0], vh2[1], vh2[2], vh2[3]}, o[3], 0, 0, 0); lacc4 = __builtin_amdgcn_mfma_f32_16x16x32_bf16(lmask, pa2, lacc4, 0, 0, 0); if (DO_EXP) { X0[14] = __builtin_amdgcn_exp2f(X0[14]); } if (DO_EXP) { X0[15] = __builtin_amdgcn_exp2f(X0[15]); } if (DO_QK) { P1[4] = fmamk_s<1090519040>(ss_, xl1_); } if (DO_QK) { P1[5] = fmamk_s<1091567616>(ss_, xl1_); } if (DO_QK) { P1[6] = fmamk_s<1092616192>(ss_, xl1_); } SBAR(); \
      if (!lead_half && (JJ) + 1 < NT) { ATT_WAIT_BAR(4); }     \
      vl2 = vtr(vb_ + 11264); vh2 = vtr(vb_ + 11776); o[0] = __builtin_amdgcn_mfma_f32_32x32x16_bf16(pa3, (bf16x8){vl0[0], vl0[1], vl0[2], vl0[3], vh0[0], vh0[1], vh0[2], vh0[3]}, o[0], 0, 0, 0); if (DO_EXP) { X1[0] = __builtin_amdgcn_exp2f(X1[0]); } if (DO_EXP) { t0_ = cvtpk(X0[8], X0[9]); t1_ = cvtpk(X0[10], X0[11]); } if (DO_QK) { P1[7] = fmamk_s<1093664768>(ss_, xl1_); } if (DO_QK) { P1[8] = fmamk_s<1098907648>(ss_, xl1_); } SBAR(); \
      vl0 = vtr(vb_ + 15360); vh0 = vtr(vb_ + 15872); o[1] = __builtin_amdgcn_mfma_f32_32x32x16_bf16(pa3, (bf16x8){vl1[0], vl1[1], vl1[2], vl1[3], vh1[0], vh1[1], vh1[2], vh1[3]}, o[1], 0, 0, 0); if (DO_EXP) { X1[1] = __builtin_amdgcn_exp2f(X1[1]); } if (DO_EXP) { t2_ = cvtpk(X0[12], X0[13]); t3_ = cvtpk(X0[14], X0[15]); { u32x4 w_ = {t0_, t1_, t2_, t3_}; pa1 = __builtin_bit_cast(bf16x8, w_); } } if (DO_QK) { P1[9] = fmamk_s<1099431936>(ss_, xl1_); } if (DO_QK) { P1[10] = fmamk_s<1099956224>(ss_, xl1_); } if (DO_QK) { P1[11] = fmamk_s<1100480512>(ss_, xl1_); } SBAR(); \
      if (DO_QK) kf0 = *(const __attribute__((address_space(3))) bf16x8*)(kb_ + 0); o[2] = __builtin_amdgcn_mfma_f32_32x32x16_bf16(pa3, (bf16x8){vl2[0], vl2[1], vl2[2], vl2[3], vh2[0], vh2[1], vh2[2], vh2[3]}, o[2], 0, 0, 0); if (DO_EXP) { X1[2] = __builtin_amdgcn_exp2f(X1[2]); } if (DO_EXP) { X1[3] = __builtin_amdgcn_exp2f(X1[3]); } if (DO_QK) { P1[12] = fmamk_s<1103101952>(ss_, xl1_); } if (DO_QK) { P1[13] = fmamk_s<1103626240>(ss_, xl1_); } SBAR(); \
      if (DO_QK) kf1 = *(const __attribute__((address_space(3))) bf16x8*)(kb_ + 512); o[3] = __builtin_amdgcn_mfma_f32_32x32x16_bf16(pa3, (bf16x8){vl0[0], vl0[1], vl0[2], vl0[3], vh0[0], vh0[1], vh0[2], vh0[3]}, o[3], 0, 0, 0); lacc4 = __builtin_amdgcn_mfma_f32_16x16x32_bf16(lmask, pa3, lacc4, 0, 0, 0); if (DO_EXP) { X1[4] = __builtin_amdgcn_exp2f(X1[4]); } if (DO_QK) { P1[14] = fmamk_s<1104150528>(ss_, xl1_); } if (DO_QK) { P1[15] = fmamk_s<1104674816>(ss_, xl1_); } SBAR(); if (DO_QK && mixed_) { const float c2_ = -2.f * nslope2; P0[0] += c2_ * __builtin_fminf(dq2_ - 0.f, 0.f); P0[1] += c2_ * __builtin_fminf(dq2_ - 1.f, 0.f); P0[2] += c2_ * __builtin_fminf(dq2_ - 2.f, 0.f); P0[3] += c2_ * __builtin_fminf(dq2_ - 3.f, 0.f); P0[4] += c2_ * __builtin_fminf(dq2_ - 8.f, 0.f); P0[5] += c2_ * __builtin_fminf(dq2_ - 9.f, 0.f); P0[6] += c2_ * __builtin_fminf(dq2_ - 10.f, 0.f); P0[7] += c2_ * __builtin_fminf(dq2_ - 11.f, 0.f); P0[8] += c2_ * __builtin_fminf(dq2_ - 16.f, 0.f); P0[9] += c2_ * __builtin_fminf(dq2_ - 17.f, 0.f); P0[10] += c2_ * __builtin_fminf(dq2_ - 18.f, 0.f); P0[11] += c2_ * __builtin_fminf(dq2_ - 19.f, 0.f); P0[12] += c2_ * __builtin_fminf(dq2_ - 24.f, 0.f); P0[13] += c2_ * __builtin_fminf(dq2_ - 25.f, 0.f); P0[14] += c2_ * __builtin_fminf(dq2_ - 26.f, 0.f); P0[15] += c2_ * __builtin_fminf(dq2_ - 27.f, 0.f); P1[0] += c2_ * __builtin_fminf(dq2_ - 32.f, 0.f); P1[1] += c2_ * __builtin_fminf(dq2_ - 33.f, 0.f); P1[2] += c2_ * __builtin_fminf(dq2_ - 34.f, 0.f); P1[3] += c2_ * __builtin_fminf(dq2_ - 35.f, 0.f); P1[4] += c2_ * __builtin_fminf(dq2_ - 40.f, 0.f); P1[5] += c2_ * __builtin_fminf(dq2_ - 41.f, 0.f); P1[6] += c2_ * __builtin_fminf(dq2_ - 42.f, 0.f); P1[7] += c2_ * __builtin_fminf(dq2_ - 43.f, 0.f); P1[8] += c2_ * __builtin_fminf(dq2_ - 48.f, 0.f); P1[9] += c2_ * __builtin_fminf(dq2_ - 49.f, 0.f); P1[10] += c2_ * __builtin_fminf(dq2_ - 50.f, 0.f); P1[11] += c2_ * __builtin_fminf(dq2_ - 51.f, 0.f); P1[12] += c2_ * __builtin_fminf(dq2_ - 56.f, 0.f); P1[13] += c2_ * __builtin_fminf(dq2_ - 57.f, 0.f); P1[14] += c2_ * __builtin_fminf(dq2_ - 58.f, 0.f); P1[15] += c2_ * __builtin_fminf(dq2_ - 59.f, 0.f); } SBAR(); \
      if (DO_QK) kf2 = *(const __attribute__((address_space(3))) bf16x8*)(kb_ + 2048); if (DO_QK) P0 = __builtin_amdgcn_mfma_f32_32x32x16_bf16(kf0, qr[0], P0, 0, 0, 0); if (DO_EXP) { X1[5] = __builtin_amdgcn_exp2f(X1[5]); } SBAR(); \
      if (DO_QK) kf0 = *(const __attribute__((address_space(3))) bf16x8*)(kb_ + 2560); if (DO_QK) P1 = __builtin_amdgcn_mfma_f32_32x32x16_bf16(kf1, qr[0], P1, 0, 0, 0); if (DO_EXP) { X1[6] = __builtin_amdgcn_exp2f(X1[6]); } if (DO_EXP) { X1[7] = __builtin_amdgcn_exp2f(X1[7]); } SBAR(); \
      if (DO_QK) kf1 = *(const __attribute__((address_space(3))) bf16x8*)(kb_ + 4096); if (DO_QK) P0 = __builtin_amdgcn_mfma_f32_32x32x16_bf16(kf2, qr[1], P0, 0, 0, 0); if (DO_EXP) { X1[8] = __builtin_amdgcn_exp2f(X1[8]); } if (DO_EXP) { t0_ = cvtpk(X1[0], X1[1]); t1_ = cvtpk(X1[2], X1[3]); } SBAR(); \
      if (DO_QK) kf2 = *(const __attribute__((address_space(3))) bf16x8*)(kb_ + 4608); if (DO_QK) P1 = __builtin_amdgcn_mfma_f32_32x32x16_bf16(kf0, qr[1], P1, 0, 0, 0); if (DO_EXP) { X1[9] = __builtin_amdgcn_exp2f(X1[9]); } if (DO_EXP) { t2_ = cvtpk(X1[4], X1[5]); t3_ = cvtpk(X1[6], X1[7]); { u32x4 w_ = {t0_, t1_, t2_, t3_}; pa2 = __builtin_bit_cast(bf16x8, w_); } } SBAR(); \
      if (DO_QK) kf0 = *(const __attribute__((address_space(3))) bf16x8*)(kb_ + 6144); if (DO_QK) P0 = __builtin_amdgcn_mfma_f32_32x32x16_bf16(kf1, qr[2], P0, 0, 0, 0); if (DO_EXP) { X1[10] = __builtin_amdgcn_exp2f(X1[10]); } if (DO_EXP) { X1[11] = __builtin_amdgcn_exp2f(X1[11]); } SBAR(); \
      if (DO_QK) kf1 = *(const __attribute__((address_space(3))) bf16x8*)(kb_ + 6656); if (DO_QK) P1 = __builtin_amdgcn_mfma_f32_32x32x16_bf16(kf2, qr[2], P1, 0, 0, 0); if (DO_EXP) { X1[12] = __builtin_amdgcn_exp2f(X1[12]); } SBAR(); \
      if (DO_QK) P0 = __builtin_amdgcn_mfma_f32_32x32x16_bf16(kf0, qr[3], P0, 0, 0, 0); if (DO_EXP) { X1[13] = __builtin_amdgcn_exp2f(X1[13]); } SBAR(); \
      if (DO_QK) P1 = __builtin_amdgcn_mfma_f32_32x32x16_bf16(kf1, qr[3], P1, 0, 0, 0); if (DO_EXP) { X1[14] = __builtin_amdgcn_exp2f(X1[14]); } if (DO_EXP) { X1[15] = __builtin_amdgcn_exp2f(X1[15]); } SBAR(); \
    } \
    dq1 -= 64.f; ATT_ROT3(sk_cur); ATT_ROT3(sv_cur); ATT_ROT3(sk_dma); ATT_ROT3(sv_dma); } while (0)

struct UnitDesc { int u, h, qb, nc, ci, sid, t_lo, t_hi; float slope; };
constexpr int RTAB_FROM_PRE = 14464 - 1024;
constexpr int ITEM_FROM_PRE = 8192 - 1024;
__device__ __forceinline__ float att_window(float Bn, float Cn, float slope, int tq) {
    float blk = 1e30f;
#pragma unroll
    for (int e = 0; e < 7; ++e) { const float Tm = (float)(1 << e) * slope; blk = fminf(blk, 32.f * Tm - __logf(64.f * Tm)); }
    { const float x = __expf(-64.f * slope), g = x / (1.f - x);
      const float gl = g * (1.f - __expf(-64.f * slope * (float)tq)), gr = g * (1.f - __expf(-64.f * slope * (float)(254 - tq)));
      blk = fminf(blk, 32.f * slope - __logf(64.f * slope * (1.f + gl + gr))); }
    float lnphi = 0.f;
    if (Bn > 1e-3f) { const float c = fminf(Cn, Bn), rho = ((Bn + c) + (Bn - c) * __expf(-2.f * Bn)) / (2.f * Bn);
                      const float kappa = 64.f * __expf(-63.f * slope) * (1.f - __expf(-slope)) / (1.f - __expf(-64.f * slope));
                      const float phi = 1.f - kappa * (1.f - rho); lnphi = phi > 0.f && phi < 1.f ? __logf(phi) + 1e-3f : 0.f; }
    const float k0 = 18.04f + __logf(slope / (1.f - __expf(-slope)));
    const float a1 = 2.f * Bn + k0, a2 = Bn + Cn + blk + k0;
    if (ATT_EXACT_ZERO) return (104.f + 2.f * Bn) / slope;
    const float a_one = fminf(a1, a2) + lnphi - 0.6931f, a_two = a_one + __logf(1.f + __expf(-127.f * slope)) + 1e-3f, r_one = a_one / slope;
    const int R1 = r_one < 20000.f ? (int)r_one + 1 : 20000, q0 = 64 * tq;
    const bool one_sided = (q0 - R1 <= 0) || (q0 + 127 + R1 >= M - 1);
    return one_sided ? r_one : a_two / slope;
}
__device__ __forceinline__ UnitDesc decode_unit(int idx, float Bn, float Cn, const __attribute__((address_space(3))) unsigned short* pre, const __attribute__((address_space(3))) unsigned short* sidx) {
    UnitDesc d;
    const unsigned it_ = (unsigned)__builtin_amdgcn_readfirstlane((int)((const __attribute__((address_space(3))) unsigned*)((const __attribute__((address_space(3))) unsigned char*)pre + ITEM_FROM_PRE))[idx]);
    d.u = (int)(it_ & 511u); d.ci = (int)((it_ >> 10) & 3u); d.nc = (int)((it_ >> 12) & 3u); d.sid = __builtin_amdgcn_readfirstlane((int)sidx[d.u]);
    const int k = d.u & 127; d.h = 3 - (d.u >> 7); d.qb = (k & 1) ? 63 - (k >> 1) : 64 + (k >> 1);
    d.slope = exp2f(-2.f * (float)(d.h + 1));
    const int R = __builtin_amdgcn_readfirstlane((int)((const __attribute__((address_space(3))) unsigned short*)((const __attribute__((address_space(3))) unsigned char*)pre + RTAB_FROM_PRE))[d.u]);
    const int q0 = d.qb * 128; const int klo = q0 - R < 0 ? 0 : q0 - R, khi = q0 + 127 + R > M - 1 ? M - 1 : q0 + 127 + R;
    const int tlo = klo >> 6, nt = (khi >> 6) - tlo + 1, base = nt / d.nc, rem = nt - base * d.nc;
    d.t_lo = tlo + d.ci * base + (d.ci < rem ? d.ci : rem); d.t_hi = d.t_lo + base + (d.ci < rem ? 1 : 0) - 1;
    return d;
}
__device__ __forceinline__ void attn_unit(int idx, float Bn, float Cn, float lam, const __attribute__((address_space(3))) unsigned short* pre, const __attribute__((address_space(3))) unsigned short* sidx,
                                          const unsigned short* Q, const unsigned char* Kimg, const unsigned char* Vimg, unsigned short* MIX, const float* hn, char* shm,
                                          float* slabs, unsigned* cnts, volatile __attribute__((address_space(3))) unsigned* bcast, unsigned& nx, gu32* qctr) {
    const int tid = threadIdx.x, lane = tid & 63, r32 = lane & 31, hi = lane >> 5; const int wid = __builtin_amdgcn_readfirstlane(tid >> 6), rg = wid >> 1, mp = wid & 1;
    const UnitDesc D = decode_unit(idx, Bn, Cn, pre, sidx);
    const int h = D.h, t_lo = D.t_lo, t_hi = D.t_hi; const float slope2 = D.slope * LOG2E;
    const float shift2 = fmaxf(0.f, Bn * LOG2E - 24.f);
    const int q0 = D.qb * 128, NT = t_hi - t_lo + 1;
    const unsigned lds0 = (unsigned)(uintptr_t)shm;
    const unsigned char* ksrc = Kimg + (size_t)h * 256 * SLOT + wid * 2048;
    const unsigned char* vsrc = Vimg + (size_t)h * 256 * SLOT + wid * 2048;
    const unsigned lane16 = (unsigned)lane * 16u;
    const unsigned kdst = lds0 + LDS_K + wid * 2048, vdst = lds0 + LDS_V + wid * 2048;
    const unsigned short* Qw = Q + (size_t)(q0 + rg * 32 + r32) * AW + h * 128 + mp * 64 + hi * 8;
    bf16x8 qr[4];
#pragma unroll
    for (int d0 = 0; d0 < 4; ++d0) qr[d0] = *(const bf16x8*)(Qw + d0 * 16);
    int tj = t_lo;
    ATT_DMA2(ksrc, tj, kdst); ATT_DMA2(ksrc, tj + 1, kdst + SLOT); ATT_DMA2(vsrc, tj, vdst); ATT_DMA2(ksrc, tj + 2, kdst + 2 * SLOT); ATT_DMA2(ksrc, tj + 3, kdst + 3 * SLOT); ATT_DMA2(vsrc, tj + 1, vdst + SLOT);
    const lds_cptr shm3 = (lds_cptr)shm;
    const lds_cptr kp0 = shm3 + LDS_K + (8 * mp + hi) * 1024 + r32 * 16;
    const lds_cptr vp0 = shm3 + LDS_V + v_rd_base(lane);
    const float dq0 = (float)(q0 + rg * 32 + r32 - t_lo * 64 - 4 * hi);
    const int qw0 = q0 + rg * 32;
    const float nslope2 = -slope2;
    f32x16 o[4]; o[0] = f32x16{}; o[1] = f32x16{}; o[2] = f32x16{}; o[3] = f32x16{};
    f32x4 lacc4 = f32x4{0.f, 0.f, 0.f, 0.f};
    bf16x8 lmask; { const int row_ = lane & 15, kg_ = lane >> 4; const bool on_ = (((row_ & 7) == 0) && ((kg_ & 1) == 0)) || (((row_ & 7) == 4) && ((kg_ & 1) == 1));
                    const short one_ = on_ ? (short)0x3F80 : (short)0; lmask = (bf16x8){one_, one_, one_, one_, one_, one_, one_, one_}; }
    f32x16 sA0, sA1, sB0, sB1; bf16x8 pa0, pa1, pa2, pa3 = bf16x8{};
    bias_general(sA0, sA1, dq0, nslope2, shift2);
    bias_general(sB0, sB1, dq0 - 64.f, nslope2, shift2);
    ATT_WAIT_BAR(8);
    qkt_acc(sA0, sA1, kp0, qr);
    qkt_acc(sB0, sB1, kp0 + SLOT, qr);
    softmax_first(sA0, sA1, pa0, pa1, pa2);
    float dq1 = dq0 - 64.f;
    int sk_cur = 2 * SLOT, sv_cur = 0, sk_dma = 0, sv_dma = 2 * SLOT;
    const bool lead_half = wid < 4;
    if (wid >= 4) __builtin_amdgcn_s_setprio(1);
    int j = 0;
    for (; j + 2 < NT; j += 2) { ATT_STEP(sA0, sA1, sB0, sB1, true, true, j); ATT_STEP(sB0, sB1, sA0, sA1, true, true, j + 1); }
    if (NT - j == 2) { ATT_STEP(sA0, sA1, sB0, sB1, true, true, j);
#pragma unroll
        for (int r = 8; r < 16; ++r) sA1[r] = sB1[r];
        ATT_STEP(sA0, sA1, sB0, sB1, false, false, j + 1); }
    else { ATT_STEP(sA0, sA1, sB0, sB1, false, false, j); }
    __builtin_amdgcn_s_setprio(0);
    float l_acc = lacc4[0];
    ATT_WAIT_BAR(0);
    if (threadIdx.x == 0) nx = ticket_add(qctr);
    int idx_e = idx; asm volatile("" : "+s"(idx_e));
    int tid_e = threadIdx.x; asm volatile("" : "+v"(tid_e));
    const int lane_e = tid_e & 63, r32_e = lane_e & 31, hi_e = lane_e >> 5, wid_e = __builtin_amdgcn_readfirstlane(tid_e >> 6), rg_e = wid_e >> 1, mp_e = wid_e & 1;
    const UnitDesc E = decode_unit(idx_e, Bn, Cn, pre, sidx);
    const int nc = E.nc, ci = E.ci, h_e = E.h, q0_e = E.qb * 128;
    float* slab_u = slabs + (size_t)E.sid * 3 * SLAB_FLOATS; unsigned* cnt_u = cnts + E.u;
    if (nc > 1) {
        float* sl = slab_u + (size_t)ci * SLAB_FLOATS + wid_e * 4160;
#pragma unroll
        for (int d0 = 0; d0 < 4; ++d0)
#pragma unroll
            for (int i = 0; i < 4; ++i) { const f32x4 v_ = (f32x4){o[d0][4 * i], o[d0][4 * i + 1], o[d0][4 * i + 2], o[d0][4 * i + 3]};
                asm volatile("global_store_dwordx4 %0, %1, off sc1\n\ts_nop 1" :: "v"(sl + ((d0 * 4 + i) * 64 + lane_e) * 4), "v"(v_) : "memory"); }
        asm volatile("global_store_dword %0, %1, off sc1\n\ts_nop 1" :: "v"(sl + 4096 + lane_e), "v"(l_acc) : "memory");
        asm volatile("s_waitcnt vmcnt(0)" ::: "memory");
        __syncthreads();
        if (tid_e == 0) bcast[0] = __hip_atomic_fetch_add(cnt_u, 1u, __ATOMIC_RELAXED, __HIP_MEMORY_SCOPE_AGENT);
        __syncthreads();
        const unsigned old = bcast[0];
        __syncthreads();
        if ((int)old != nc - 1) return;
        if (tid_e == 0) { __builtin_amdgcn_fence(__ATOMIC_ACQUIRE, "agent"); asm volatile("s_waitcnt vmcnt(0)" ::: "memory"); }
        __syncthreads();
        o[0] = f32x16{}; o[1] = f32x16{}; o[2] = f32x16{}; o[3] = f32x16{}; l_acc = 0.f;
        for (int cc = 0; cc < nc; ++cc) { const float* rs = slab_u + (size_t)cc * SLAB_FLOATS + wid_e * 4160;
            f32x4 sv[16];
#pragma unroll
            for (int k = 0; k < 16; ++k) sv[k] = *(const f32x4*)(rs + (k * 64 + lane_e) * 4);
            const float sl_l = rs[4096 + lane_e];
            asm volatile("" :: "v"(sv[0]), "v"(sv[1]), "v"(sv[2]), "v"(sv[3]), "v"(sv[4]), "v"(sv[5]), "v"(sv[6]), "v"(sv[7]), "v"(sv[8]), "v"(sv[9]), "v"(sv[10]), "v"(sv[11]), "v"(sv[12]), "v"(sv[13]), "v"(sv[14]), "v"(sv[15]));
#pragma unroll
            for (int d0 = 0; d0 < 4; ++d0)
#pragma unroll
                for (int i = 0; i < 4; ++i) { const f32x4 v = sv[d0 * 4 + i]; o[d0][4 * i] += v[0]; o[d0][4 * i + 1] += v[1]; o[d0][4 * i + 2] += v[2]; o[d0][4 * i + 3] += v[3]; }
            l_acc += sl_l; }
    }
    float* wsf = (float*)(shm + LDS_WS) + wid_e * 64;
    if (hi_e == 0) wsf[r32_e] = l_acc;
    asm volatile("s_waitcnt lgkmcnt(0)" ::: "memory");
    float rli[16];
#pragma unroll
    for (int r = 0; r < 16; ++r) rli[r] = __builtin_amdgcn_rcpf(wsf[crow(r, hi_e)]);
    float* X = (float*)shm + rg_e * 32 * XSTRIDE;
    if (mp_e == 1) {
#pragma unroll
        for (int r = 0; r < 16; ++r)
#pragma unroll
            for (int d0 = 0; d0 < 4; ++d0) X[crow(r, hi_e) * XSTRIDE + d0 * 32 + r32_e] = lam * o[d0][r] * rli[r];
    }
    ATT_LDS_BAR();
    if (mp_e == 0) {
#pragma unroll
        for (int r = 0; r < 16; ++r)
#pragma unroll
            for (int d0 = 0; d0 < 4; ++d0) { float* xp = X + crow(r, hi_e) * XSTRIDE + d0 * 32 + r32_e; *xp = o[d0][r] * rli[r] - *xp; }
        asm volatile("s_waitcnt lgkmcnt(0)" ::: "memory");
        const float* xr = X + r32_e * XSTRIDE + hi_e * 64;
        f32x4 v[16]; float ss = 0.f;
#pragma unroll
        for (int i = 0; i < 16; ++i) { v[i] = *(const f32x4*)(xr + 4 * i); ss += (v[i][0] * v[i][0] + v[i][1] * v[i][1]) + (v[i][2] * v[i][2] + v[i][3] * v[i][3]); }
        { auto rr = __builtin_amdgcn_permlane32_swap(__float_as_uint(ss), __float_as_uint(ss), false, false); ss = __uint_as_float(rr[0]) + __uint_as_float(rr[1]); }
        const float rn = rsqrtf(ss * (1.f / 128.f) + EPS) * (1.f - LAM_INIT);
        unsigned short* orow = MIX + (size_t)(q0_e + rg_e * 32 + r32_e) * DM + h_e * 128 + hi_e * 64;
        const __attribute__((address_space(3))) f32x4* g = (const __attribute__((address_space(3))) f32x4*)((lds_cptr)shm + LDS_HN + hi_e * 256);
#pragma unroll
        for (int i = 0; i < 8; ++i) { const f32x4 g0 = g[2 * i], g1 = g[2 * i + 1]; const f32x4 a = v[2 * i] * rn * g0, b = v[2 * i + 1] * rn * g1;
            u32x4 w; w.x = cvtpk(a[0], a[1]); w.y = cvtpk(a[2], a[3]); w.z = cvtpk(b[0], b[1]); w.w = cvtpk(b[2], b[3]); *(u32x4*)(orow + 8 * i) = w; }
    }
    ATT_LDS_BAR();
}
}

constexpr int N_LAUNCHES = MK_N_LAUNCHES, PER_PHASE = 7;
constexpr int N_ATT_UNITS = NH * (M / 128), N_CONV_UNITS = M / CONV_ROWS;

__global__ void __launch_bounds__(NWAVES * 64, 2) fwd(Args args) {
    extern __shared__ __attribute__((aligned(16))) unsigned char lds_raw[];
    LAS unsigned char* lds = (LAS unsigned char*)lds_raw;
    volatile LAS unsigned* MISC = (volatile LAS unsigned*)(lds + MISC_OFF);
    const int tid = threadIdx.x, lane = tid & 63, wave = __builtin_amdgcn_readfirstlane(tid >> 6);
    const int G = gridDim.x; const int bx = blockIdx.x; const int vcu = (G % 8 == 0) ? (bx % 8) * (G / 8) + bx / 8 : bx;
    unsigned char* ws = args.ws;
    gu32* ctl = (gu32*)(ws + WS_CTL);
    for (int u = tid; u < (LDS_BYTES - LDSCTL_OFF) / 4; u += NWAVES * 64) ((LAS unsigned*)(lds + LDSCTL_OFF))[u] = 0u;
    __syncthreads();
    XcdBarrier bar; bar.bar = (unsigned*)(ctl + CW_BAR); bar.x = 0; bar.st = nullptr;
    unsigned rank0 = 0u;
    if (N_LAUNCHES != PER_PHASE) bar = xcd_barrier_post((unsigned*)(ctl + CW_BAR), MISC + 8, rank0);
#define GRID_BAR() do { if (N_LAUNCHES != PER_PHASE) xcd_barrier(bar); } while (0)
    const int lo = args.ph_lo, hi = args.ph_hi;
#define IN(k) (lo <= (k) && (k) < hi)
#define BOTH(k) (IN(k) && IN((k) + 1))
    bf16* XN = (bf16*)(ws + WS_XN); bf16* Qb = (bf16*)(ws + WS_Q); unsigned char* Kimg = ws + WS_KIMG; unsigned char* Vimg = ws + WS_VIMG; bf16* Ub = (bf16*)(ws + WS_U);
    bf16* MIX = (bf16*)(ws + WS_MIX); bf16* HM = (bf16*)(ws + WS_HM); bf16* PB = (bf16*)(ws + WS_PB); bf16* PR = (bf16*)(ws + WS_PROJ);
    float* SS1 = (float*)(ws + WS_SS1); float* SS2 = (float*)(ws + WS_SS2);

    if (IN(0)) { p0_prologue(args, lds, vcu, G, wave, lane); if (tid == 0) MISC[10] = rank0; if (BOTH(0)) GRID_BAR(); }
    int vc = bx; bool xl = false;
    if (N_LAUNCHES == 1 && IN(0)) { xl = __builtin_amdgcn_readfirstlane((int)MISC[11]) != 0; if (xl) vc = (int)bar.x + 8 * __builtin_amdgcn_readfirstlane((int)MISC[10]); }
#define XCD_BAR() do { if (N_LAUNCHES != PER_PHASE) { if (xl) xcd_local_barrier(bar); else xcd_barrier(bar); } } while (0)

    constexpr int NT1 = (M / 256) * (NIN / 256);
    const int first_idle = NT1 - ((NT1 + G - 1) / G - 1) * G, w_p1 = (N_LAUNCHES == 1) ? ((G - first_idle) < N_W_UNITS ? (G - first_idle) : N_W_UNITS) : 0, w_p2 = N_W_UNITS - w_p1;
    if (IN(1)) {
        { pg8::Gemm g{XN, (const bf16*)(ws + WS_WIN), M, NIN, DM}; pg8::StaticOrder S; S.init(M, NIN, G, bx);
          LAS float* rtab = (LAS float*)(lds + LDSCTL_OFF + 12288); int rpm = -1;
          LAS float* gtab = (LAS float*)(lds + LDSCTL_OFF + 13824);
          if (tid >= 256 && tid < 384) gtab[tid - 256] = tid < 320 ? args.in[4][tid - 256] : args.in[5][tid - 320];
          { pg8::Unit u0; if (S.next(0, u0)) { rpm = u0.pm; if (tid < 256) rtab[tid] = rsqrtf(((const float*)(ws + WS_SS0))[rpm * 256 + tid] * (1.f / DM) + EPS); } __syncthreads(); }
          pg8::EpiIn E{Qb, Kimg, Vimg, Ub, args.in[4], args.in[5], (unsigned*)(ctl + CW_QMAX), (const float*)(ws + WS_SS0), rtab, rpm, gtab, (LAS unsigned*)(lds + LDSCTL_OFF + 14400)};
          pg8::gemm_phase<pg8::EpiIn, pg8::StaticOrder, PG8_ALIGN, PG8_SP2>(lds + RING_OFF, g, S, E);
          __syncthreads();
          if (tid < 3) { const unsigned v = ((LAS unsigned*)(lds + LDSCTL_OFF + 14400))[tid]; if (v) atomicMax((unsigned*)(ctl + CW_QMAX) + tid, v); } }
        if (w_p1 > 0 && bx >= first_idle && bx - first_idle < w_p1) weight_unit(bx - first_idle, args, lds, wave, lane);
        if (BOTH(1)) GRID_BAR();
    }

    if (IN(2)) {
        const unsigned mx3 = __hip_atomic_load((unsigned*)(ctl + CW_QMAX) + (lane < 3 ? lane : 0), __ATOMIC_RELAXED, __HIP_MEMORY_SCOPE_AGENT);
        const float hn_in = args.in[10][tid & 127];
        unsigned nx = 0;
        if (tid == 0) nx = ticket_add(ctl + CW_QUEUE);
        const float qmax = __uint_as_float(__builtin_amdgcn_readlane(mx3, 0)), kmax = __uint_as_float(__builtin_amdgcn_readlane(mx3, 1)), kbar = __uint_as_float(__builtin_amdgcn_readlane(mx3, 2));
        const float Bn = qmax * kmax * (1.02f / LOG2E);
        const float Cn = qmax * kbar * (1.02f / LOG2E) + 0.05f;
        const float d1 = wave_sum(args.in[6][lane] * args.in[7][lane]), d2 = wave_sum(args.in[8][lane] * args.in[9][lane]);
        const float lam = __expf(d1) - __expf(d2) + LAM_INIT;
        LAS unsigned short* pre = (LAS unsigned short*)(lds + LDSCTL_OFF + 1024);
        LAS unsigned short* sidx = (LAS unsigned short*)(lds + LDSCTL_OFF + 2112);
        LAS unsigned* wtot = (LAS unsigned*)(lds + LDSCTL_OFF + 3200);
        if (tid < 128) ((LAS float*)(lds + att::LDS_HN))[tid] = hn_in;
        { const int u = tid, h = 3 - (u >> 7), k = u & 127, qb = (k & 1) ? 63 - (k >> 1) : 64 + (k >> 1);
          const float slope = exp2f(-2.f * (float)(h + 1));
          const float Rf = att::att_window(Bn, Cn, slope, 2 * qb);
          const int R = Rf < 20000.f ? (int)Rf + 1 : 20000;
          ((LAS unsigned short*)(lds + LDSCTL_OFF + 14464))[u] = (unsigned short)R;
          const int q0 = qb * 128; const int klo = q0 - R < 0 ? 0 : q0 - R, khi = q0 + 127 + R > M - 1 ? M - 1 : q0 + 127 + R;
          const int my_nt = (khi >> 6) - (klo >> 6) + 1, want = my_nt > 100 ? 1 : 0;
          int v = want;
#pragma unroll
          for (int o = 1; o < 64; o <<= 1) { const int t = __shfl_up(v, o); if (lane >= o) v += t; }
          if (lane == 63) wtot[wave] = (unsigned)v;
          __syncthreads();
          int off = 0;
          for (int w = 0; w < wave; ++w) off += (int)wtot[w];
          const int sid = off + v - want;
          const int my_nc = (want && sid < MAX_SPLIT_UNITS) ? ((my_nt + 63) / 64 < 3 ? (my_nt + 63) / 64 : 3) : 1;
          sidx[u] = (unsigned short)sid;
          v = my_nc;
#pragma unroll
          for (int o = 1; o < 64; o <<= 1) { const int t = __shfl_up(v, o); if (lane >= o) v += t; }
          if (lane == 63) wtot[8 + wave] = (unsigned)v;
          __syncthreads();
          off = 0;
          for (int w = 0; w < wave; ++w) off += (int)wtot[8 + w];
          pre[u] = (unsigned short)(off + v - my_nc);
          if (u == 511) pre[512] = (unsigned short)(off + v);
          { LAS unsigned* item = (LAS unsigned*)(lds + LDSCTL_OFF + 8192);
            for (int ci = 0; ci < my_nc; ++ci) item[off + v - my_nc + ci] = (unsigned)u | ((unsigned)ci << 10) | ((unsigned)my_nc << 12); }
          __syncthreads(); }
        const int n_att = (int)pre[512];
        unsigned* slabs_cnt = (unsigned*)(ctl + CW_UCNT);
        bool conv_w_staged = false;
        for (;;) {
            if (tid == 0) MISC[16] = nx;
            ATT_LDS_BAR();
            const int idx = __builtin_amdgcn_readfirstlane((int)MISC[16]);
            ATT_LDS_BAR();
            if (idx >= n_att + w_p2 + N_CONV_UNITS) break;
            if (idx < n_att) {
                att::attn_unit(idx, Bn, Cn, lam, pre, sidx, Qb, Kimg, Vimg, MIX, args.in[10], (char*)lds_raw, (float*)(ws + WS_SLAB), slabs_cnt, MISC + 17, nx, ctl + CW_QUEUE);
            } else if (idx < n_att + w_p2 && tid == 0) nx = ticket_add(ctl + CW_QUEUE);
            if (idx < n_att) {
            } else if (idx < n_att + w_p2) {
                weight_unit(w_p1 + idx - n_att, args, lds, wave, lane);
            } else {
                conv_unit(idx - n_att - w_p2, Ub, ws + WS_CW16, args.in[12], args.in[13], args.in[14], MIX, lds, tid, wave, lane, conv_w_staged, nx, ctl + CW_QUEUE);
            }
        }
        if (BOTH(2)) GRID_BAR();
    }

    if (IN(3)) {
        pg8::Gemm g{MIX, (const bf16*)(ws + WS_WOUT), M, DM, DM}; pg8::StaticOrder S; S.init(M, DM, G, vc);
        pg8::EpiRes<false> E{nullptr, XN, SS1};
        pg8::gemm_phase<pg8::EpiRes<false>, pg8::StaticOrder, PG8_ALIGN, PG8_SP2>(lds + RING_OFF, g, S, E);
        if (BOTH(3)) XCD_BAR();
    }
    if (IN(4)) {
        { pg8::Gemm g{XN, (const bf16*)(ws + WS_WGU), M, 2 * FF, DM}; pg8::StaticOrder S; S.init(M, 2 * FF, G, vc);
          LAS float* rtab = (LAS float*)(lds + LDSCTL_OFF + 12288); int rpm = -1;
          { pg8::Unit u0; if (S.next(0, u0)) { rpm = u0.pm; if (tid < 256) { const f32x4* sp = (const f32x4*)(SS1 + (size_t)(rpm * 256 + tid) * 16); const f32x4 a = sp[0], b = sp[1], c = sp[2], d = sp[3];
                rtab[tid] = rsqrtf((((a[0] + a[1]) + (a[2] + a[3])) + ((b[0] + b[1]) + (b[2] + b[3])) + ((c[0] + c[1]) + (c[2] + c[3])) + ((d[0] + d[1]) + (d[2] + d[3]))) * (1.f / DM) + EPS); } } __syncthreads(); }
          pg8::EpiGU E{HM, SS1, rtab, rpm};
          pg8::gemm_phase<pg8::EpiGU, pg8::StaticOrder, PG8_ALIGN, PG8_SP2>(lds + RING_OFF, g, S, E); }
        { int kproj = PD; asm volatile("" : "+s"(kproj));
          pg8::Gemm g{PB, (const bf16*)(ws + WS_WPP), M, DM, kproj}; pg8::HelperOrder S{G, vc};
          pg8::EpiBf16 E{PR, DM};
          pg8::gemm_phase<pg8::EpiBf16, pg8::HelperOrder, PG8_ALIGN, PG8_SP2>(lds + RING_OFF, g, S, E); }
        if (BOTH(4)) XCD_BAR();
    }
    if (IN(5)) {
        pg8::Gemm g{HM, (const bf16*)(ws + WS_WDN), M, DM, FF}; pg8::StaticOrder S; S.init(M, DM, G, vc);
        pg8::EpiRes<false> E{nullptr, XN, SS2};
        pg8::gemm_phase<pg8::EpiRes<false>, pg8::StaticOrder, PG8_ALIGN, PG8_SP2>(lds + RING_OFF, g, S, E);
        if (BOTH(5)) XCD_BAR();
    }
    if (IN(6)) {
        pg8::Gemm g{XN, (const bf16*)(ws + WS_WPG), M, DM, DM}; pg8::StaticOrder S; S.init(M, DM, G, vc);
        LAS float* rtab = (LAS float*)(lds + LDSCTL_OFF + 12288); int rpm = -1;
        { pg8::Unit u0; if (S.next(0, u0)) { rpm = u0.pm; if (tid < 256) { const f32x4* sp = (const f32x4*)(SS2 + (size_t)(rpm * 256 + tid) * 16); const f32x4 a = sp[0], b = sp[1], c = sp[2], d = sp[3];
              rtab[tid] = rsqrtf((((a[0] + a[1]) + (a[2] + a[3])) + ((b[0] + b[1]) + (b[2] + b[3])) + ((c[0] + c[1]) + (c[2] + c[3])) + ((d[0] + d[1]) + (d[2] + d[3]))) * (1.f / DM) + EPS); } } __syncthreads(); }
        pg8::EpiPG E{args.out, XN, PR, SS2, rtab, rpm};
        pg8::gemm_phase<pg8::EpiPG, pg8::StaticOrder, PG8_ALIGN, PG8_SP2>(lds + RING_OFF, g, S, E);
    }
#undef IN
#undef BOTH
#undef GRID_BAR
#undef XCD_BAR
}

extern "C" void kernel_launch(void* const* d_in, const int* in_sizes, int n_in, void* d_out, int out_size, void* d_ws, size_t ws_size, hipStream_t stream) {
    static int grid = 0;
    if (grid == 0) {
        if (n_in != 23 || in_sizes[0] != M * DM || out_size != M * DM || ws_size < WS_END) { fprintf(stderr, "kernel_launch: unexpected shapes (n_in %d, out %d, ws %zu); nothing launched\n", n_in, out_size, ws_size); grid = -1; return; }
        int dev = 0, cus = 0, per_cu = 0;
        if (hipGetDevice(&dev) != hipSuccess || hipDeviceGetAttribute(&cus, hipDeviceAttributeMultiprocessorCount, dev) != hipSuccess) { grid = -1; return; }
        if (hipFuncSetAttribute((const void*)fwd, hipFuncAttributeMaxDynamicSharedMemorySize, LDS_BYTES) != hipSuccess) { fprintf(stderr, "kernel_launch: hipFuncSetAttribute failed\n"); grid = -1; return; }
        const hipError_t oe = hipOccupancyMaxActiveBlocksPerMultiprocessor(&per_cu, (const void*)fwd, NWAVES * 64, LDS_BYTES);
        (void)hipGetLastError();
        if (oe == hipSuccess && per_cu < 1) { fprintf(stderr, "kernel_launch: the occupancy query admits no workgroup of this kernel per CU; nothing launched\n"); grid = -1; return; }
        grid = cus;
    }
    if (grid < 0) return;
    if (hipMemsetAsync((char*)d_ws + WS_CTL, 0, CTL_ZERO_BYTES, stream) != hipSuccess) { fprintf(stderr, "kernel_launch: memset failed\n"); return; }
    Args a{};
    for (int i = 0; i < 23; ++i) a.in[i] = (const float*)d_in[i];
    a.out = (float*)d_out; a.ws = (unsigned char*)d_ws;
    for (int li = 0; li < N_LAUNCHES; ++li) {
        a.ph_lo = (N_LAUNCHES == PER_PHASE) ? li : 0; a.ph_hi = (N_LAUNCHES == PER_PHASE) ? li + 1 : PER_PHASE; a.li = li;
        hipLaunchKernelGGL(fwd, dim3(grid), dim3(NWAVES * 64), LDS_BYTES, stream, a);
        const hipError_t le = hipPeekAtLastError();
        if (le != hipSuccess) { fprintf(stderr, "kernel_launch: launch %d failed: %s\n", li, hipGetErrorName(le)); break; }
    }
}
```
